# Optimizing an MI355X kernel written in HIP

```python
import jax, jax.numpy as jnp
from jax import lax
import numpy as np

D_MODEL = 1024
BATCH = 8
SEQ = 4096
DEPTH = 4

EPS = 1e-6
GLA_HEADS = 4
GLA_DK = 64
GLA_DV = 128
GLA_GATE_RANK = 16
GLA_TAU = 16.0
GLA_CHUNK = 64
GLA_WIDTH = GLA_HEADS * GLA_DV
MLA_HEADS = 4
MLA_Q_RANK = 256
MLA_KV_RANK = 128
MLA_NOPE = 128
MLA_ROPE = 64
MLA_V = 128
MLA_QBLOCK = 128
MLA_WIDTH = MLA_HEADS * MLA_V
ROPE_THETA = 10000.0
SG_GROUPS = 8
SG_WIDTH = 2 * D_MODEL
SG_CHUNK = 128

N_EVEN = (DEPTH + 1) // 2
N_ODD = DEPTH // 2

EVEN_SPLITS = (GLA_HEADS * GLA_DK, GLA_HEADS * GLA_DK, GLA_WIDTH, GLA_GATE_RANK, GLA_GATE_RANK, GLA_WIDTH,
               MLA_Q_RANK, MLA_KV_RANK, MLA_ROPE, MLA_WIDTH)
EVEN_IN = sum(EVEN_SPLITS)
ODD_IN = 3 * SG_WIDTH

kernel_name = "hybrid_gla_mla_gmlp_encoder"


def _split(x, sizes):
    out, o = [], 0
    for s in sizes:
        out.append(x[..., o:o + s])
        o += s
    return out


def rms_norm(x, g):
    xf = x.astype(jnp.float32)
    y = xf * lax.rsqrt(jnp.mean(xf * xf, axis=-1, keepdims=True) + EPS)
    return (y * g.astype(jnp.float32)).astype(x.dtype)


def layer_norm(x, g, b):
    xf = x.astype(jnp.float32)
    mu = jnp.mean(xf, axis=-1, keepdims=True)
    var = jnp.mean(jnp.square(xf - mu), axis=-1, keepdims=True)
    y = (xf - mu) * lax.rsqrt(var + EPS)
    return (y * g.astype(jnp.float32) + b.astype(jnp.float32)).astype(x.dtype)


def apply_rope(x, cos, sin):
    x1, x2 = jnp.split(x, 2, axis=-1)
    return jnp.concatenate([x1 * cos - x2 * sin, x2 * cos + x1 * sin], axis=-1)


def gla_scan(q, k, v, g, strict):
    B, S, H, dk = q.shape
    dv = v.shape[-1]
    N = S // GLA_CHUNK

    def to_chunks(t):
        return t.reshape(B, N, GLA_CHUNK, H, t.shape[-1]).transpose(1, 0, 3, 2, 4)

    mask = jnp.tril(jnp.ones((GLA_CHUNK, GLA_CHUNK), bool), k=-1 if strict else 0)

    def step(state, inp):
        qc, kc, vc, gc = inp
        b = jnp.cumsum(gc, axis=2)
        diff = b[:, :, :, None, :] - b[:, :, None, :, :]
        decay = jnp.exp(jnp.where(mask[None, None, :, :, None], diff, -jnp.inf))
        att = jnp.einsum('bhid,bhjd,bhijd->bhij', qc, kc, decay)
        o = jnp.einsum('bhij,bhjv->bhiv', att, vc) + jnp.einsum('bhid,bhdv->bhiv', qc * jnp.exp(b), state)
        b_last = b[:, :, -1, :]
        state = jnp.exp(b_last)[..., None] * state + jnp.einsum(
            'bhjd,bhjv->bhdv', kc * jnp.exp(b_last[:, :, None, :] - b), vc)
        return state, o

    s0 = jnp.zeros((B, H, dk, dv), jnp.float32)
    _, outs = lax.scan(step, s0, (to_chunks(q), to_chunks(k), to_chunks(v), to_chunks(g)))
    return outs.transpose(1, 0, 3, 2, 4).reshape(B, S, H, dv)


def gla_branch(q, k, v, a_f, a_b, z, w2_f, b_f, w2_b, b_b, g_norm):
    B, S, _ = q.shape
    q = q.reshape(B, S, GLA_HEADS, GLA_DK) * (GLA_DK ** -0.5)
    k = k.reshape(B, S, GLA_HEADS, GLA_DK)
    v = v.reshape(B, S, GLA_HEADS, GLA_DV)
    g_f = (jax.nn.log_sigmoid((a_f @ w2_f + b_f).astype(jnp.float32)) / GLA_TAU).reshape(B, S, GLA_HEADS, GLA_DK)
    g_b = (jax.nn.log_sigmoid((a_b @ w2_b + b_b).astype(jnp.float32)) / GLA_TAU).reshape(B, S, GLA_HEADS, GLA_DK)
    o_f = gla_scan(q, k, v, g_f, False)
    flip = lambda t: jnp.flip(t, axis=1)
    o_b = flip(gla_scan(flip(q), flip(k), flip(v), flip(g_b), True))
    o = rms_norm((o_f + o_b).astype(z.dtype), g_norm).reshape(B, S, GLA_WIDTH)
    return o * jax.nn.silu(z)


def mla_branch(cq, ckv, kr, z, g_q, w_uq, g_kv, w_ukv, cos, sin):
    B, S, _ = cq.shape
    q = (rms_norm(cq, g_q) @ w_uq).reshape(B, S, MLA_HEADS, MLA_NOPE + MLA_ROPE)
    qn, qr = q[..., :MLA_NOPE], q[..., MLA_NOPE:]
    qr = apply_rope(qr, cos[:, :, None, :], sin[:, :, None, :])
    kv = (rms_norm(ckv, g_kv) @ w_ukv).reshape(B, S, MLA_HEADS, MLA_NOPE + MLA_V)
    kn, v = kv[..., :MLA_NOPE], kv[..., MLA_NOPE:]
    kr = apply_rope(kr, cos, sin)
    scale = (MLA_NOPE + MLA_ROPE) ** -0.5
    nb = S // MLA_QBLOCK
    qn_b = (qn * scale).reshape(B, nb, MLA_QBLOCK, MLA_HEADS, MLA_NOPE).transpose(1, 0, 2, 3, 4)
    qr_b = (qr * scale).reshape(B, nb, MLA_QBLOCK, MLA_HEADS, MLA_ROPE).transpose(1, 0, 2, 3, 4)

    def attend(blk):
        qn_i, qr_i = blk
        s = jnp.einsum('bqhd,bkhd->bhqk', qn_i, kn) + jnp.einsum('bqhr,bkr->bhqk', qr_i, kr)
        p = jax.nn.softmax(s.astype(jnp.float32), axis=-1).astype(v.dtype)
        return jnp.einsum('bhqk,bkhd->bqhd', p, v)

    o = lax.map(attend, (qn_b, qr_b))
    o = o.transpose(1, 0, 2, 3, 4).reshape(B, S, MLA_WIDTH)
    return o * jax.nn.silu(z)


def sgmlp_branch(p, g_ln, b_ln, w_s, b_s):
    B, S, _ = p.shape
    uv, z = p[..., :2 * SG_WIDTH], p[..., 2 * SG_WIDTH:]
    uv = jax.nn.gelu(uv, approximate=False)
    u, v = uv[..., :SG_WIDTH], uv[..., SG_WIDTH:]
    v = layer_norm(v, g_ln, b_ln)
    n = S // SG_CHUNK
    vc = v.reshape(B, n, SG_CHUNK, SG_GROUPS, SG_WIDTH // SG_GROUPS)
    mixed = jnp.einsum('gij,bnjgc->bnigc', w_s, vc) + b_s.T[:, :, None]
    return u * mixed.reshape(B, S, SG_WIDTH) * jax.nn.silu(z)


def setup_inputs(seed: int = 0) -> dict:
    key = jax.random.key(seed)
    ks = jax.random.split(key, 32)
    nrm = lambda k, shape, s: jax.random.normal(k, shape, jnp.float32) * s
    gain = lambda k, shape: 1.0 + nrm(k, shape, 0.02)
    D = D_MODEL
    x = nrm(ks[0], (BATCH, SEQ, D), 1.0)
    c = nrm(ks[1], (BATCH, D), 1.0)
    positions = jnp.arange(SEQ, dtype=jnp.int32)[None, :] + jax.random.randint(ks[2], (BATCH, 1), 0, 1024, jnp.int32)
    return {
        "x": x,
        "c": c,
        "positions": positions,
        "w_mod": nrm(ks[3], (DEPTH, D, 3 * D), 0.5 * D ** -0.5),
        "b_mod": nrm(ks[4], (DEPTH, 3 * D), 0.1),
        "g_pre": gain(ks[5], (DEPTH, D)),
        "g_post": gain(ks[6], (DEPTH, D)),
        "w_in_e": nrm(ks[7], (N_EVEN, D, EVEN_IN), D ** -0.5),
        "gla_w_gate_f": nrm(ks[8], (N_EVEN, GLA_GATE_RANK, GLA_HEADS * GLA_DK), GLA_GATE_RANK ** -0.5),
        "gla_b_gate_f": nrm(ks[9], (N_EVEN, GLA_HEADS * GLA_DK), 0.5),
        "gla_w_gate_b": nrm(ks[10], (N_EVEN, GLA_GATE_RANK, GLA_HEADS * GLA_DK), GLA_GATE_RANK ** -0.5),
        "gla_b_gate_b": nrm(ks[11], (N_EVEN, GLA_HEADS * GLA_DK), 0.5),
        "gla_g_norm": gain(ks[12], (N_EVEN, GLA_DV)),
        "mla_g_q": gain(ks[13], (N_EVEN, MLA_Q_RANK)),
        "mla_w_uq": nrm(ks[14], (N_EVEN, MLA_Q_RANK, MLA_HEADS * (MLA_NOPE + MLA_ROPE)), MLA_Q_RANK ** -0.5),
        "mla_g_kv": gain(ks[15], (N_EVEN, MLA_KV_RANK)),
        "mla_w_ukv": nrm(ks[16], (N_EVEN, MLA_KV_RANK, MLA_HEADS * (MLA_NOPE + MLA_V)), MLA_KV_RANK ** -0.5),
        "w_out_e": nrm(ks[17], (N_EVEN, GLA_WIDTH + MLA_WIDTH, D), (GLA_WIDTH + MLA_WIDTH) ** -0.5),
        "w_in_o": nrm(ks[18], (N_ODD, D, ODD_IN), D ** -0.5),
        "sg_g_norm": gain(ks[19], (N_ODD, SG_WIDTH)),
        "sg_b_norm": nrm(ks[20], (N_ODD, SG_WIDTH), 0.02),
        "sg_w_s": nrm(ks[21], (N_ODD, SG_GROUPS, SG_CHUNK, SG_CHUNK), SG_CHUNK ** -0.5),
        "sg_b_s": 1.0 + nrm(ks[22], (N_ODD, SG_GROUPS, SG_CHUNK), 0.1),
        "w_out_o": nrm(ks[23], (N_ODD, SG_WIDTH, D), SG_WIDTH ** -0.5),
    }


def reference(x, c, positions, w_mod, b_mod, g_pre, g_post, w_in_e, gla_w_gate_f, gla_b_gate_f,
              gla_w_gate_b, gla_b_gate_b, gla_g_norm, mla_g_q, mla_w_uq, mla_g_kv, mla_w_ukv, w_out_e,
              w_in_o, sg_g_norm, sg_b_norm, sg_w_s, sg_b_s, w_out_o):
    inv_freq = 1.0 / (ROPE_THETA ** (jnp.arange(0, MLA_ROPE, 2, dtype=jnp.float32) / MLA_ROPE))
    ang = positions.astype(jnp.float32)[..., None] * inv_freq
    cos, sin = jnp.cos(ang).astype(x.dtype), jnp.sin(ang).astype(x.dtype)
    c_act = jax.nn.silu(c)
    for l in range(DEPTH):
        mod = c_act @ w_mod[l] + b_mod[l]
        shift, scale, gate = jnp.split(mod[:, None, :], 3, axis=-1)
        h = rms_norm(x, g_pre[l]) * (1.0 + scale) + shift
        if l % 2 == 0:
            e = l // 2
            (gq, gk, gv, ga_f, ga_b, gz, cq, ckv, kr, mz) = _split(h @ w_in_e[e], EVEN_SPLITS)
            o_a = gla_branch(gq, gk, gv, ga_f, ga_b, gz, gla_w_gate_f[e], gla_b_gate_f[e],
                             gla_w_gate_b[e], gla_b_gate_b[e], gla_g_norm[e])
            o_b = mla_branch(cq, ckv, kr, mz, mla_g_q[e], mla_w_uq[e], mla_g_kv[e], mla_w_ukv[e], cos, sin)
            y = jnp.concatenate([o_a, o_b], axis=-1) @ w_out_e[e]
        else:
            o = l // 2
            y = sgmlp_branch(h @ w_in_o[o], sg_g_norm[o], sg_b_norm[o], sg_w_s[o], sg_b_s[o]) @ w_out_o[o]
        x = x + gate * rms_norm(y, g_post[l])
    return x
```

```cpp
#ifndef ATT_SDEPTH
#define ATT_SDEPTH 1
#endif
#ifndef ATT_NQR
#define ATT_NQR 5
#endif
#include <hip/hip_runtime.h>
namespace pg8 {
#define PG8_LAS __attribute__((address_space(3)))
typedef unsigned short bf16_t;
typedef short bf16x8 __attribute__((ext_vector_type(8)));
typedef float f32x4 __attribute__((ext_vector_type(4)));
typedef unsigned u32x4 __attribute__((ext_vector_type(4)));
constexpr int BM = 256, BK = 64, HALF = 128, HTB = HALF * BK * 2  , STAGE_BYTES = 8 * HTB, NXCD = 8, WGM = 8;

__host__ __device__ __forceinline__ int lds_byte(int r, int c) { const int st = (r >> 4) * 2 + (c >> 5), rr = r & 15, cc = c & 31, ob = rr * 64 + cc * 2; return st * 1024 + (ob ^ (((ob >> 9) & 1) << 5)); }
__host__ __device__ __forceinline__ void stage_rc(int b, int& R, int& C) { const int st = b / 1024, sb = b % 1024, swz = sb ^ (((sb >> 9) & 1) << 5); R = (st >> 1) * 16 + swz / 64; C = (st & 1) * 32 + (swz % 64) / 2; }
__host__ __device__ __forceinline__ int perm32(int rho) { const int n = rho >> 4, i = rho & 15; return 8 * (i >> 2) + 4 * n + (i & 3); }

struct Unit { int pm, pn; };
struct Gemm { const bf16_t* A; const bf16_t* Bt; int M, N, K; };

struct StaticOrder {
    int nM, nN, nwg, G, c;
    __host__ __device__ void init(int M, int N, int G_, int c_) { nM = M / BM; nN = N / BM; nwg = nM * nN; G = G_; c = c_; }
    __host__ __device__ bool next(int i, Unit& u) const {
        const long L = (long)i * G + c; if (L >= nwg) return false;
        int wgid = (int)L; { const int q = nwg / NXCD, r = nwg % NXCD, xcd = wgid % NXCD, off = wgid / NXCD; wgid = (xcd < r ? xcd * (q + 1) : r * (q + 1) + (xcd - r) * q) + off; }
        const int nig = WGM * nN, gid = wgid / nig, fm = gid * WGM, gsz = (nM - fm) < WGM ? (nM - fm) : WGM;
        u.pm = fm + ((wgid % nig) % gsz); u.pn = (wgid % nig) / gsz; return true;
    }
    __device__ __forceinline__ void a_ready(const Unit&) const {}
    __device__ __forceinline__ void done(const Unit&) const {}
};
__device__ __forceinline__ unsigned cvt_pk_bf16(float lo, float hi) { unsigned r; asm volatile("v_cvt_pk_bf16_f32 %0, %1, %2" : "=v"(r) : "v"(lo), "v"(hi)); return r; }
typedef float f32x2 __attribute__((ext_vector_type(2)));
__device__ __forceinline__ f32x2 gelu_pk(f32x2 v) {
    const f32x2 av = __builtin_elementwise_abs(v), d = av * 0.2316418882f + 1.0f;
    f32x2 t; t.x = __builtin_amdgcn_rcpf(d.x); t.y = __builtin_amdgcn_rcpf(d.y);
    f32x2 q = t * 0.5307027145f + (-0.7265760135f); q = q * t + 0.7107068705f; q = q * t + (-0.142248368f); q = q * t + 0.127414796f; q = q * t;
    const f32x2 s = (v * v) * (-0.72134752044f);
    f32x2 e; e.x = __builtin_amdgcn_exp2f(s.x); e.y = __builtin_amdgcn_exp2f(s.y);
    const f32x2 m = v * (q * e), r = v - m;
    f32x2 o; o.x = v.x < 0.f ? m.x : r.x; o.y = v.y < 0.f ? m.y : r.y; return o;
}

struct EpiF32 {
    static constexpr bool PERM = false, AFTER_DRAIN = false;
    float* C; int ldc; const float* bias;
    __device__ __forceinline__ void operator()(const f32x4 (&acc)[2][2][4][2], const Unit& u, int wr, int wc, int fr, int fq) const {
        const int row0 = u.pm * BM + wr * 64 + fr, col0 = u.pn * BM + wc * 32 + 4 * fq;
        f32x4 bv[2][2];
#pragma unroll
        for (int bj = 0; bj < 2; ++bj)
#pragma unroll
            for (int n = 0; n < 2; ++n) bv[bj][n] = bias ? *(const f32x4*)(bias + col0 + bj * HALF + n * 16) : (f32x4){0.f, 0.f, 0.f, 0.f};
#pragma unroll
        for (int ai = 0; ai < 2; ++ai)
#pragma unroll
            for (int m = 0; m < 4; ++m) { float* rowp = C + (size_t)(row0 + ai * HALF + m * 16) * ldc + col0;
#pragma unroll
                for (int bj = 0; bj < 2; ++bj)
#pragma unroll
                    for (int n = 0; n < 2; ++n) *(f32x4*)(rowp + bj * HALF + n * 16) = acc[ai][bj][m][n] + bv[bj][n]; }
    }
};
template <class Epi, class Sched, bool STAMP = false>
__device__ __forceinline__ void gemm_phase(PG8_LAS unsigned char* lds, const Gemm g, const Sched& S, const Epi& E, unsigned long long* stamps) {
    int tid = threadIdx.x; asm volatile("" : "+v"(tid));
    const int wid = __builtin_amdgcn_readfirstlane(tid >> 6), lane = tid & 63, wr = wid >> 2, wc = wid & 3, fr = lane & 15, fq = lane >> 4;
    const int K = g.K, nt = K / BK;
    int ts_lo = 0, ts_hi = 0, nts = 0; const unsigned long long rt_entry = STAMP ? (unsigned long long)wall_clock64() : 0ull;
#define PG8_STAMP() do { if (STAMP && wid == 0 && nts < 64) { const unsigned long long _c = (unsigned long long)clock64(); \
        ts_lo = (lane == nts) ? (int)(unsigned)_c : ts_lo; ts_hi = (lane == nts) ? (int)(unsigned)(_c >> 32) : ts_hi; ++nts; } } while (0)
    PG8_STAMP();
    unsigned voffA[2], voffB[2];
#pragma unroll
    for (int i = 0; i < 2; ++i) { int R, C; stage_rc(tid * 16 + i * 8192, R, C); const int Rb = Epi::PERM ? ((R & ~31) + perm32(R & 31)) : R;
        voffA[i] = (unsigned)(R * K + C) * 2u; voffB[i] = (unsigned)(Rb * K + C) * 2u; }
    const size_t kstep = (size_t)(BK * 2);
    const size_t hstep = (size_t)HALF * K * 2;
    const size_t tstep = 2 * hstep;
    const unsigned ldsw = (unsigned)wid * 1024u;
    const int aoff = lds_byte(wr * 64 + fr, fq * 8), boff = lds_byte(wc * 32 + fr, fq * 8);
#define PG8_SA(b, h) (((b) * 2 + (h)) * HTB)
#define PG8_SB(b, h) ((4 + (b) * 2 + (h)) * HTB)
#define PG8_STAGE(bufoff, gbase, voff) do { _Pragma("unroll") for (int _i = 0; _i < 2; ++_i) \
        __builtin_amdgcn_global_load_lds((const unsigned*)((const char*)(gbase) + (voff)[_i]), (PG8_LAS unsigned*)(lds + (bufoff) + ldsw + _i * 8192), 16, 0, 0); } while (0)
#define PG8_LDA(dst, b, h) do { _Pragma("unroll") for (int m = 0; m < 4; ++m) _Pragma("unroll") for (int k = 0; k < 2; ++k) dst[m][k] = *(const PG8_LAS bf16x8*)(lds + PG8_SA(b, h) + aoff + m * 2048 + k * 1024); } while (0)
#define PG8_LDB(dst, b, h) do { _Pragma("unroll") for (int n = 0; n < 2; ++n) _Pragma("unroll") for (int k = 0; k < 2; ++k) dst[n][k] = *(const PG8_LAS bf16x8*)(lds + PG8_SB(b, h) + boff + n * 2048 + k * 1024); } while (0)
#define PG8_MMA(ai, bj, At, Bt) do { __builtin_amdgcn_s_setprio(1); _Pragma("unroll") for (int m = 0; m < 4; ++m) _Pragma("unroll") for (int n = 0; n < 2; ++n) _Pragma("unroll") for (int k = 0; k < 2; ++k) \
        acc[ai][bj][m][n] = __builtin_amdgcn_mfma_f32_16x16x32_bf16(Bt[n][k], At[m][k], acc[ai][bj][m][n], 0, 0, 0); __builtin_amdgcn_s_setprio(0); } while (0)
#define PG8_WAIT_V(n) asm volatile("s_waitcnt vmcnt(" #n ")" ::: "memory")
#define PG8_WAIT_L(n) asm volatile("s_waitcnt lgkmcnt(" #n ")" ::: "memory")
#define PG8_BAR __builtin_amdgcn_s_barrier()
#define PG8_SCHED __builtin_amdgcn_sched_barrier(0)
    Unit cur, nxt; int ui = 0;
    if (!S.next(0, cur)) return;
    f32x4 acc[2][2][4][2];
#pragma unroll
    for (int a = 0; a < 2; ++a)
#pragma unroll
        for (int b = 0; b < 2; ++b)
#pragma unroll
            for (int m = 0; m < 4; ++m)
#pragma unroll
                for (int n = 0; n < 2; ++n) acc[a][b][m][n] = (f32x4){0.f, 0.f, 0.f, 0.f};
    bf16x8 At[4][2], B0[2][2], B1[2][2];
    const char* cA = (const char*)g.A + (size_t)cur.pm * tstep; const char* cB = (const char*)g.Bt + (size_t)cur.pn * tstep;
    S.a_ready(cur);
    PG8_STAGE(PG8_SB(0, 0), cB, voffB); PG8_STAGE(PG8_SA(0, 0), cA, voffA); PG8_STAGE(PG8_SB(0, 1), cB + hstep, voffB); PG8_STAGE(PG8_SA(0, 1), cA + hstep, voffA);
    if (wr == 1) PG8_BAR;
    PG8_WAIT_V(4); PG8_BAR;
    PG8_STAGE(PG8_SB(1, 0), cB + kstep, voffB); PG8_STAGE(PG8_SA(1, 0), cA + kstep, voffA); PG8_STAGE(PG8_SB(1, 1), cB + hstep + kstep, voffB);
    PG8_WAIT_V(6); PG8_BAR;
    PG8_STAMP();
    for (;;) {
        const bool has_next = S.next(ui + 1, nxt);
        const char* nA = has_next ? (const char*)g.A + (size_t)nxt.pm * tstep : cA; const char* nB = has_next ? (const char*)g.Bt + (size_t)nxt.pn * tstep : cB;
        for (int t = 0; t < nt; t += 2) {
            const bool last = (t == nt - 2);
            const char* a1 = cA + (size_t)(t + 1) * kstep;
            const char* a2 = last ? nA : cA + (size_t)(t + 2) * kstep; const char* b2 = last ? nB : cB + (size_t)(t + 2) * kstep;
            const char* a3 = a2 + kstep; const char* b3 = b2 + kstep;
            if (last && has_next) S.a_ready(nxt);
            PG8_LDB(B0, 0, 0); PG8_SCHED; PG8_LDA(At, 0, 0); PG8_STAGE(PG8_SA(1, 1), a1 + hstep, voffA);
            PG8_WAIT_L(8); PG8_BAR; PG8_WAIT_L(0); PG8_MMA(0, 0, At, B0); PG8_BAR; PG8_SCHED;
            PG8_LDB(B1, 0, 1); PG8_STAGE(PG8_SB(0, 0), b2, voffB);
            PG8_BAR; PG8_WAIT_L(0); PG8_MMA(0, 1, At, B1); PG8_BAR;
            PG8_LDA(At, 0, 1); PG8_STAGE(PG8_SA(0, 0), a2, voffA);
            PG8_BAR; PG8_WAIT_L(0); PG8_MMA(1, 0, At, B0); PG8_BAR; PG8_SCHED;
            PG8_STAGE(PG8_SB(0, 1), b2 + hstep, voffB);
            PG8_WAIT_V(6); PG8_BAR; PG8_MMA(1, 1, At, B1); PG8_BAR;
            PG8_LDB(B0, 1, 0); PG8_SCHED; PG8_LDA(At, 1, 0); PG8_STAGE(PG8_SA(0, 1), a2 + hstep, voffA);
            PG8_WAIT_L(8); PG8_BAR; PG8_WAIT_L(0); PG8_MMA(0, 0, At, B0); PG8_BAR; PG8_SCHED;
            PG8_LDB(B1, 1, 1); PG8_STAGE(PG8_SB(1, 0), b3, voffB);
            PG8_BAR; PG8_WAIT_L(0); PG8_MMA(0, 1, At, B1); PG8_BAR;
            PG8_LDA(At, 1, 1); PG8_STAGE(PG8_SA(1, 0), a3, voffA);
            PG8_BAR; PG8_WAIT_L(0); PG8_MMA(1, 0, At, B0); PG8_BAR; PG8_SCHED;
            PG8_STAGE(PG8_SB(1, 1), b3 + hstep, voffB);
            PG8_WAIT_V(6); PG8_BAR; PG8_MMA(1, 1, At, B1); PG8_BAR;
        }
        PG8_STAMP();
        if constexpr (!Epi::AFTER_DRAIN) { E(acc, cur, wr, wc, fr, fq); S.done(cur); }
        PG8_STAMP();
        if (!has_next) break;
#pragma unroll
        for (int a = 0; a < 2; ++a)
#pragma unroll
            for (int b = 0; b < 2; ++b)
#pragma unroll
                for (int m = 0; m < 4; ++m)
#pragma unroll
                    for (int n = 0; n < 2; ++n) acc[a][b][m][n] = (f32x4){0.f, 0.f, 0.f, 0.f};
        cur = nxt; cA = nA; cB = nB; ++ui;
    }
    PG8_WAIT_V(0);
    if (wr == 0) PG8_BAR;
    PG8_BAR;
    if constexpr (Epi::AFTER_DRAIN) { E.fused(acc, cur, wr, wc, fr, fq, lds, wid, lane); S.done(cur); }
    PG8_STAMP();
    if (STAMP && wid == 0) { stamps[lane] = lane < nts ? (((unsigned long long)(unsigned)ts_hi << 32) | (unsigned)ts_lo) : 0ull;
        if (lane == 62) stamps[62] = rt_entry; if (lane == 63) stamps[63] = (unsigned long long)wall_clock64(); }
#undef PG8_STAMP
#undef PG8_SA
#undef PG8_SB
#undef PG8_STAGE
#undef PG8_LDA
#undef PG8_LDB
#undef PG8_MMA
#undef PG8_WAIT_V
#undef PG8_WAIT_L
#undef PG8_BAR
#undef PG8_SCHED
}
}


#include <hip/hip_cooperative_groups.h>
#include <cstdio>
namespace cg = cooperative_groups;
#define LAS __attribute__((address_space(3)))
typedef unsigned short bf16_t;
typedef short bf16x8 __attribute__((ext_vector_type(8)));
typedef short s16x4 __attribute__((ext_vector_type(4)));
typedef float f32x4 __attribute__((ext_vector_type(4)));
typedef float f32x2 __attribute__((ext_vector_type(2)));
typedef float f32x16 __attribute__((ext_vector_type(16)));
typedef unsigned u32x4 __attribute__((ext_vector_type(4)));
typedef unsigned u32x2 __attribute__((ext_vector_type(2)));

#ifndef N_LAUNCH_MODE
#define N_LAUNCH_MODE 0
#endif

constexpr int T_ = 32768, DM = 1024, NBAT = 8, SEQ = 4096;
constexpr float EPS = 1e-6f;
constexpr int NPHASE = 22;
constexpr size_t LDS_BYTES = 163840;

constexpr size_t al256(size_t x) { return (x + 255) / 256 * 256; }
constexpr size_t WS_WINE  = 0;
constexpr size_t WS_WUP   = WS_WINE  + al256((size_t)2 * 2560 * 1024 * 2);
constexpr size_t WS_WOUTE = WS_WUP   + al256((size_t)2 * 1792 * 384 * 2);
constexpr size_t WS_WINO  = WS_WOUTE + al256((size_t)2 * 1024 * 1024 * 2);
constexpr size_t WS_WOUTO = WS_WINO  + al256((size_t)2 * 6144 * 1024 * 2);
constexpr size_t WS_WS    = WS_WOUTO + al256((size_t)2 * 1024 * 2048 * 2);
constexpr size_t WS_MOD   = WS_WS    + al256((size_t)2 * 8 * 128 * 128 * 2);
constexpr size_t WS_ROPE  = WS_MOD   + al256((size_t)4 * 8 * 3072 * 4);
constexpr size_t WS_RS    = WS_ROPE  + al256((size_t)T_ * 32 * 8);
constexpr size_t WS_EV    = WS_RS    + al256((size_t)T_ * 2 * 4);
constexpr size_t WS_PART  = WS_EV    + al256((size_t)4096 * 64 * 4);
constexpr size_t WS_H     = WS_PART  + al256((size_t)T_ * 32 * 8);
constexpr size_t WS_R2    = WS_H     + al256((size_t)T_ * 1024 * 2);
constexpr size_t WS_GQ    = WS_R2;
constexpr size_t WS_GK    = WS_GQ   + (size_t)T_ * 256 * 2;
constexpr size_t WS_GV    = WS_GK   + (size_t)T_ * 256 * 2;
constexpr size_t WS_GZ    = WS_GV   + (size_t)T_ * 512 * 2;
constexpr size_t WS_MZ    = WS_GZ   + (size_t)T_ * 512 * 2;
constexpr size_t WS_CQKV  = WS_MZ   + (size_t)T_ * 512 * 2;
constexpr size_t WS_KR    = WS_CQKV + (size_t)T_ * 384 * 2;
constexpr size_t WS_GA    = WS_KR   + (size_t)T_ * 64 * 2;
constexpr size_t WS_Q     = WS_GA   + (size_t)T_ * 32 * 4;
constexpr size_t WS_K     = WS_Q    + (size_t)T_ * 4 * 192 * 2;
constexpr size_t WS_V     = WS_K    + (size_t)T_ * 4 * 192 * 2;
constexpr size_t WS_ST    = WS_V    + (size_t)T_ * 4 * 128 * 2;
constexpr size_t WS_EVEN_END = WS_ST + (size_t)4096 * 8192 * 2;
constexpr size_t WS_YE    = WS_Q;
constexpr size_t WS_UZ    = WS_R2;
constexpr size_t WS_V2    = WS_UZ   + (size_t)T_ * 2048 * 2;
constexpr size_t WS_YO    = WS_V2;
constexpr size_t WS_ODD_END = WS_V2 + (size_t)T_ * 2048 * 2;
constexpr size_t WS_TOTAL = WS_EVEN_END > WS_ODD_END ? WS_EVEN_END : WS_ODD_END;
static_assert(WS_Q + (size_t)T_ * 1024 * 4 == WS_ST, "Y_even must cover exactly Q|K|V");

struct Params { const float* in[24]; float* out; unsigned char* ws; int ph_lo, ph_hi; };
enum { I_X = 0, I_C, I_POS, I_WMOD, I_BMOD, I_GPRE, I_GPOST, I_WINE, I_W2F, I_B2F, I_W2B, I_B2B, I_GNORM, I_GQ, I_WUQ, I_GKV, I_WUKV, I_WOUTE,
       I_WINO, I_SGG, I_SGB, I_SGW, I_SGBS, I_WOUTO };

typedef __bf16 bf16v2 __attribute__((ext_vector_type(2)));
__device__ __forceinline__ unsigned cvtpk(float lo, float hi) { const f32x2 v = {lo, hi}; return __builtin_bit_cast(unsigned, __builtin_convertvector(v, bf16v2)); }
__device__ __forceinline__ float bflo(unsigned w) { return __uint_as_float(w << 16); }
__device__ __forceinline__ float bfhi(unsigned w) { return __uint_as_float(w & 0xffff0000u); }
__device__ __forceinline__ float bf2f(unsigned short b) { return __uint_as_float(((unsigned)b) << 16); }
__device__ __forceinline__ int tid_fresh() { int t = threadIdx.x; asm volatile("" : "+v"(t)); return t; }
__device__ __forceinline__ float wave_sum(float v) {
#pragma unroll
    for (int o = 32; o >= 1; o >>= 1) v += __shfl_xor(v, o);
    return v; }
__device__ __forceinline__ float silu_f(float z) { return z * __builtin_amdgcn_rcpf(1.0f + __expf(-z)); }
__device__ __forceinline__ float logsig_f(float x) { return fminf(x, 0.f) - __logf(1.0f + __expf(-fabsf(x))); }
__device__ __forceinline__ void unpack8(const u32x4 w, float (&f)[8]) {
    f[0] = bflo(w.x); f[1] = bfhi(w.x); f[2] = bflo(w.y); f[3] = bfhi(w.y); f[4] = bflo(w.z); f[5] = bfhi(w.z); f[6] = bflo(w.w); f[7] = bfhi(w.w); }
__device__ __forceinline__ u32x4 pack8(const float (&f)[8]) { u32x4 w; w.x = cvtpk(f[0], f[1]); w.y = cvtpk(f[2], f[3]); w.z = cvtpk(f[4], f[5]); w.w = cvtpk(f[6], f[7]); return w; }
#define MFMA16(a, b, c) __builtin_amdgcn_mfma_f32_16x16x32_bf16((a), (b), (c), 0, 0, 0)

__device__ __forceinline__ int map_even_col(int n) {
    if (n < 1024) return n;
    if (n < 1536) return n - 1024 + 1056;
    if (n < 2048) return n - 1536 + 2016;
    if (n < 2304) return n - 2048 + 1568;
    if (n < 2432) return n - 2304 + 1824;
    if (n < 2496) return n - 2432 + 1952;
    if (n < 2528) return n - 2496 + 1024;
    return -1; }
__device__ __forceinline__ int map_q_col(int n) {
    const int hh = n / 192, j = n - hh * 192;
    if (j < 128) return n;
    const int jj = j - 128, g8 = jj >> 3, w = jj & 7;
    return hh * 192 + 128 + ((w < 4) ? (4 * g8 + w) : (32 + 4 * g8 + (w - 4))); }
__device__ __forceinline__ int map_odd_col(int n) {
    const int pn = n >> 8;
    if (pn < 16) { const int half = (n >> 7) & 1, idx = n & 127; return (half ? 4096 : 0) + 128 * pn + idx; }
    return 2048 + (n - 4096); }

template <int MAT> __device__ __forceinline__ float prep_val(const Params& p, int e, int n, int k) {
    if (MAT == 0) { const int sc = map_even_col(n); return sc < 0 ? 0.f : p.in[I_WINE][((size_t)e * 1024 + k) * 2528 + sc]; }
    if (MAT == 1) {
        if (n < 768) { if (k >= 256) return 0.f; return p.in[I_GQ][e * 256 + k] * p.in[I_WUQ][((size_t)e * 256 + k) * 768 + map_q_col(n)]; }
        if (k < 256) return 0.f; const int kk = k - 256;
        return p.in[I_GKV][e * 128 + kk] * p.in[I_WUKV][((size_t)e * 128 + kk) * 1024 + (n - 768)]; }
    if (MAT == 2) return p.in[I_WOUTE][((size_t)e * 1024 + k) * 1024 + n];
    if (MAT == 3) return p.in[I_WINO][((size_t)e * 1024 + k) * 6144 + map_odd_col(n)];
    return p.in[I_WOUTO][((size_t)e * 2048 + k) * 1024 + n];
}
template <int MAT> __device__ __forceinline__ void prep_tile(const Params& p, LAS float* tl, bf16_t* dst, int K, int e, int n0, int k0) {
    const int tid = tid_fresh(), nl = tid & 63, kl = tid >> 6;
#pragma unroll
    for (int r = 0; r < 8; ++r) { const int k = kl + 8 * r; tl[k * 65 + nl] = prep_val<MAT>(p, e, n0 + nl, k0 + k); }
    __syncthreads();
    const int nl2 = tid >> 3, kg = tid & 7; float v[8];
#pragma unroll
    for (int q = 0; q < 8; ++q) v[q] = tl[(8 * kg + q) * 65 + nl2];
    *(u32x4*)(dst + (size_t)(n0 + nl2) * K + k0 + 8 * kg) = pack8(v);
    __syncthreads();
}

__device__ __forceinline__ void p0_phase(const Params& p, LAS unsigned char* lds) {
    const int tid = tid_fresh();
    unsigned char* ws = p.ws;
    constexpr int N_MOD = 192, N_ROPE = 256, N_WS = 64;
    constexpr int T0 = N_MOD + N_ROPE + N_WS;
    constexpr int T1 = T0 + 2 * 40 * 16;
    constexpr int T2 = T1 + 2 * 28 * 6;
    constexpr int T3 = T2 + 2 * 16 * 16;
    constexpr int T4 = T3 + 2 * 96 * 16;
    constexpr int T5 = T4 + 2 * 16 * 32;
    LAS float* tl = (LAS float*)lds;
    for (int it = blockIdx.x; it < T5; it += gridDim.x) {
        if (it < N_MOD) {
            const int l = it / 48, jc = it % 48;
            LAS float* sc = (LAS float*)lds;
            LAS float* red = (LAS float*)(lds + 32768);
            for (int i = tid; i < 8192; i += 512) { const float cv = p.in[I_C][i]; sc[i] = silu_f(cv); }
            __syncthreads();
            const int cgp = tid & 15, kg = tid >> 4;
            float acc[8][4];
#pragma unroll
            for (int b = 0; b < 8; ++b)
#pragma unroll
                for (int c = 0; c < 4; ++c) acc[b][c] = 0.f;
            const float* wp = p.in[I_WMOD] + ((size_t)l * 1024 + 32 * kg) * 3072 + 64 * jc + 4 * cgp;
#pragma unroll 4
            for (int kk = 0; kk < 32; ++kk) {
                const f32x4 w = *(const f32x4*)(wp + (size_t)kk * 3072);
#pragma unroll
                for (int b = 0; b < 8; ++b) { const float s = sc[b * 1024 + 32 * kg + kk];
#pragma unroll
                    for (int c = 0; c < 4; ++c) acc[b][c] += s * w[c]; } }
#pragma unroll
            for (int b = 0; b < 8; ++b)
#pragma unroll
                for (int c = 0; c < 4; ++c) red[(kg * 8 + b) * 64 + 4 * cgp + c] = acc[b][c];
            __syncthreads();
            { const int b = tid >> 6, col = tid & 63; float s = p.in[I_BMOD][l * 3072 + 64 * jc + col];
              for (int q = 0; q < 32; ++q) s += red[(q * 8 + b) * 64 + col];
              ((float*)(ws + WS_MOD))[((size_t)l * 8 + b) * 3072 + 64 * jc + col] = s; }
            __syncthreads();
        } else if (it < N_MOD + N_ROPE) {
            const int r0 = (it - N_MOD) * 4096;
            for (int i = tid; i < 4096; i += 512) { const int idx = r0 + i, row = idx >> 5, fi = idx & 31;
                const float pos = (float)((const int*)p.in[I_POS])[row];
                const float inv = 1.0f / powf(10000.0f, (float)(2 * fi) * (1.0f / 64.0f));
                const float ang = pos * inv; f32x2 cs; cs.x = cosf(ang); cs.y = sinf(ang);
                ((f32x2*)(ws + WS_ROPE))[idx] = cs; }
        } else if (it < T0) {
            const int r0 = (it - N_MOD - N_ROPE) * 4096;
            for (int i = tid; i < 2048; i += 512) { const int idx = r0 + 2 * i; const f32x2 v = *(const f32x2*)(p.in[I_SGW] + idx);
                ((unsigned*)(ws + WS_WS))[idx >> 1] = cvtpk(v.x, v.y); }
        } else if (it < T1) { const int q = it - T0, e = q / 640, r = q % 640, nt = r / 16, kt = r % 16;
            prep_tile<0>(p, tl, (bf16_t*)(ws + WS_WINE) + (size_t)e * 2560 * 1024, 1024, e, nt * 64, kt * 64);
        } else if (it < T2) { const int q = it - T1, e = q / 168, r = q % 168, nt = r / 6, kt = r % 6;
            prep_tile<1>(p, tl, (bf16_t*)(ws + WS_WUP) + (size_t)e * 1792 * 384, 384, e, nt * 64, kt * 64);
        } else if (it < T3) { const int q = it - T2, e = q / 256, r = q % 256, nt = r / 16, kt = r % 16;
            prep_tile<2>(p, tl, (bf16_t*)(ws + WS_WOUTE) + (size_t)e * 1024 * 1024, 1024, e, nt * 64, kt * 64);
        } else if (it < T4) { const int q = it - T3, e = q / 1536, r = q % 1536, nt = r / 16, kt = r % 16;
            prep_tile<3>(p, tl, (bf16_t*)(ws + WS_WINO) + (size_t)e * 6144 * 1024, 1024, e, nt * 64, kt * 64);
        } else { const int q = it - T4, e = q / 512, r = q % 512, nt = r / 32, kt = r % 32;
            prep_tile<4>(p, tl, (bf16_t*)(ws + WS_WOUTO) + (size_t)e * 1024 * 2048, 2048, e, nt * 64, kt * 64);
        }
    }
}

__device__ __forceinline__ void norm_phase(const Params& p, int l_post, int l_pre, const float* y, const float* xin) {
    const int tid = tid_fresh(), lane = tid & 63, wave = tid >> 6;
    const float* mod = (const float*)(p.ws + WS_MOD);
    bf16_t* H = (bf16_t*)(p.ws + WS_H);
    for (int row = blockIdx.x * 8 + wave; row < T_; row += gridDim.x * 8) {
        const int b = row >> 12;
        f32x4 xv[4];
#pragma unroll
        for (int i = 0; i < 4; ++i) xv[i] = *(const f32x4*)(xin + (size_t)row * 1024 + 256 * i + 4 * lane);
        if (l_post >= 0) {
            f32x4 yv[4]; float ss = 0.f;
#pragma unroll
            for (int i = 0; i < 4; ++i) { yv[i] = *(const f32x4*)(y + (size_t)row * 1024 + 256 * i + 4 * lane); ss += yv[i][0] * yv[i][0] + yv[i][1] * yv[i][1] + yv[i][2] * yv[i][2] + yv[i][3] * yv[i][3]; }
            ss = wave_sum(ss); const float rs = rsqrtf(ss * (1.0f / 1024.0f) + EPS);
            const float* gate = mod + ((size_t)l_post * 8 + b) * 3072 + 2048; const float* gp = p.in[I_GPOST] + l_post * 1024;
#pragma unroll
            for (int i = 0; i < 4; ++i) { const f32x4 g = *(const f32x4*)(gate + 256 * i + 4 * lane), w = *(const f32x4*)(gp + 256 * i + 4 * lane);
                xv[i] = xv[i] + g * (yv[i] * rs * w);
#ifdef DEBUG_SANITIZE
                if (l_post == 3) { for (int q = 0; q < 4; ++q) if (!(fabsf(xv[i][q]) < 1e30f)) xv[i][q] = 12345.f; }
#endif
                *(f32x4*)(p.out + (size_t)row * 1024 + 256 * i + 4 * lane) = xv[i]; }
        }
        if (l_pre >= 0) {
            float ss = 0.f;
#pragma unroll
            for (int i = 0; i < 4; ++i) ss += xv[i][0] * xv[i][0] + xv[i][1] * xv[i][1] + xv[i][2] * xv[i][2] + xv[i][3] * xv[i][3];
            ss = wave_sum(ss); const float rs = rsqrtf(ss * (1.0f / 1024.0f) + EPS);
            const float* sh = mod + ((size_t)l_pre * 8 + b) * 3072; const float* sc = sh + 1024; const float* gp = p.in[I_GPRE] + l_pre * 1024;
#pragma unroll
            for (int i = 0; i < 4; ++i) { const f32x4 s0 = *(const f32x4*)(sh + 256 * i + 4 * lane), s1 = *(const f32x4*)(sc + 256 * i + 4 * lane), w = *(const f32x4*)(gp + 256 * i + 4 * lane);
                const f32x4 hv = (xv[i] * rs * w) * (s1 + 1.0f) + s0; u32x2 o; o.x = cvtpk(hv[0], hv[1]); o.y = cvtpk(hv[2], hv[3]);
                *(u32x2*)(H + (size_t)row * 1024 + 256 * i + 4 * lane) = o; }
        }
    }
}

struct EpiEvenIn {
    static constexpr bool PERM = true, AFTER_DRAIN = false;
    unsigned char* ws;
    __device__ __forceinline__ void operator()(const f32x4 (&acc)[2][2][4][2], const pg8::Unit& u, int wr, int wc, int fr_, int fq_) const {
        int fr = fr_, fq = fq_; asm volatile("" : "+v"(fr), "+v"(fq));
        const int row0 = u.pm * 256 + wr * 64 + fr, pn = u.pn, cu = 32 * wc + 8 * fq;
        if (pn < 9) {
            bf16_t* base; int ld;
            if (pn == 0) { base = (bf16_t*)(ws + WS_GQ); ld = 256; }
            else if (pn == 1) { base = (bf16_t*)(ws + WS_GK); ld = 256; }
            else if (pn < 4) { base = (bf16_t*)(ws + WS_GV) + (pn - 2) * 256; ld = 512; }
            else if (pn < 6) { base = (bf16_t*)(ws + WS_GZ) + (pn - 4) * 256; ld = 512; }
            else if (pn < 8) { base = (bf16_t*)(ws + WS_MZ) + (pn - 6) * 256; ld = 512; }
            else { base = (bf16_t*)(ws + WS_CQKV); ld = 384; }
#pragma unroll
            for (int ai = 0; ai < 2; ++ai)
#pragma unroll
                for (int m = 0; m < 4; ++m) { bf16_t* rowp = base + (size_t)(row0 + ai * 128 + m * 16) * ld + cu;
#pragma unroll
                    for (int bj = 0; bj < 2; ++bj) { const f32x4 v0 = acc[ai][bj][m][0], v1 = acc[ai][bj][m][1];
                        u32x4 w; w.x = cvtpk(v0[0], v0[1]); w.y = cvtpk(v0[2], v0[3]); w.z = cvtpk(v1[0], v1[1]); w.w = cvtpk(v1[2], v1[3]);
                        *(u32x4*)(rowp + bj * 128) = w; } }
        } else {
            bf16_t* cq = (bf16_t*)(ws + WS_CQKV); bf16_t* kr = (bf16_t*)(ws + WS_KR); float* ga = (float*)(ws + WS_GA);
#pragma unroll
            for (int ai = 0; ai < 2; ++ai)
#pragma unroll
                for (int m = 0; m < 4; ++m) { const size_t row = (size_t)(row0 + ai * 128 + m * 16);
                    { const f32x4 v0 = acc[ai][0][m][0], v1 = acc[ai][0][m][1];
                      u32x4 w; w.x = cvtpk(v0[0], v0[1]); w.y = cvtpk(v0[2], v0[3]); w.z = cvtpk(v1[0], v1[1]); w.w = cvtpk(v1[2], v1[3]);
                      *(u32x4*)(cq + row * 384 + 256 + cu) = w; }
                    { const f32x4 v0 = acc[ai][1][m][0], v1 = acc[ai][1][m][1];
                      if (wc < 2) { u32x4 w; w.x = cvtpk(v0[0], v0[1]); w.y = cvtpk(v0[2], v0[3]); w.z = cvtpk(v1[0], v1[1]); w.w = cvtpk(v1[2], v1[3]);
                          *(u32x4*)(kr + row * 64 + cu) = w; }
                      else if (wc == 2) { *(f32x4*)(ga + row * 32 + 8 * fq) = v0; *(f32x4*)(ga + row * 32 + 8 * fq + 4) = v1; } } }
        }
    }
};
struct EpiUp {
    static constexpr bool PERM = true, AFTER_DRAIN = false;
    unsigned char* ws;
    __device__ __forceinline__ void operator()(const f32x4 (&acc)[2][2][4][2], const pg8::Unit& u, int wr, int wc, int fr_, int fq_) const {
        int fr = fr_, fq = fq_; asm volatile("" : "+v"(fr), "+v"(fq));
        const int row0 = u.pm * 256 + wr * 64 + fr, pn = u.pn;
        bf16_t* Q = (bf16_t*)(ws + WS_Q); bf16_t* K = (bf16_t*)(ws + WS_K); bf16_t* V = (bf16_t*)(ws + WS_V);
        const float* RS = (const float*)(ws + WS_RS); const f32x2* ROPE = (const f32x2*)(ws + WS_ROPE);
#pragma unroll
        for (int ai = 0; ai < 2; ++ai)
#pragma unroll
            for (int m = 0; m < 4; ++m) { const int row = row0 + ai * 128 + m * 16, b = row >> 12, s = row & 4095;
                const f32x2 rs = *(const f32x2*)(RS + 2 * (size_t)row);
#pragma unroll
                for (int bj = 0; bj < 2; ++bj) { f32x4 v0 = acc[ai][bj][m][0], v1 = acc[ai][bj][m][1];
                    if (pn < 3) {
                        v0 = v0 * rs.x; v1 = v1 * rs.x;
                        const int n = 256 * pn + 128 * bj + 32 * wc + 8 * fq, hh = n / 192, j = n - hh * 192;
                        bf16_t* qrow = Q + ((size_t)(b * 4 + hh) * 4096 + s) * 192;
                        if (j < 128) { u32x4 w; w.x = cvtpk(v0[0], v0[1]); w.y = cvtpk(v0[2], v0[3]); w.z = cvtpk(v1[0], v1[1]); w.w = cvtpk(v1[2], v1[3]);
                            *(u32x4*)(qrow + j) = w; }
                        else { const int i0 = (j - 128) >> 1;
                            const f32x4 c01 = *(const f32x4*)(ROPE + (size_t)row * 32 + i0), c23 = *(const f32x4*)(ROPE + (size_t)row * 32 + i0 + 2);
                            const float cs[4] = {c01[0], c01[2], c23[0], c23[2]}, sn[4] = {c01[1], c01[3], c23[1], c23[3]};
                            float o1[4], o2[4];
#pragma unroll
                            for (int q = 0; q < 4; ++q) { o1[q] = v0[q] * cs[q] - v1[q] * sn[q]; o2[q] = v1[q] * cs[q] + v0[q] * sn[q]; }
                            u32x2 w1, w2; w1.x = cvtpk(o1[0], o1[1]); w1.y = cvtpk(o1[2], o1[3]); w2.x = cvtpk(o2[0], o2[1]); w2.y = cvtpk(o2[2], o2[3]);
                            *(u32x2*)(qrow + 128 + i0) = w1; *(u32x2*)(qrow + 160 + i0) = w2; }
                    } else {
                        v0 = v0 * rs.y; v1 = v1 * rs.y; const int hh = pn - 3, jj = 32 * wc + 8 * fq;
                        u32x4 w; w.x = cvtpk(v0[0], v0[1]); w.y = cvtpk(v0[2], v0[3]); w.z = cvtpk(v1[0], v1[1]); w.w = cvtpk(v1[2], v1[3]);
                        if (bj == 0) *(u32x4*)(K + ((size_t)(b * 4 + hh) * 4096 + s) * 192 + jj) = w;
                        else         *(u32x4*)(V + ((size_t)(b * 4 + hh) * 4096 + s) * 128 + jj) = w;
                    } }
                asm volatile("" ::: "memory"); }
    }
};
struct EpiOddIn {
    static constexpr bool PERM = true, AFTER_DRAIN = false;
    unsigned char* ws;
    __device__ __forceinline__ void operator()(const f32x4 (&acc)[2][2][4][2], const pg8::Unit& u, int wr, int wc, int fr_, int fq_) const {
        int fr = fr_, fq = fq_; asm volatile("" : "+v"(fr), "+v"(fq));
        const int row0 = u.pm * 256 + wr * 64 + fr, pn = u.pn, cu = 32 * wc + 8 * fq;
        typedef float f2 __attribute__((ext_vector_type(2)));
        if (pn < 16) {
            bf16_t* UZ = (bf16_t*)(ws + WS_UZ);
#pragma unroll
            for (int ai = 0; ai < 2; ++ai)
#pragma unroll
                for (int m = 0; m < 4; ++m) { const size_t row = (size_t)(row0 + ai * 128 + m * 16); float o[8];
#pragma unroll
                    for (int n = 0; n < 2; ++n) { const f32x4 uu = acc[ai][0][m][n], zz = acc[ai][1][m][n];
                        const f2 ga = pg8::gelu_pk((f2){uu[0], uu[1]}), gb = pg8::gelu_pk((f2){uu[2], uu[3]});
                        o[4 * n + 0] = ga.x * silu_f(zz[0]); o[4 * n + 1] = ga.y * silu_f(zz[1]); o[4 * n + 2] = gb.x * silu_f(zz[2]); o[4 * n + 3] = gb.y * silu_f(zz[3]); }
                    *(u32x4*)(UZ + row * 2048 + 128 * pn + cu) = pack8(o); }
        } else {
            bf16_t* V2 = (bf16_t*)(ws + WS_V2); f32x2* PART = (f32x2*)(ws + WS_PART);
#pragma unroll
            for (int ai = 0; ai < 2; ++ai)
#pragma unroll
                for (int m = 0; m < 4; ++m) { const size_t row = (size_t)(row0 + ai * 128 + m * 16); float s = 0.f, ss = 0.f;
#pragma unroll
                    for (int bj = 0; bj < 2; ++bj) { float o[8];
#pragma unroll
                        for (int n = 0; n < 2; ++n) { const f32x4 vv = acc[ai][bj][m][n];
                            const f2 ga = pg8::gelu_pk((f2){vv[0], vv[1]}), gb = pg8::gelu_pk((f2){vv[2], vv[3]});
                            o[4 * n + 0] = ga.x; o[4 * n + 1] = ga.y; o[4 * n + 2] = gb.x; o[4 * n + 3] = gb.y; }
#pragma unroll
                        for (int q = 0; q < 8; ++q) { s += o[q]; ss += o[q] * o[q]; }
                        *(u32x4*)(V2 + row * 2048 + 256 * (pn - 16) + 128 * bj + cu) = pack8(o); }
                    s += __shfl_xor(s, 16); ss += __shfl_xor(ss, 16); s += __shfl_xor(s, 32); ss += __shfl_xor(ss, 32);
                    if (fq == 0) PART[row * 32 + (pn - 16) * 4 + wc] = (f32x2){s, ss}; }
        }
    }
};

__device__ __forceinline__ void rs_rope_phase(const Params& p) {
    const int tid = tid_fresh(), lane = tid & 63, wave = tid >> 6;
    unsigned char* ws = p.ws;
    const bf16_t* CQKV = (const bf16_t*)(ws + WS_CQKV); const bf16_t* KR = (const bf16_t*)(ws + WS_KR);
    float* RS = (float*)(ws + WS_RS); const f32x2* ROPE = (const f32x2*)(ws + WS_ROPE); bf16_t* K = (bf16_t*)(ws + WS_K);
    for (int row = blockIdx.x * 8 + wave; row < T_; row += gridDim.x * 8) {
        const int b = row >> 12, s = row & 4095;
        const u32x2 a = *(const u32x2*)(CQKV + (size_t)row * 384 + 4 * lane); const unsigned c = *(const unsigned*)(CQKV + (size_t)row * 384 + 256 + 2 * lane);
        float sq = bflo(a.x) * bflo(a.x) + bfhi(a.x) * bfhi(a.x) + bflo(a.y) * bflo(a.y) + bfhi(a.y) * bfhi(a.y);
        float sk = bflo(c) * bflo(c) + bfhi(c) * bfhi(c);
        sq = wave_sum(sq); sk = wave_sum(sk);
        if (lane == 0) { f32x2 o; o.x = rsqrtf(sq * (1.0f / 256.0f) + EPS); o.y = rsqrtf(sk * (1.0f / 128.0f) + EPS); *(f32x2*)(RS + 2 * (size_t)row) = o; }
        if (lane < 32) { const float x1 = bf2f(KR[(size_t)row * 64 + lane]), x2 = bf2f(KR[(size_t)row * 64 + 32 + lane]); const f32x2 cs = ROPE[(size_t)row * 32 + lane];
            const float o1 = x1 * cs.x - x2 * cs.y, o2 = x2 * cs.x + x1 * cs.y; const unsigned w1 = cvtpk(o1, o1), w2 = cvtpk(o2, o2);
#pragma unroll
            for (int h = 0; h < 4; ++h) { bf16_t* kp = K + ((size_t)(b * 4 + h) * 4096 + s) * 192 + 128; kp[lane] = (bf16_t)(w1 & 0xffff); kp[32 + lane] = (bf16_t)(w2 & 0xffff); } }
    }
}

constexpr int GL_QF = 0, GL_KF = 9216, GL_QB = 18432, GL_KB = 27648, GL_VT = 36864, GL_ATT = 55296, GL_GRP = 64512, GL_W2 = 129024, GL_B2 = 137216, GL_ROW = 144;
static_assert(GL_B2 + 512 <= LDS_BYTES, "gla lds");

__device__ __forceinline__ void gla_stage_w2(const Params& p, int e, int h, LAS unsigned char* lds) {
    LAS float* W2L = (LAS float*)(lds + GL_W2); LAS float* B2L = (LAS float*)(lds + GL_B2);
    const int tid = tid_fresh();
    for (int idx = tid; idx < 2048; idx += 512) { const int dir = idx >> 10, d = (idx >> 4) & 63, r = idx & 15;
        W2L[idx] = p.in[dir ? I_W2B : I_W2F][((size_t)e * 16 + r) * 256 + h * 64 + d]; }
    if (tid < 128) { const int dir = tid >> 6, d = tid & 63; B2L[tid] = p.in[dir ? I_B2B : I_B2F][e * 256 + h * 64 + d]; }
}
__device__ __forceinline__ void gla_stage_vt(const Params& p, int b, int h, int chunk, LAS unsigned char* G, int gt) {
    const bf16_t* GV = (const bf16_t*)(p.ws + WS_GV);
    const int tp = gt & 31, cg0 = gt >> 5; const size_t tokA = (size_t)b * 4096 + chunk * 64 + 2 * tp;
#pragma unroll
    for (int i = 0; i < 2; ++i) { const int c0 = 8 * (cg0 + 8 * i);
        const u32x4 ra = *(const u32x4*)(GV + tokA * 512 + h * 128 + c0), rb = *(const u32x4*)(GV + (tokA + 1) * 512 + h * 128 + c0);
        const unsigned wa[4] = {ra.x, ra.y, ra.z, ra.w}, wb[4] = {rb.x, rb.y, rb.z, rb.w};
#pragma unroll
        for (int q = 0; q < 4; ++q) { const unsigned lo = (wa[q] & 0xffffu) | (wb[q] << 16), hi = (wa[q] >> 16) | (wb[q] & 0xffff0000u);
            *(LAS unsigned*)(G + GL_VT + (c0 + 2 * q) * GL_ROW + 4 * tp) = lo; *(LAS unsigned*)(G + GL_VT + (c0 + 2 * q + 1) * GL_ROW + 4 * tp) = hi; } }
}
template <bool FOR_A>
__device__ __forceinline__ void gla_prep(const Params& p, int e, int b, int h, int chunk, LAS unsigned char* lds, LAS unsigned char* G, int wv, int lane) {
    const LAS float* W2L = (const LAS float*)(lds + GL_W2); const LAS float* B2L = (const LAS float*)(lds + GL_B2);
    const size_t tok = (size_t)b * 4096 + chunk * 64 + lane;
    const float* ga = (const float*)(p.ws + WS_GA) + tok * 32;
    float af[16], ab[16];
#pragma unroll
    for (int q = 0; q < 4; ++q) { const f32x4 x = *(const f32x4*)(ga + 4 * q), y = *(const f32x4*)(ga + 16 + 4 * q);
        af[4 * q] = x[0]; af[4 * q + 1] = x[1]; af[4 * q + 2] = x[2]; af[4 * q + 3] = x[3]; ab[4 * q] = y[0]; ab[4 * q + 1] = y[1]; ab[4 * q + 2] = y[2]; ab[4 * q + 3] = y[3]; }
    float pf[16], pb[16], gbv[16];
#pragma unroll
    for (int dd = 0; dd < 16; ++dd) { const int d = 16 * wv + dd; float xf = B2L[d], xb = B2L[64 + d];
#pragma unroll
        for (int q = 0; q < 4; ++q) { const f32x4 wf = *(const LAS f32x4*)(W2L + d * 16 + 4 * q), wb = *(const LAS f32x4*)(W2L + 1024 + d * 16 + 4 * q);
            xf += af[4 * q] * wf[0] + af[4 * q + 1] * wf[1] + af[4 * q + 2] * wf[2] + af[4 * q + 3] * wf[3];
            xb += ab[4 * q] * wb[0] + ab[4 * q + 1] * wb[1] + ab[4 * q + 2] * wb[2] + ab[4 * q + 3] * wb[3]; }
        pf[dd] = logsig_f(xf) * 0.0625f; gbv[dd] = logsig_f(xb) * 0.0625f; pb[dd] = gbv[dd]; }
#pragma unroll
    for (int off = 1; off < 64; off <<= 1) {
#pragma unroll
        for (int dd = 0; dd < 16; ++dd) { const float tf = __shfl_up(pf[dd], off), tb = __shfl_up(pb[dd], off); if (lane >= off) { pf[dd] += tf; pb[dd] += tb; } } }
#pragma unroll
    for (int dd = 0; dd < 16; ++dd) { const float tot = __shfl(pb[dd], 63); pb[dd] = tot - pb[dd] + gbv[dd]; }
    if (FOR_A) {
        float* EV = (float*)(p.ws + WS_EV);
#pragma unroll
        for (int dd = 0; dd < 16; ++dd) { const float tf = __shfl(pf[dd], 63), tb = __shfl(pb[dd], 0);
            if (lane == 0) { EV[((size_t)((b * 4 + h) * 2 + 0) * 64 + chunk) * 64 + 16 * wv + dd] = __expf(tf); EV[((size_t)((b * 4 + h) * 2 + 1) * 64 + chunk) * 64 + 16 * wv + dd] = __expf(tb); } }
    }
#ifdef DBG_MAXP
    if (FOR_A) { float mx = 0.f;
        for (int dd = 0; dd < 16; ++dd) { mx = fmaxf(mx, DBG_MAXP); }
        atomicMax((int*)(p.ws + WS_PART) + 41, __float_as_int(mx)); }
#endif
    float kv[16], qv[16];
    { const bf16_t* kp = (const bf16_t*)(p.ws + WS_GK) + tok * 256 + h * 64 + 16 * wv; const u32x4 k0 = *(const u32x4*)kp, k1 = *(const u32x4*)(kp + 8);
      float t0[8], t1[8]; unpack8(k0, t0); unpack8(k1, t1);
#pragma unroll
      for (int q = 0; q < 8; ++q) { kv[q] = t0[q]; kv[8 + q] = t1[q]; } }
    if (!FOR_A) { const bf16_t* qp = (const bf16_t*)(p.ws + WS_GQ) + tok * 256 + h * 64 + 16 * wv; const u32x4 q0 = *(const u32x4*)qp, q1 = *(const u32x4*)(qp + 8);
      float t0[8], t1[8]; unpack8(q0, t0); unpack8(q1, t1);
#pragma unroll
      for (int q = 0; q < 8; ++q) { qv[q] = t0[q] * 0.125f; qv[8 + q] = t1[q] * 0.125f; } }
    if (FOR_A) {
#pragma unroll
        for (int dd = 0; dd < 16; ++dd) { const int d = 16 * wv + dd;
#ifdef DBG_NOEXP
            const float kf = kv[dd], kb = kv[dd];
#else
            const float kf = kv[dd] * __expf(-pf[dd]), kb = kv[dd] * __expf(-pb[dd]);
#endif
#ifdef DBG_KEXPR
            { const float vv = DBG_KEXPR; const float mv = (vv != vv) ? 7.7e7f : fabsf(vv); atomicMax((int*)(p.ws + WS_PART) + 41, __float_as_int(mv)); }
#endif

            *(LAS bf16_t*)(G + GL_QF + d * GL_ROW + 2 * lane) = (bf16_t)(cvtpk(kf, kf) & 0xffff);
            *(LAS bf16_t*)(G + GL_KF + d * GL_ROW + 2 * lane) = (bf16_t)(cvtpk(kb, kb) & 0xffff); }
    } else {
        float o[8];
#define GLA_PUT(OFF, EXPR0) do { _Pragma("unroll") for (int hf = 0; hf < 2; ++hf) { _Pragma("unroll") for (int q = 0; q < 8; ++q) { const int dd = 8 * hf + q; o[q] = (EXPR0); } \
            *(LAS u32x4*)(G + (OFF) + lane * GL_ROW + (16 * wv + 8 * hf) * 2) = pack8(o); } } while (0)
        GLA_PUT(GL_QF, qv[dd] * __expf(pf[dd]));
        GLA_PUT(GL_KF, kv[dd] * __expf(-pf[dd]));
        GLA_PUT(GL_QB, qv[dd] * __expf(pb[dd]));
        GLA_PUT(GL_KB, kv[dd] * __expf(-pb[dd]));
#undef GLA_PUT
    }
}

__device__ __forceinline__ void gla_a_phase(const Params& p, int e, LAS unsigned char* lds) {
    const int tid = tid_fresh(), grp = __builtin_amdgcn_readfirstlane(tid >> 8), wv = __builtin_amdgcn_readfirstlane((tid & 255) >> 6);
    LAS unsigned char* G = lds + grp * GL_GRP;
    bf16_t* ST = (bf16_t*)(p.ws + WS_ST);
    for (int it = blockIdx.x; it < 1024; it += gridDim.x) {
        int lane = tid & 63; asm volatile("" : "+v"(lane));
        const int gt = 64 * wv + lane, tq = lane & 15, quad = lane >> 4;
        const int b = it >> 7, h = (it >> 5) & 3, chunk = 2 * (it & 31) + grp;
        __syncthreads();
        gla_stage_w2(p, e, h, lds);
        __syncthreads();
        gla_prep<true>(p, e, b, h, chunk, lds, G, wv, lane);
        gla_stage_vt(p, b, h, chunk, G, gt);
        __syncthreads();
        const int dir = wv >> 1, ch = wv & 1;
        LAS unsigned char* KT = G + (dir ? GL_KF : GL_QF);
        f32x4 acc[4][4];
#pragma unroll
        for (int mb = 0; mb < 4; ++mb)
#pragma unroll
            for (int nb = 0; nb < 4; ++nb) acc[mb][nb] = (f32x4){0.f, 0.f, 0.f, 0.f};
#pragma unroll
        for (int ks = 0; ks < 2; ++ks) { bf16x8 a[4], bb[4];
#pragma unroll
            for (int mb = 0; mb < 4; ++mb) a[mb] = *(const LAS bf16x8*)(KT + (16 * mb + tq) * GL_ROW + (32 * ks + 8 * quad) * 2);
#pragma unroll
            for (int nb = 0; nb < 4; ++nb) bb[nb] = *(const LAS bf16x8*)(G + GL_VT + (64 * ch + 16 * nb + tq) * GL_ROW + (32 * ks + 8 * quad) * 2);
#pragma unroll
            for (int mb = 0; mb < 4; ++mb)
#pragma unroll
                for (int nb = 0; nb < 4; ++nb) acc[mb][nb] = MFMA16(a[mb], bb[nb], acc[mb][nb]); }
        bf16_t* slot = ST + ((size_t)((b * 4 + h) * 2 + dir) * 64 + chunk) * 8192;
#pragma unroll
        for (int mb = 0; mb < 4; ++mb)
#pragma unroll
            for (int nb = 0; nb < 4; ++nb) { const int c = 64 * ch + 16 * nb + tq, d = 16 * mb + 4 * quad; const f32x4 v = acc[mb][nb];
                u32x2 w; w.x = cvtpk(v[0], v[1]); w.y = cvtpk(v[2], v[3]); *(u32x2*)(slot + c * 64 + d) = w; }
    }
}
__device__ __forceinline__ void gla_b_phase(const Params& p) {
    bf16_t* ST = (bf16_t*)(p.ws + WS_ST); const float* EV = (const float*)(p.ws + WS_EV);
    const int tid = tid_fresh();
    for (int e = blockIdx.x * 512 + tid; e < 131072; e += gridDim.x * 512) {
        const int seq = e >> 11, within = e & 2047, dq = within & 15, dir = seq & 1;
        bf16_t* sp = ST + (size_t)seq * 64 * 8192 + within * 4; const float* ep = EV + (size_t)seq * 64 * 64 + dq * 4;
        float S0 = 0.f, S1 = 0.f, S2 = 0.f, S3 = 0.f;
        for (int k0 = 0; k0 < 64; k0 += 8) { u32x2 uu[8]; f32x4 ee[8];
#pragma unroll
            for (int q = 0; q < 8; ++q) { const int ck = dir ? 63 - (k0 + q) : (k0 + q); uu[q] = *(const u32x2*)(sp + (size_t)ck * 8192); ee[q] = *(const f32x4*)(ep + ck * 64); }
#pragma unroll
            for (int q = 0; q < 8; ++q) { const int ck = dir ? 63 - (k0 + q) : (k0 + q);
                u32x2 w; w.x = cvtpk(S0, S1); w.y = cvtpk(S2, S3); *(u32x2*)(sp + (size_t)ck * 8192) = w;
                S0 = ee[q][0] * (S0 + bflo(uu[q].x)); S1 = ee[q][1] * (S1 + bfhi(uu[q].x)); S2 = ee[q][2] * (S2 + bflo(uu[q].y)); S3 = ee[q][3] * (S3 + bfhi(uu[q].y)); } }
    }
}
__device__ __forceinline__ void gla_c_phase(const Params& p, int e, LAS unsigned char* lds) {
    const int tid = tid_fresh(), grp = __builtin_amdgcn_readfirstlane(tid >> 8), wv = __builtin_amdgcn_readfirstlane((tid & 255) >> 6);
    LAS unsigned char* G = lds + grp * GL_GRP;
    const bf16_t* ST = (const bf16_t*)(p.ws + WS_ST); const bf16_t* GZ = (const bf16_t*)(p.ws + WS_GZ); bf16_t* O = (bf16_t*)(p.ws + WS_H);
    for (int it = blockIdx.x; it < 1024; it += gridDim.x) {
        int lane = tid & 63; asm volatile("" : "+v"(lane));
        const int gt = 64 * wv + lane, tq = lane & 15, quad = lane >> 4;
        const int b = it >> 7, h = (it >> 5) & 3, chunk = 2 * (it & 31) + grp;
        __syncthreads();
        gla_stage_w2(p, e, h, lds);
        __syncthreads();
        gla_prep<false>(p, e, b, h, chunk, lds, G, wv, lane);
        gla_stage_vt(p, b, h, chunk, G, gt);
        __syncthreads();
        const int t = 16 * wv + tq;
        {
            f32x4 sf[4], sb[4];
#pragma unroll
            for (int mb = 0; mb < 4; ++mb) { sf[mb] = (f32x4){0.f, 0.f, 0.f, 0.f}; sb[mb] = (f32x4){0.f, 0.f, 0.f, 0.f}; }
#pragma unroll
            for (int ks = 0; ks < 2; ++ks) { const int ko = (32 * ks + 8 * quad) * 2;
                const bf16x8 bqf = *(const LAS bf16x8*)(G + GL_QF + t * GL_ROW + ko), bqb = *(const LAS bf16x8*)(G + GL_QB + t * GL_ROW + ko);
#pragma unroll
                for (int mb = 0; mb < 4; ++mb) { const bf16x8 akf = *(const LAS bf16x8*)(G + GL_KF + (16 * mb + tq) * GL_ROW + ko), akb = *(const LAS bf16x8*)(G + GL_KB + (16 * mb + tq) * GL_ROW + ko);
                    sf[mb] = MFMA16(akf, bqf, sf[mb]); sb[mb] = MFMA16(akb, bqb, sb[mb]); } }
#pragma unroll
            for (int mb = 0; mb < 4; ++mb) { const int s0 = 16 * mb + 4 * quad; float v[4];
#pragma unroll
                for (int j = 0; j < 4; ++j) v[j] = (s0 + j <= t) ? sf[mb][j] : sb[mb][j];
                u32x2 w; w.x = cvtpk(v[0], v[1]); w.y = cvtpk(v[2], v[3]); *(LAS u32x2*)(G + GL_ATT + t * GL_ROW + s0 * 2) = w; }
        }
        __syncthreads();
        f32x4 o[8];
#pragma unroll
        for (int mb = 0; mb < 8; ++mb) o[mb] = (f32x4){0.f, 0.f, 0.f, 0.f};
        const int crow0 = 8 * (tq >> 2) + (tq & 3);
#pragma unroll
        for (int ks = 0; ks < 2; ++ks) { const int ko = (32 * ks + 8 * quad) * 2; const bf16x8 batt = *(const LAS bf16x8*)(G + GL_ATT + t * GL_ROW + ko);
#pragma unroll
            for (int mb = 0; mb < 8; ++mb) { const int c = 32 * (mb >> 1) + crow0 + 4 * (mb & 1);
                const bf16x8 av = *(const LAS bf16x8*)(G + GL_VT + c * GL_ROW + ko); o[mb] = MFMA16(av, batt, o[mb]); } }
#pragma unroll
        for (int dir = 0; dir < 2; ++dir) { const bf16_t* slot = ST + ((size_t)((b * 4 + h) * 2 + dir) * 64 + chunk) * 8192;
#pragma unroll
            for (int ks = 0; ks < 2; ++ks) { const int ko = (32 * ks + 8 * quad) * 2; const bf16x8 bq = *(const LAS bf16x8*)(G + (dir ? GL_QB : GL_QF) + t * GL_ROW + ko);
#pragma unroll
                for (int mb = 0; mb < 8; ++mb) { const int c = 32 * (mb >> 1) + crow0 + 4 * (mb & 1);
                    const bf16x8 as = *(const bf16x8*)(slot + c * 64 + 32 * ks + 8 * quad); o[mb] = MFMA16(as, bq, o[mb]); } } }
        float ss = 0.f;
#pragma unroll
        for (int mb = 0; mb < 8; ++mb) ss += o[mb][0] * o[mb][0] + o[mb][1] * o[mb][1] + o[mb][2] * o[mb][2] + o[mb][3] * o[mb][3];
        ss += __shfl_xor(ss, 16); ss += __shfl_xor(ss, 32);
        const float rs = rsqrtf(ss * (1.0f / 128.0f) + EPS);
        const size_t tok = (size_t)b * 4096 + chunk * 64 + t;
#pragma unroll
        for (int pp = 0; pp < 4; ++pp) { const int c0 = 32 * pp + 8 * quad;
            const u32x4 gzw = *(const u32x4*)(GZ + tok * 512 + h * 128 + c0); float z[8]; unpack8(gzw, z);
            const f32x4 g0 = *(const f32x4*)(p.in[I_GNORM] + e * 128 + c0), g1 = *(const f32x4*)(p.in[I_GNORM] + e * 128 + c0 + 4);
            float r[8];
#pragma unroll
            for (int j = 0; j < 4; ++j) { r[j] = o[2 * pp][j] * rs * g0[j] * silu_f(z[j]); r[4 + j] = o[2 * pp + 1][j] * rs * g1[j] * silu_f(z[4 + j]); }
            *(u32x4*)(O + tok * 1024 + h * 128 + c0) = pack8(r); }
    }
}

namespace att {
constexpr int DQK = 192, DV = 128, NW = 8, QBLK = 32, KVBLK = 64;
constexpr float SCALE = 0.07216878364870323f;
constexpr float THR = 8.f;
constexpr int SDEPTH = ATT_SDEPTH;
constexpr int SHM_V = KVBLK * DV * 2, SHM_K = KVBLK * DQK * 2;
constexpr int SHM_QR = 2 * SHM_V + 2 * SHM_K + NW * 64 * 4;
constexpr int NQR = ATT_NQR;
constexpr int SHM_ATTN = SHM_QR + NW * (12 - NQR) * 1024;
#define KSWZ(row, colB) ((row) * 384 + ((colB) ^ (((row) & 7) << 4)))
#define SBAR() __builtin_amdgcn_sched_barrier(0)
__device__ __forceinline__ int crow(int r, int hi) { return (r & 3) + 8 * (r >> 2) + 4 * hi; }
__device__ __forceinline__ unsigned cvtpkv(float lo, float hi) { unsigned r; asm volatile("v_cvt_pk_bf16_f32 %0, %1, %2" : "=v"(r) : "v"(lo), "v"(hi)); return r; }

__device__ __forceinline__ void partialSM(f32x16& p0, f32x16& p1, float& m_reg, float& mn, float& alpha) {
  constexpr float C = SCALE * 1.4426950408889634f;
  float pmax = p0[0];
#pragma unroll
  for (int r = 1; r < 16; ++r) pmax = fmaxf(pmax, p0[r]);
#pragma unroll
  for (int r = 0; r < 16; ++r) pmax = fmaxf(pmax, p1[r]);
  { auto rr = __builtin_amdgcn_permlane32_swap(__float_as_uint(pmax), __float_as_uint(pmax), false, false);
    pmax = fmaxf(__uint_as_float(rr[0]), __uint_as_float(rr[1])); }
  if (__builtin_expect(__all(pmax - m_reg <= THR / SCALE), 1)) { mn = m_reg; alpha = 1.f; }
  else { mn = fmaxf(m_reg, pmax); alpha = __builtin_amdgcn_exp2f((m_reg - mn) * C); m_reg = mn; }
  float mnC = -mn * C;
#pragma unroll
  for (int r = 0; r < 16; ++r) p0[r] = fmaf(p0[r], C, mnC);
#pragma unroll
  for (int r = 0; r < 16; ++r) p1[r] = fmaf(p1[r], C, mnC);
#pragma unroll
  for (int r = 0; r < 16; ++r) p0[r] = __builtin_amdgcn_exp2f(p0[r]);
}
__device__ __forceinline__ void finishSM(f32x16& p0, f32x16& p1, float alpha, float& l_reg, bf16x8& pa0, bf16x8& pa1, bf16x8& pa2, bf16x8& pa3) {
#pragma unroll
  for (int r = 0; r < 16; ++r) p1[r] = __builtin_amdgcn_exp2f(p1[r]);
  float ps = 0;
#pragma unroll
  for (int r = 0; r < 16; ++r) ps += p0[r];
#pragma unroll
  for (int r = 0; r < 16; ++r) ps += p1[r];
  { auto rr = __builtin_amdgcn_permlane32_swap(__float_as_uint(ps), __float_as_uint(ps), false, false);
    ps = __uint_as_float(rr[0]) + __uint_as_float(rr[1]); }
  l_reg = l_reg * alpha + ps;
#define PK4(P, BASE, OUT) do { unsigned a0 = cvtpkv(P[BASE + 0], P[BASE + 1]), a1 = cvtpkv(P[BASE + 2], P[BASE + 3]);   \
    unsigned b0 = cvtpkv(P[BASE + 4], P[BASE + 5]), b1 = cvtpkv(P[BASE + 6], P[BASE + 7]);                              \
    auto r0 = __builtin_amdgcn_permlane32_swap(a0, b0, false, false); auto r1 = __builtin_amdgcn_permlane32_swap(a1, b1, false, false); \
    u32x4 w = {r0[0], r1[0], r0[1], r1[1]}; OUT = *reinterpret_cast<bf16x8*>(&w); } while (0)
  PK4(p0, 0, pa0); PK4(p0, 8, pa1); PK4(p1, 0, pa2); PK4(p1, 8, pa3);
#undef PK4
}
__device__ __forceinline__ void qkt(f32x16& p0, f32x16& p1, const char* Ks, const bf16x8* qr, const char* qrl, int r32, int hi) {
  p0 = f32x16{}; p1 = f32x16{};
#pragma unroll
  for (int d0 = 0; d0 < 12; ++d0) { int cb = (d0 * 16 + hi * 8) * 2;
    bf16x8 b0 = *reinterpret_cast<const bf16x8*>(Ks + KSWZ(r32, cb));
    bf16x8 b1 = *reinterpret_cast<const bf16x8*>(Ks + KSWZ(32 + r32, cb));
    const bf16x8 q = d0 < NQR ? qr[d0 < NQR ? d0 : 0] : *reinterpret_cast<const bf16x8*>(qrl + (d0 - NQR) * 1024);
    p0 = __builtin_amdgcn_mfma_f32_32x32x16_bf16(b0, q, p0, 0, 0, 0);
    p1 = __builtin_amdgcn_mfma_f32_32x32x16_bf16(b1, q, p1, 0, 0, 0); }
}
__device__ __forceinline__ int v_st(int k, int c) { const int kk = (k & ~0xC) | ((k & 4) << 1) | ((k & 8) >> 1); return ((kk >> 3) * 4 + (c >> 5)) * 512 + ((kk & 7) * 32 + (c & 31)) * 2; }
__device__ __forceinline__ int v_rd_base(int lane) { return ((lane & 3) << 3) | (((lane >> 2) & 3) << 6) | (((lane >> 4) & 1) << 5) | (((lane >> 5) & 1) << 8); }
constexpr int v_rd_off(int d0, int ks, int half) { return d0 * 512 + ks * 4096 + half * 2048; }
template <int OFF> __device__ __forceinline__ s16x4 tr_read(int vb) {
  s16x4 r; asm volatile("ds_read_b64_tr_b16 %0, %1 offset:%2" : "=&v"(r) : "v"(vb), "i"(OFF) : "memory"); return r;
}
template <int D0> __device__ __forceinline__ void pv_one(f32x16& od, int vb, bf16x8 pa0, bf16x8 pa1, bf16x8 pa2, bf16x8 pa3) {
  const s16x4 l0 = tr_read<v_rd_off(D0, 0, 0)>(vb), h0 = tr_read<v_rd_off(D0, 0, 1)>(vb), l1 = tr_read<v_rd_off(D0, 1, 0)>(vb), h1 = tr_read<v_rd_off(D0, 1, 1)>(vb);
  const s16x4 l2 = tr_read<v_rd_off(D0, 2, 0)>(vb), h2 = tr_read<v_rd_off(D0, 2, 1)>(vb), l3 = tr_read<v_rd_off(D0, 3, 0)>(vb), h3 = tr_read<v_rd_off(D0, 3, 1)>(vb);
  asm volatile("s_waitcnt lgkmcnt(0)" ::: "memory"); SBAR();
#define PK(L, H) (bf16x8){L[0], L[1], L[2], L[3], H[0], H[1], H[2], H[3]}
  od = __builtin_amdgcn_mfma_f32_32x32x16_bf16(pa0, PK(l0, h0), od, 0, 0, 0);
  od = __builtin_amdgcn_mfma_f32_32x32x16_bf16(pa1, PK(l1, h1), od, 0, 0, 0);
  od = __builtin_amdgcn_mfma_f32_32x32x16_bf16(pa2, PK(l2, h2), od, 0, 0, 0);
  od = __builtin_amdgcn_mfma_f32_32x32x16_bf16(pa3, PK(l3, h3), od, 0, 0, 0);
#undef PK
}
__device__ __forceinline__ void pv_d0(f32x16* o, int vb, bf16x8 pa0, bf16x8 pa1, bf16x8 pa2, bf16x8 pa3) {
  pv_one<0>(o[0], vb, pa0, pa1, pa2, pa3); pv_one<1>(o[1], vb, pa0, pa1, pa2, pa3); pv_one<2>(o[2], vb, pa0, pa1, pa2, pa3); pv_one<3>(o[3], vb, pa0, pa1, pa2, pa3);
}

__device__ __forceinline__ void attn_body(const bf16_t* __restrict__ Qb, const bf16_t* __restrict__ Kh, const bf16_t* __restrict__ Vh,
                                          const bf16_t* __restrict__ MZb, bf16_t* __restrict__ Ob, int seq, char* lds) {
  const int tid = tid_fresh(), wid = __builtin_amdgcn_readfirstlane(tid >> 6), lane = tid & 63, r32 = lane & 31, hi = lane >> 5;
  char* V_lds = lds; char* K_lds = lds + 2 * SHM_V;
  float* wsl = (float*)(lds + 2 * SHM_V + 2 * SHM_K) + wid * 64; float* li_l = wsl; float* al_l = wsl + 32;
  float m_reg = -1e30f, l_reg = 0; f32x16 o[4] = {}; bf16x8 qr[NQR];
  char* qrl = lds + SHM_QR + wid * ((12 - NQR) * 1024) + lane * 16;
  const bf16_t* Qw = Qb + (long)(wid * QBLK + r32) * DQK + hi * 8;
#pragma unroll
  for (int d0 = 0; d0 < NQR; ++d0) qr[d0] = *reinterpret_cast<const bf16x8*>(Qw + d0 * 16);
#pragma unroll
  for (int d0 = NQR; d0 < 12; ++d0) *reinterpret_cast<bf16x8*>(qrl + (d0 - NQR) * 1024) = *reinterpret_cast<const bf16x8*>(Qw + d0 * 16);
  const int sr = tid >> 4, sc = (tid & 15) * 8, vst0 = v_st(sr, sc);
  const int sr2 = tid >> 3, sl2 = 16 + (tid & 7);
  const unsigned kg0 = sr * DQK + sc, kg2 = sr2 * DQK + sl2 * 8, voff0 = sr * DV + sc;
  const int kl0 = KSWZ(sr, sc * 2), kl2 = KSWZ(sr2, sl2 * 16);
  const int vb0 = (int)(uintptr_t)(LAS char*)V_lds + v_rd_base(lane);
  struct { bf16x8 vs0, vs1, ks0, ks1, ks2; } sr_[SDEPTH];
#define SLOAD(i, k0) do { const bf16_t* Kt = Kh + (size_t)(k0) * DQK; const bf16_t* Vt = Vh + (size_t)(k0) * DV; \
    sr_[i].vs0 = *(const bf16x8*)(Vt + voff0); sr_[i].vs1 = *(const bf16x8*)(Vt + voff0 + 32 * DV); \
    sr_[i].ks0 = *(const bf16x8*)(Kt + kg0); sr_[i].ks1 = *(const bf16x8*)(Kt + kg0 + 32 * DQK); sr_[i].ks2 = *(const bf16x8*)(Kt + kg2); } while (0)
#define SWRITE(b, i) do { *(bf16x8*)(V_lds + (b) * SHM_V + vst0) = sr_[i].vs0; *(bf16x8*)(V_lds + (b) * SHM_V + vst0 + 8192) = sr_[i].vs1; \
    *(bf16x8*)(K_lds + (b) * SHM_K + kl0) = sr_[i].ks0; *(bf16x8*)(K_lds + (b) * SHM_K + kl0 + 32 * 384) = sr_[i].ks1; *(bf16x8*)(K_lds + (b) * SHM_K + kl2) = sr_[i].ks2; } while (0)
#define SWAIT() do { if constexpr (SDEPTH == 2) asm volatile("s_waitcnt vmcnt(5)" ::: "memory"); else asm volatile("s_waitcnt vmcnt(0)" ::: "memory"); } while (0)
#define RESC(a) do { if (__any((a) < 1.f)) { if (hi == 0) al_l[r32] = (a); asm volatile("s_waitcnt lgkmcnt(0)" ::: "memory"); \
    _Pragma("unroll") for (int d = 0; d < 4; ++d) _Pragma("unroll") for (int r = 0; r < 16; ++r) o[d][r] *= al_l[crow(r, hi)]; } } while (0)
  f32x16 pA0, pA1, pB0, pB1; float mnA, mnB, alA, alB; bf16x8 pa0, pa1, pa2, pa3; const int NT = seq / KVBLK;
  constexpr int SE = 0, SO = SDEPTH - 1;
  SLOAD(SE, 0); asm volatile("s_waitcnt vmcnt(0)" ::: "memory"); SWRITE(0, SE); __syncthreads();
  qkt(pA0, pA1, K_lds, qr, qrl, r32, hi); partialSM(pA0, pA1, m_reg, mnA, alA);
  SLOAD(SO, KVBLK); if constexpr (SDEPTH == 2) { if (2 < NT) SLOAD(SE, 2 * KVBLK); }
  SWAIT(); SWRITE(1, SO); __syncthreads();
  for (int j = 1; j + 1 < NT; j += 2) {
    SBAR(); qkt(pB0, pB1, K_lds + SHM_K, qr, qrl, r32, hi);
    finishSM(pA0, pA1, alA, l_reg, pa0, pa1, pa2, pa3); SBAR();
    SLOAD(SO, (j + SDEPTH) * KVBLK); SBAR();
    pv_d0(o, vb0, pa0, pa1, pa2, pa3); partialSM(pB0, pB1, m_reg, mnB, alB);
    __syncthreads(); SWAIT(); SWRITE(0, SE);
    RESC(alB); __syncthreads();
    SBAR(); qkt(pA0, pA1, K_lds, qr, qrl, r32, hi);
    finishSM(pB0, pB1, alB, l_reg, pa0, pa1, pa2, pa3); SBAR();
    if (SDEPTH == 1 || j + 3 < NT) SLOAD(SE, (j + 1 + SDEPTH) * KVBLK); SBAR();
    pv_d0(o, vb0 + (int)SHM_V, pa0, pa1, pa2, pa3); partialSM(pA0, pA1, m_reg, mnA, alA);
    __syncthreads(); SWAIT(); SWRITE(1, SO);
    RESC(alA); __syncthreads();
  }
  SBAR(); qkt(pB0, pB1, K_lds + SHM_K, qr, qrl, r32, hi);
  finishSM(pA0, pA1, alA, l_reg, pa0, pa1, pa2, pa3); SBAR();
  pv_d0(o, vb0, pa0, pa1, pa2, pa3); partialSM(pB0, pB1, m_reg, mnB, alB);
  __syncthreads(); RESC(alB);
  finishSM(pB0, pB1, alB, l_reg, pa0, pa1, pa2, pa3); SBAR();
  pv_d0(o, vb0 + (int)SHM_V, pa0, pa1, pa2, pa3);
  if (hi == 0) li_l[r32] = l_reg; asm volatile("s_waitcnt lgkmcnt(0)" ::: "memory");
  float rli[16];
#pragma unroll
  for (int r = 0; r < 16; ++r) rli[r] = __builtin_amdgcn_rcpf(li_l[crow(r, hi)]);
  int hil = hi; asm volatile("" : "+v"(hil));
  bf16_t* Ow = Ob + (size_t)(wid * QBLK) * 1024; const bf16_t* Zw = MZb + (size_t)(wid * QBLK) * 512;
  const unsigned oo = 4 * hil * 1024 + r32, zo = 4 * hil * 512 + r32;
#pragma unroll
  for (int r = 0; r < 16; ++r) { const int ro = (r & 3) + 8 * (r >> 2);
#pragma unroll
    for (int d0 = 0; d0 < 4; ++d0) { const float z = bf2f(Zw[zo + (unsigned)(ro * 512 + d0 * 32)]); const float v = o[d0][r] * rli[r] * silu_f(z);
      Ow[oo + (unsigned)(ro * 1024 + d0 * 32)] = (bf16_t)(cvtpk(v, v) & 0xffff); } }
#undef SLOAD
#undef SWRITE
#undef SWAIT
#undef RESC
}
}

__device__ __forceinline__ void attn_phase(const Params& p, unsigned char* lds_generic) {
    const bf16_t* Q = (const bf16_t*)(p.ws + WS_Q); const bf16_t* K = (const bf16_t*)(p.ws + WS_K); const bf16_t* V = (const bf16_t*)(p.ws + WS_V);
    const bf16_t* MZ = (const bf16_t*)(p.ws + WS_MZ); bf16_t* O = (bf16_t*)(p.ws + WS_H);
    for (int it = blockIdx.x; it < 512; it += gridDim.x) {
        const int xcd = it & 7, r = it >> 3, bh = xcd * 4 + (r >> 4), qb = r & 15, b = bh >> 2, h = bh & 3;
        __syncthreads();
        const size_t tok0 = (size_t)b * 4096 + qb * 256;
        att::attn_body(Q + ((size_t)bh * 4096 + qb * 256) * 192, K + (size_t)bh * 4096 * 192, V + (size_t)bh * 4096 * 128,
                       MZ + tok0 * 512 + h * 128, O + tok0 * 1024 + 512 + h * 128, 4096, (char*)lds_generic);
    }
    __syncthreads();
}

constexpr int MX_WL = 0, MX_VT = 34816, MX_ST = 104448, MX_ROW = 272;
__device__ __forceinline__ void mix_phase(const Params& p, int oi, LAS unsigned char* lds) {
    const int tid = tid_fresh(), w = __builtin_amdgcn_readfirstlane(tid >> 6), lane = tid & 63, tq = lane & 15, quad = lane >> 4;
    const bf16_t* Wsb = (const bf16_t*)(p.ws + WS_WS); const bf16_t* V2 = (const bf16_t*)(p.ws + WS_V2); bf16_t* UZ = (bf16_t*)(p.ws + WS_UZ);
    const f32x2* PART = (const f32x2*)(p.ws + WS_PART);
    LAS f32x2* STAT = (LAS f32x2*)(lds + MX_ST);
    const int per = 2048 / gridDim.x; int last_g = -1;
    for (int i = 0; i < per; ++i) {
        const int it = blockIdx.x * per + i, g = it >> 8, bn = it & 255, b = bn >> 5, n = bn & 31; const size_t tok0 = (size_t)b * 4096 + n * 128;
        __syncthreads();
        if (g != last_g) { last_g = g;
#pragma unroll
            for (int q = 0; q < 4; ++q) { const int pc = tid + 512 * q, row = pc >> 4, cgp = pc & 15;
                *(LAS u32x4*)(lds + MX_WL + row * MX_ROW + cgp * 16) = *(const u32x4*)(Wsb + ((size_t)(oi * 8 + g) * 128 + row) * 128 + cgp * 8); } }
        if (tid < 128) { const size_t tok = tok0 + tid; float s = 0.f, ss = 0.f;
            for (int q = 0; q < 32; ++q) { const f32x2 pr = PART[tok * 32 + q]; s += pr.x; ss += pr.y; }
            const float mu = s * (1.0f / 2048.0f), var = ss * (1.0f / 2048.0f) - mu * mu; STAT[tid] = (f32x2){mu, rsqrtf(var + EPS)}; }
        __syncthreads();
        {
            const size_t tokA = tok0 + 2 * lane; const f32x2 sa = STAT[2 * lane], sb = STAT[2 * lane + 1];
#pragma unroll
            for (int q = 0; q < 4; ++q) { const int c0 = 8 * (w + 8 * q);
                const u32x4 ra = *(const u32x4*)(V2 + tokA * 2048 + g * 256 + c0), rb = *(const u32x4*)(V2 + (tokA + 1) * 2048 + g * 256 + c0);
                float fa[8], fb[8]; unpack8(ra, fa); unpack8(rb, fb);
                const float* gl = p.in[I_SGG] + oi * 2048 + g * 256 + c0; const float* bl = p.in[I_SGB] + oi * 2048 + g * 256 + c0;
#pragma unroll
                for (int e = 0; e < 8; ++e) { const float gg = gl[e], bb = bl[e];
                    const float va = (fa[e] - sa.x) * sa.y * gg + bb, vb = (fb[e] - sb.x) * sb.y * gg + bb;
                    *(LAS unsigned*)(lds + MX_VT + (c0 + e) * MX_ROW + 4 * lane) = cvtpk(va, vb); } }
        }
        __syncthreads();
        bf16x8 A[2][4];
#pragma unroll
        for (int mb = 0; mb < 2; ++mb)
#pragma unroll
            for (int ks = 0; ks < 4; ++ks) { const int c = 32 * w + 8 * (tq >> 2) + 4 * mb + (tq & 3);
                A[mb][ks] = *(const LAS bf16x8*)(lds + MX_VT + c * MX_ROW + (32 * ks + 8 * quad) * 2); }
#pragma unroll 2
        for (int nb = 0; nb < 8; ++nb) {
            f32x4 a0 = (f32x4){0.f, 0.f, 0.f, 0.f}, a1 = (f32x4){0.f, 0.f, 0.f, 0.f};
#pragma unroll
            for (int ks = 0; ks < 4; ++ks) { const bf16x8 bw = *(const LAS bf16x8*)(lds + MX_WL + (16 * nb + tq) * MX_ROW + (32 * ks + 8 * quad) * 2);
                a0 = MFMA16(A[0][ks], bw, a0); a1 = MFMA16(A[1][ks], bw, a1); }
            const int ti = 16 * nb + tq; const size_t tok = tok0 + ti; const float bias = p.in[I_SGBS][(oi * 8 + g) * 128 + ti];
            bf16_t* up = UZ + tok * 2048 + g * 256 + 32 * w + 8 * quad;
            const u32x4 uzw = *(const u32x4*)up; float f[8]; unpack8(uzw, f);
#pragma unroll
            for (int j = 0; j < 4; ++j) { f[j] *= (a0[j] + bias); f[4 + j] *= (a1[j] + bias); }
            *(u32x4*)up = pack8(f);
        }
    }
    __syncthreads();
}

__device__ __forceinline__ int opq(int x) { asm volatile("" : "+s"(x)); return x; }
__global__ void __launch_bounds__(512, 2) mega(Params p) {
    extern __shared__ __attribute__((aligned(16))) unsigned char lds_[];
    LAS unsigned char* lds = (LAS unsigned char*)lds_;
    cg::grid_group grid = cg::this_grid();
    const int lo = p.ph_lo, hi = p.ph_hi;
    unsigned char* ws = p.ws;
#ifdef ONLY_PH
#define IN(k) ((((k) - 2) % 10 + 2 == ONLY_PH || (k) == ONLY_PH) && lo <= (k) && (k) < hi)
#else
#define IN(k) (lo <= (k) && (k) < hi)
#endif
#define SEAM(k) do { if (IN(k) && IN((k) + 1)) grid.sync(); } while (0)
#if defined(DBG_MAXP) || defined(DBG_KEXPR)
    if (blockIdx.x == 0 && threadIdx.x == 0) ((int*)(ws + WS_PART))[41] = 0;
#endif
    if (IN(0)) p0_phase(p, lds);
    SEAM(0);
    if (IN(1)) norm_phase(p, -1, 0, nullptr, p.in[I_X]);
    SEAM(1);
    for (int lp = 0; lp < 2; ++lp) {
        const int base = 2 + 10 * lp, le = 2 * lp, lod = 2 * lp + 1;
        if (IN(base + 0)) {
            pg8::Gemm g{(const bf16_t*)(ws + WS_H), (const bf16_t*)(ws + WS_WINE) + (size_t)lp * 2560 * 1024, T_, opq(2560), opq(1024)};
            pg8::StaticOrder S; S.init(T_, 2560, (int)gridDim.x, (int)blockIdx.x); EpiEvenIn E{ws};
            pg8::gemm_phase<EpiEvenIn, pg8::StaticOrder, false>(lds, g, S, E, nullptr);
        }
        SEAM(base + 0);
        if (IN(base + 1)) { rs_rope_phase(p); gla_a_phase(p, lp, lds); }
        SEAM(base + 1);
        if (IN(base + 2)) {
            pg8::Gemm g{(const bf16_t*)(ws + WS_CQKV), (const bf16_t*)(ws + WS_WUP) + (size_t)lp * 1792 * 384, T_, opq(1792), opq(384)};
            pg8::StaticOrder S; S.init(T_, 1792, (int)gridDim.x, (int)blockIdx.x); EpiUp E{ws};
            pg8::gemm_phase<EpiUp, pg8::StaticOrder, false>(lds, g, S, E, nullptr);
            gla_b_phase(p);
        }
        SEAM(base + 2);
        if (IN(base + 3)) { attn_phase(p, lds_); gla_c_phase(p, lp, lds); }
        SEAM(base + 3);
        if (IN(base + 4)) {
            pg8::Gemm g{(const bf16_t*)(ws + WS_H), (const bf16_t*)(ws + WS_WOUTE) + (size_t)lp * 1024 * 1024, T_, opq(1024), opq(1024)};
            pg8::StaticOrder S; S.init(T_, 1024, (int)gridDim.x, (int)blockIdx.x); pg8::EpiF32 E{(float*)(ws + WS_YE), 1024, nullptr};
            pg8::gemm_phase<pg8::EpiF32, pg8::StaticOrder, false>(lds, g, S, E, nullptr);
        }
        SEAM(base + 4);
        if (IN(base + 5)) norm_phase(p, le, le + 1, (const float*)(ws + WS_YE), le == 0 ? p.in[I_X] : p.out);
        SEAM(base + 5);
        if (IN(base + 6)) {
            pg8::Gemm g{(const bf16_t*)(ws + WS_H), (const bf16_t*)(ws + WS_WINO) + (size_t)lp * 6144 * 1024, T_, opq(6144), opq(1024)};
            pg8::StaticOrder S; S.init(T_, 6144, (int)gridDim.x, (int)blockIdx.x); EpiOddIn E{ws};
            pg8::gemm_phase<EpiOddIn, pg8::StaticOrder, false>(lds, g, S, E, nullptr);
        }
        SEAM(base + 6);
        if (IN(base + 7)) mix_phase(p, lp, lds);
        SEAM(base + 7);
        if (IN(base + 8)) {
            pg8::Gemm g{(const bf16_t*)(ws + WS_UZ), (const bf16_t*)(ws + WS_WOUTO) + (size_t)lp * 1024 * 2048, T_, opq(1024), opq(2048)};
            pg8::StaticOrder S; S.init(T_, 1024, (int)gridDim.x, (int)blockIdx.x); pg8::EpiF32 E{(float*)(ws + WS_YO), 1024, nullptr};
            pg8::gemm_phase<pg8::EpiF32, pg8::StaticOrder, false>(lds, g, S, E, nullptr);
        }
        SEAM(base + 8);
        if (IN(base + 9)) norm_phase(p, lod, lod < 3 ? lod + 1 : -1, (const float*)(ws + WS_YO), p.out);
        SEAM(base + 9);
    }
#ifdef DEBUG_HI
    {
        int* DIAG = (int*)(ws + WS_PART);
        const int tid = tid_fresh(); const size_t gtid = (size_t)blockIdx.x * 512 + tid, gsz = (size_t)gridDim.x * 512;
        grid.sync();
        if (blockIdx.x == 0 && tid < 64 && tid != 41) DIAG[tid] = 0;
        for (size_t i = gtid; i < (size_t)T_ * 1024; i += gsz) p.out[i] = DBG_KEEP_OUT ? p.out[i] : 0.f;
        grid.sync();
#define DBG_CHECK(bi, off_, n_, isf32) { int bad = 0; \
            if (isf32) { const float* q = (const float*)(ws + (off_)); for (size_t i = gtid; i < (size_t)(n_); i += gsz) { const float v = q[i]; if (!(fabsf(v) < DBG_LIM)) bad = 1; } } \
            else { const bf16_t* q = (const bf16_t*)(ws + (off_)); for (size_t i = gtid; i < (size_t)(n_); i += gsz) { const float v = bf2f(q[i]); if (!(fabsf(v) < DBG_LIM)) bad = 1; } } \
            if (bad) atomicAdd(&DIAG[bi], 1); }
        DEBUG_BUFS
#ifdef DBG_FRAC
        { int cnt = 0; const bf16_t* q = (const bf16_t*)(ws + DBG_FRAC_OFF); for (size_t i = gtid; i < (size_t)(DBG_FRAC_N); i += gsz) { const float v = bf2f(q[i]); if (!(fabsf(v) < DBG_LIM)) ++cnt; } if (cnt) atomicAdd(&DIAG[40], cnt); }
#endif
        const int nb = DBG_NB;
        grid.sync();
        if (blockIdx.x == 0 && tid == 0) { int first = -1; for (int bi = 0; bi < nb; ++bi) if (first < 0 && __hip_atomic_load(&DIAG[bi], __ATOMIC_RELAXED, __HIP_MEMORY_SCOPE_AGENT) != 0) first = bi; p.out[0] = 1000.f * (float)(first + 1);
#if defined(DBG_MAXP) || defined(DBG_KEXPR)
            p.out[0] = 100.f * __int_as_float(__hip_atomic_load(&DIAG[41], __ATOMIC_RELAXED, __HIP_MEMORY_SCOPE_AGENT));
#endif
#ifdef DBG_FRAC
            p.out[0] = 100.f * (float)__hip_atomic_load(&DIAG[40], __ATOMIC_RELAXED, __HIP_MEMORY_SCOPE_AGENT);
#endif
        }
    }
#endif
}

extern "C" void kernel_launch(void* const* d_in, const int* in_sizes, int n_in, void* d_out, int out_size, void* d_ws, size_t ws_size, hipStream_t stream) {
    static int grid_blocks = 0;
    if (!grid_blocks) {
        if (n_in != 24 || out_size != T_ * 1024 || ws_size < WS_TOTAL) { fprintf(stderr, "kernel_launch: unexpected shapes (n_in %d out %d ws %zu need %zu)\n", n_in, out_size, ws_size, (size_t)WS_TOTAL); return; }
        if (hipFuncSetAttribute((const void*)mega, hipFuncAttributeMaxDynamicSharedMemorySize, (int)LDS_BYTES) != hipSuccess) { fprintf(stderr, "hipFuncSetAttribute failed\n"); return; }
        int dev = 0, cus = 0, per_cu = 0;
        (void)hipGetDevice(&dev);
        (void)hipDeviceGetAttribute(&cus, hipDeviceAttributeMultiprocessorCount, dev);
        (void)hipOccupancyMaxActiveBlocksPerMultiprocessor(&per_cu, mega, 512, LDS_BYTES);
        if (per_cu < 1 || cus != 256) { fprintf(stderr, "kernel_launch: occupancy %d cus %d\n", per_cu, cus); }
        grid_blocks = 256;
    }
    Params p{};
    for (int i = 0; i < 24; ++i) p.in[i] = (const float*)d_in[i];
    p.out = (float*)d_out; p.ws = (unsigned char*)d_ws;
#if N_LAUNCH_MODE == 0
#ifdef DEBUG_HI
    p.ph_lo = 0; p.ph_hi = DEBUG_HI;
#else
    p.ph_lo = 0; p.ph_hi = NPHASE;
#endif
    void* args[] = {&p};
    hipError_t e = hipLaunchCooperativeKernel((void*)mega, dim3(grid_blocks), dim3(512), args, LDS_BYTES, stream);
    if (e != hipSuccess) fprintf(stderr, "cooperative launch failed: %s (grid %d)\n", hipGetErrorString(e), grid_blocks);
#else
    for (int k = 0; k < NPHASE; ++k) { p.ph_lo = k; p.ph_hi = k + 1; hipLaunchKernelGGL(mega, dim3(grid_blocks), dim3(512), LDS_BYTES, stream, p); }
#endif
}
```

```cpp
#ifndef ATT_SDEPTH
#define ATT_SDEPTH 1
#endif
#ifndef ATT_NQR
#define ATT_NQR 12
#endif
#include <hip/hip_runtime.h>
namespace pg8 {
#define PG8_LAS __attribute__((address_space(3)))
typedef unsigned short bf16_t;
typedef short bf16x8 __attribute__((ext_vector_type(8)));
typedef float f32x4 __attribute__((ext_vector_type(4)));
typedef unsigned u32x4 __attribute__((ext_vector_type(4)));
constexpr int BM = 256, BK = 64, HALF = 128, HTB = HALF * BK * 2  , STAGE_BYTES = 8 * HTB, NXCD = 8, WGM = 8;

__host__ __device__ __forceinline__ int lds_byte(int r, int c) { const int st = (r >> 4) * 2 + (c >> 5), rr = r & 15, cc = c & 31, ob = rr * 64 + cc * 2; return st * 1024 + (ob ^ (((ob >> 9) & 1) << 5)); }
__host__ __device__ __forceinline__ void stage_rc(int b, int& R, int& C) { const int st = b / 1024, sb = b % 1024, swz = sb ^ (((sb >> 9) & 1) << 5); R = (st >> 1) * 16 + swz / 64; C = (st & 1) * 32 + (swz % 64) / 2; }
__host__ __device__ __forceinline__ int perm32(int rho) { const int n = rho >> 4, i = rho & 15; return 8 * (i >> 2) + 4 * n + (i & 3); }

struct Unit { int pm, pn; };
struct Gemm { const bf16_t* A; const bf16_t* Bt; int M, N, K; };

struct StaticOrder {
    int nM, nN, nwg, G, c;
    __host__ __device__ void init(int M, int N, int G_, int c_) { nM = M / BM; nN = N / BM; nwg = nM * nN; G = G_; c = c_; }
    __host__ __device__ bool next(int i, Unit& u) const {
        const long L = (long)i * G + c; if (L >= nwg) return false;
        int wgid = (int)L; { const int q = nwg / NXCD, r = nwg % NXCD, xcd = wgid % NXCD, off = wgid / NXCD; wgid = (xcd < r ? xcd * (q + 1) : r * (q + 1) + (xcd - r) * q) + off; }
        const int nig = WGM * nN, gid = wgid / nig, fm = gid * WGM, gsz = (nM - fm) < WGM ? (nM - fm) : WGM;
        u.pm = fm + ((wgid % nig) % gsz); u.pn = (wgid % nig) / gsz; return true;
    }
    __device__ __forceinline__ void a_ready(const Unit&) const {}
    __device__ __forceinline__ void done(const Unit&) const {}
};
__device__ __forceinline__ unsigned cvt_pk_bf16(float lo, float hi) { unsigned r; asm volatile("v_cvt_pk_bf16_f32 %0, %1, %2" : "=v"(r) : "v"(lo), "v"(hi)); return r; }
typedef float f32x2 __attribute__((ext_vector_type(2)));
__device__ __forceinline__ f32x2 gelu_pk(f32x2 v) {
    const f32x2 av = __builtin_elementwise_abs(v), d = av * 0.2316418882f + 1.0f;
    f32x2 t; t.x = __builtin_amdgcn_rcpf(d.x); t.y = __builtin_amdgcn_rcpf(d.y);
    f32x2 q = t * 0.5307027145f + (-0.7265760135f); q = q * t + 0.7107068705f; q = q * t + (-0.142248368f); q = q * t + 0.127414796f; q = q * t;
    const f32x2 s = (v * v) * (-0.72134752044f);
    f32x2 e; e.x = __builtin_amdgcn_exp2f(s.x); e.y = __builtin_amdgcn_exp2f(s.y);
    const f32x2 m = v * (q * e), r = v - m;
    f32x2 o; o.x = v.x < 0.f ? m.x : r.x; o.y = v.y < 0.f ? m.y : r.y; return o;
}

struct EpiF32 {
    static constexpr bool PERM = false, AFTER_DRAIN = false;
    float* C; int ldc; const float* bias;
    __device__ __forceinline__ void operator()(const f32x4 (&acc)[2][2][4][2], const Unit& u, int wr, int wc, int fr, int fq) const {
        const int row0 = u.pm * BM + wr * 64 + fr, col0 = u.pn * BM + wc * 32 + 4 * fq;
        f32x4 bv[2][2];
#pragma unroll
        for (int bj = 0; bj < 2; ++bj)
#pragma unroll
            for (int n = 0; n < 2; ++n) bv[bj][n] = bias ? *(const f32x4*)(bias + col0 + bj * HALF + n * 16) : (f32x4){0.f, 0.f, 0.f, 0.f};
#pragma unroll
        for (int ai = 0; ai < 2; ++ai)
#pragma unroll
            for (int m = 0; m < 4; ++m) { float* rowp = C + (size_t)(row0 + ai * HALF + m * 16) * ldc + col0;
#pragma unroll
                for (int bj = 0; bj < 2; ++bj)
#pragma unroll
                    for (int n = 0; n < 2; ++n) *(f32x4*)(rowp + bj * HALF + n * 16) = acc[ai][bj][m][n] + bv[bj][n]; }
    }
};
template <class Epi, class Sched, bool STAMP = false>
__device__ __forceinline__ void gemm_phase(PG8_LAS unsigned char* lds, const Gemm g, const Sched& S, const Epi& E, unsigned long long* stamps) {
    int tid = threadIdx.x; asm volatile("" : "+v"(tid));
    const int wid = __builtin_amdgcn_readfirstlane(tid >> 6), lane = tid & 63, wr = wid >> 2, wc = wid & 3, fr = lane & 15, fq = lane >> 4;
    const int K = g.K, nt = K / BK;
    int ts_lo = 0, ts_hi = 0, nts = 0; const unsigned long long rt_entry = STAMP ? (unsigned long long)wall_clock64() : 0ull;
#define PG8_STAMP() do { if (STAMP && wid == 0 && nts < 64) { const unsigned long long _c = (unsigned long long)clock64(); \
        ts_lo = (lane == nts) ? (int)(unsigned)_c : ts_lo; ts_hi = (lane == nts) ? (int)(unsigned)(_c >> 32) : ts_hi; ++nts; } } while (0)
    PG8_STAMP();
    unsigned voffA[2], voffB[2];
#pragma unroll
    for (int i = 0; i < 2; ++i) { int R, C; stage_rc(tid * 16 + i * 8192, R, C); const int Rb = Epi::PERM ? ((R & ~31) + perm32(R & 31)) : R;
        voffA[i] = (unsigned)(R * K + C) * 2u; voffB[i] = (unsigned)(Rb * K + C) * 2u; }
    const size_t kstep = (size_t)(BK * 2);
    const size_t hstep = (size_t)HALF * K * 2;
    const size_t tstep = 2 * hstep;
    const unsigned ldsw = (unsigned)wid * 1024u;
    const int aoff = lds_byte(wr * 64 + fr, fq * 8), boff = lds_byte(wc * 32 + fr, fq * 8);
#define PG8_SA(b, h) (((b) * 2 + (h)) * HTB)
#define PG8_SB(b, h) ((4 + (b) * 2 + (h)) * HTB)
#define PG8_STAGE(bufoff, gbase, voff) do { _Pragma("unroll") for (int _i = 0; _i < 2; ++_i) \
        __builtin_amdgcn_global_load_lds((const unsigned*)((const char*)(gbase) + (voff)[_i]), (PG8_LAS unsigned*)(lds + (bufoff) + ldsw + _i * 8192), 16, 0, 0); } while (0)
#define PG8_LDA(dst, b, h) do { _Pragma("unroll") for (int m = 0; m < 4; ++m) _Pragma("unroll") for (int k = 0; k < 2; ++k) dst[m][k] = *(const PG8_LAS bf16x8*)(lds + PG8_SA(b, h) + aoff + m * 2048 + k * 1024); } while (0)
#define PG8_LDB(dst, b, h) do { _Pragma("unroll") for (int n = 0; n < 2; ++n) _Pragma("unroll") for (int k = 0; k < 2; ++k) dst[n][k] = *(const PG8_LAS bf16x8*)(lds + PG8_SB(b, h) + boff + n * 2048 + k * 1024); } while (0)
#define PG8_MMA(ai, bj, At, Bt) do { __builtin_amdgcn_s_setprio(1); _Pragma("unroll") for (int m = 0; m < 4; ++m) _Pragma("unroll") for (int n = 0; n < 2; ++n) _Pragma("unroll") for (int k = 0; k < 2; ++k) \
        acc[ai][bj][m][n] = __builtin_amdgcn_mfma_f32_16x16x32_bf16(Bt[n][k], At[m][k], acc[ai][bj][m][n], 0, 0, 0); __builtin_amdgcn_s_setprio(0); } while (0)
#define PG8_WAIT_V(n) asm volatile("s_waitcnt vmcnt(" #n ")" ::: "memory")
#define PG8_WAIT_L(n) asm volatile("s_waitcnt lgkmcnt(" #n ")" ::: "memory")
#define PG8_BAR __builtin_amdgcn_s_barrier()
#define PG8_SCHED __builtin_amdgcn_sched_barrier(0)
    Unit cur, nxt; int ui = 0;
    if (!S.next(0, cur)) return;
    f32x4 acc[2][2][4][2];
#pragma unroll
    for (int a = 0; a < 2; ++a)
#pragma unroll
        for (int b = 0; b < 2; ++b)
#pragma unroll
            for (int m = 0; m < 4; ++m)
#pragma unroll
                for (int n = 0; n < 2; ++n) acc[a][b][m][n] = (f32x4){0.f, 0.f, 0.f, 0.f};
    bf16x8 At[4][2], B0[2][2], B1[2][2];
    const char* cA = (const char*)g.A + (size_t)cur.pm * tstep; const char* cB = (const char*)g.Bt + (size_t)cur.pn * tstep;
    S.a_ready(cur);
    PG8_STAGE(PG8_SB(0, 0), cB, voffB); PG8_STAGE(PG8_SA(0, 0), cA, voffA); PG8_STAGE(PG8_SB(0, 1), cB + hstep, voffB); PG8_STAGE(PG8_SA(0, 1), cA + hstep, voffA);
    if (wr == 1) PG8_BAR;
    PG8_WAIT_V(4); PG8_BAR;
    PG8_STAGE(PG8_SB(1, 0), cB + kstep, voffB); PG8_STAGE(PG8_SA(1, 0), cA + kstep, voffA); PG8_STAGE(PG8_SB(1, 1), cB + hstep + kstep, voffB);
    PG8_WAIT_V(6); PG8_BAR;
    PG8_STAMP();
    for (;;) {
        const bool has_next = S.next(ui + 1, nxt);
        const char* nA = has_next ? (const char*)g.A + (size_t)nxt.pm * tstep : cA; const char* nB = has_next ? (const char*)g.Bt + (size_t)nxt.pn * tstep : cB;
        for (int t = 0; t < nt; t += 2) {
            const bool last = (t == nt - 2);
            const char* a1 = cA + (size_t)(t + 1) * kstep;
            const char* a2 = last ? nA : cA + (size_t)(t + 2) * kstep; const char* b2 = last ? nB : cB + (size_t)(t + 2) * kstep;
            const char* a3 = a2 + kstep; const char* b3 = b2 + kstep;
            if (last && has_next) S.a_ready(nxt);
            PG8_LDB(B0, 0, 0); PG8_SCHED; PG8_LDA(At, 0, 0); PG8_STAGE(PG8_SA(1, 1), a1 + hstep, voffA);
            PG8_WAIT_L(8); PG8_BAR; PG8_WAIT_L(0); PG8_MMA(0, 0, At, B0); PG8_BAR; PG8_SCHED;
            PG8_LDB(B1, 0, 1); PG8_STAGE(PG8_SB(0, 0), b2, voffB);
            PG8_BAR; PG8_WAIT_L(0); PG8_MMA(0, 1, At, B1); PG8_BAR;
            PG8_LDA(At, 0, 1); PG8_STAGE(PG8_SA(0, 0), a2, voffA);
            PG8_BAR; PG8_WAIT_L(0); PG8_MMA(1, 0, At, B0); PG8_BAR; PG8_SCHED;
            PG8_STAGE(PG8_SB(0, 1), b2 + hstep, voffB);
            PG8_WAIT_V(6); PG8_BAR; PG8_MMA(1, 1, At, B1); PG8_BAR;
            PG8_LDB(B0, 1, 0); PG8_SCHED; PG8_LDA(At, 1, 0); PG8_STAGE(PG8_SA(0, 1), a2 + hstep, voffA);
            PG8_WAIT_L(8); PG8_BAR; PG8_WAIT_L(0); PG8_MMA(0, 0, At, B0); PG8_BAR; PG8_SCHED;
            PG8_LDB(B1, 1, 1); PG8_STAGE(PG8_SB(1, 0), b3, voffB);
            PG8_BAR; PG8_WAIT_L(0); PG8_MMA(0, 1, At, B1); PG8_BAR;
            PG8_LDA(At, 1, 1); PG8_STAGE(PG8_SA(1, 0), a3, voffA);
            PG8_BAR; PG8_WAIT_L(0); PG8_MMA(1, 0, At, B0); PG8_BAR; PG8_SCHED;
            PG8_STAGE(PG8_SB(1, 1), b3 + hstep, voffB);
            PG8_WAIT_V(6); PG8_BAR; PG8_MMA(1, 1, At, B1); PG8_BAR;
        }
        PG8_STAMP();
        if constexpr (!Epi::AFTER_DRAIN) { E(acc, cur, wr, wc, fr, fq); S.done(cur); }
        PG8_STAMP();
        if (!has_next) break;
#pragma unroll
        for (int a = 0; a < 2; ++a)
#pragma unroll
            for (int b = 0; b < 2; ++b)
#pragma unroll
                for (int m = 0; m < 4; ++m)
#pragma unroll
                    for (int n = 0; n < 2; ++n) acc[a][b][m][n] = (f32x4){0.f, 0.f, 0.f, 0.f};
        cur = nxt; cA = nA; cB = nB; ++ui;
    }
    PG8_WAIT_V(0);
    if (wr == 0) PG8_BAR;
    PG8_BAR;
    if constexpr (Epi::AFTER_DRAIN) { E.fused(acc, cur, wr, wc, fr, fq, lds, wid, lane); S.done(cur); }
    PG8_STAMP();
    if (STAMP && wid == 0) { stamps[lane] = lane < nts ? (((unsigned long long)(unsigned)ts_hi << 32) | (unsigned)ts_lo) : 0ull;
        if (lane == 62) stamps[62] = rt_entry; if (lane == 63) stamps[63] = (unsigned long long)wall_clock64(); }
#undef PG8_STAMP
#undef PG8_SA
#undef PG8_SB
#undef PG8_STAGE
#undef PG8_LDA
#undef PG8_LDB
#undef PG8_MMA
#undef PG8_WAIT_V
#undef PG8_WAIT_L
#undef PG8_BAR
#undef PG8_SCHED
}
}


#include <hip/hip_cooperative_groups.h>
#include <cstdio>
namespace cg = cooperative_groups;
#define LAS __attribute__((address_space(3)))
typedef unsigned short bf16_t;
typedef short bf16x8 __attribute__((ext_vector_type(8)));
typedef short s16x4 __attribute__((ext_vector_type(4)));
typedef float f32x4 __attribute__((ext_vector_type(4)));
typedef float f32x2 __attribute__((ext_vector_type(2)));
typedef float f32x16 __attribute__((ext_vector_type(16)));
typedef unsigned u32x4 __attribute__((ext_vector_type(4)));
typedef unsigned u32x2 __attribute__((ext_vector_type(2)));

#ifndef N_LAUNCH_MODE
#define N_LAUNCH_MODE 0
#endif

constexpr int T_ = 32768, DM = 1024, NBAT = 8, SEQ = 4096;
constexpr float EPS = 1e-6f;
constexpr int NPHASE = 22;
constexpr size_t LDS_BYTES = 163840;

constexpr size_t al256(size_t x) { return (x + 255) / 256 * 256; }
constexpr size_t WS_WINE  = 0;
constexpr size_t WS_WUP   = WS_WINE  + al256((size_t)2 * 2560 * 1024 * 2);
constexpr size_t WS_WOUTE = WS_WUP   + al256((size_t)2 * 1792 * 384 * 2);
constexpr size_t WS_WINO  = WS_WOUTE + al256((size_t)2 * 1024 * 1024 * 2);
constexpr size_t WS_WOUTO = WS_WINO  + al256((size_t)2 * 6144 * 1024 * 2);
constexpr size_t WS_WS    = WS_WOUTO + al256((size_t)2 * 1024 * 2048 * 2);
constexpr size_t WS_MOD   = WS_WS    + al256((size_t)2 * 8 * 128 * 128 * 2);
constexpr size_t WS_ROPE  = WS_MOD   + al256((size_t)4 * 8 * 3072 * 4);
constexpr size_t WS_RS    = WS_ROPE  + al256((size_t)T_ * 32 * 8);
constexpr size_t WS_EV    = WS_RS    + al256((size_t)T_ * 2 * 4);
constexpr size_t WS_PART  = WS_EV    + al256((size_t)4096 * 64 * 4);
constexpr size_t WS_H     = WS_PART  + al256((size_t)T_ * 32 * 8);
constexpr size_t WS_R2    = WS_H     + al256((size_t)T_ * 1024 * 2);
constexpr size_t WS_GQ    = WS_R2;
constexpr size_t WS_GK    = WS_GQ   + (size_t)T_ * 256 * 2;
constexpr size_t WS_GV    = WS_GK   + (size_t)T_ * 256 * 2;
constexpr size_t WS_GZ    = WS_GV   + (size_t)T_ * 512 * 2;
constexpr size_t WS_MZ    = WS_GZ   + (size_t)T_ * 512 * 2;
constexpr size_t WS_CQKV  = WS_MZ   + (size_t)T_ * 512 * 2;
constexpr size_t WS_KR    = WS_CQKV + (size_t)T_ * 384 * 2;
constexpr size_t WS_GA    = WS_KR   + (size_t)T_ * 64 * 2;
constexpr size_t WS_Q     = WS_GA   + (size_t)T_ * 32 * 4;
constexpr size_t WS_K     = WS_Q    + (size_t)T_ * 4 * 192 * 2;
constexpr size_t WS_V     = WS_K    + (size_t)T_ * 4 * 192 * 2;
constexpr size_t WS_ST    = WS_V    + (size_t)T_ * 4 * 128 * 2;
constexpr size_t WS_EVEN_END = WS_ST + (size_t)4096 * 8192 * 2;
constexpr size_t WS_YE    = WS_Q;
constexpr size_t WS_UZ    = WS_R2;
constexpr size_t WS_V2    = WS_UZ   + (size_t)T_ * 2048 * 2;
constexpr size_t WS_YO    = WS_V2;
constexpr size_t WS_ODD_END = WS_V2 + (size_t)T_ * 2048 * 2;
constexpr size_t WS_TOTAL = WS_EVEN_END > WS_ODD_END ? WS_EVEN_END : WS_ODD_END;
static_assert(WS_Q + (size_t)T_ * 1024 * 4 == WS_ST, "Y_even must cover exactly Q|K|V");

constexpr size_t WUP_E = 768 * 256 + 1024 * 128, WUP_KV = 768 * 256;
constexpr size_t WS_CQ = WS_CQKV, WS_CKV = WS_CQKV + (size_t)T_ * 256 * 2;
struct Params { const float* in[24]; float* out; unsigned char* ws; int ph_lo, ph_hi; };
enum { I_X = 0, I_C, I_POS, I_WMOD, I_BMOD, I_GPRE, I_GPOST, I_WINE, I_W2F, I_B2F, I_W2B, I_B2B, I_GNORM, I_GQ, I_WUQ, I_GKV, I_WUKV, I_WOUTE,
       I_WINO, I_SGG, I_SGB, I_SGW, I_SGBS, I_WOUTO };

typedef __bf16 bf16v2 __attribute__((ext_vector_type(2)));
__device__ __forceinline__ unsigned cvtpk(float lo, float hi) { const f32x2 v = {lo, hi}; return __builtin_bit_cast(unsigned, __builtin_convertvector(v, bf16v2)); }
__device__ __forceinline__ float bflo(unsigned w) { return __uint_as_float(w << 16); }
__device__ __forceinline__ float bfhi(unsigned w) { return __uint_as_float(w & 0xffff0000u); }
__device__ __forceinline__ float bf2f(unsigned short b) { return __uint_as_float(((unsigned)b) << 16); }
__device__ __forceinline__ int tid_fresh() { int t = threadIdx.x; asm volatile("" : "+v"(t)); return t; }
__device__ __forceinline__ float wave_sum(float v) {
#pragma unroll
    for (int o = 32; o >= 1; o >>= 1) v += __shfl_xor(v, o);
    return v; }
__device__ __forceinline__ float silu_f(float z) { return z * __builtin_amdgcn_rcpf(1.0f + __expf(-z)); }
__device__ __forceinline__ float logsig_f(float x) { return fminf(x, 0.f) - __logf(1.0f + __expf(-fabsf(x))); }
__device__ __forceinline__ void unpack8(const u32x4 w, float (&f)[8]) {
    f[0] = bflo(w.x); f[1] = bfhi(w.x); f[2] = bflo(w.y); f[3] = bfhi(w.y); f[4] = bflo(w.z); f[5] = bfhi(w.z); f[6] = bflo(w.w); f[7] = bfhi(w.w); }
__device__ __forceinline__ u32x4 pack8(const float (&f)[8]) { u32x4 w; w.x = cvtpk(f[0], f[1]); w.y = cvtpk(f[2], f[3]); w.z = cvtpk(f[4], f[5]); w.w = cvtpk(f[6], f[7]); return w; }
#define MFMA16(a, b, c) __builtin_amdgcn_mfma_f32_16x16x32_bf16((a), (b), (c), 0, 0, 0)

__device__ __forceinline__ int map_even_col(int n) {
    if (n < 1024) return n;
    if (n < 1536) return n - 1024 + 1056;
    if (n < 2048) return n - 1536 + 2016;
    if (n < 2304) return n - 2048 + 1568;
    if (n < 2432) return n - 2304 + 1824;
    if (n < 2496) return n - 2432 + 1952;
    if (n < 2528) return n - 2496 + 1024;
    return -1; }
__device__ __forceinline__ int map_q_col(int n) {
    const int hh = n / 192, j = n - hh * 192;
    if (j < 128) return n;
    const int jj = j - 128, g8 = jj >> 3, w = jj & 7;
    return hh * 192 + 128 + ((w < 4) ? (4 * g8 + w) : (32 + 4 * g8 + (w - 4))); }
__device__ __forceinline__ int map_odd_col(int n) {
    const int pn = n >> 8;
    if (pn < 16) { const int half = (n >> 7) & 1, idx = n & 127; return (half ? 4096 : 0) + 128 * pn + idx; }
    return 2048 + (n - 4096); }

template <int MAT> __device__ __forceinline__ float prep_val(const Params& p, int e, int n, int k) {
    if (MAT == 0) { const int sc = map_even_col(n); return sc < 0 ? 0.f : p.in[I_WINE][((size_t)e * 1024 + k) * 2528 + sc]; }
    if (MAT == 1) return p.in[I_GQ][e * 256 + k] * p.in[I_WUQ][((size_t)e * 256 + k) * 768 + map_q_col(n)];
    if (MAT == 5) return p.in[I_GKV][e * 128 + k] * p.in[I_WUKV][((size_t)e * 128 + k) * 1024 + n];
    if (MAT == 2) return p.in[I_WOUTE][((size_t)e * 1024 + k) * 1024 + n];
    if (MAT == 3) return p.in[I_WINO][((size_t)e * 1024 + k) * 6144 + map_odd_col(n)];
    return p.in[I_WOUTO][((size_t)e * 2048 + k) * 1024 + n];
}
template <int MAT> __device__ __forceinline__ void prep_tile(const Params& p, LAS float* tl, bf16_t* dst, int K, int e, int n0, int k0) {
    const int tid = tid_fresh(), nl = tid & 63, kl = tid >> 6;
#pragma unroll
    for (int r = 0; r < 8; ++r) { const int k = kl + 8 * r; tl[k * 65 + nl] = prep_val<MAT>(p, e, n0 + nl, k0 + k); }
    __syncthreads();
    const int nl2 = tid >> 3, kg = tid & 7; float v[8];
#pragma unroll
    for (int q = 0; q < 8; ++q) v[q] = tl[(8 * kg + q) * 65 + nl2];
    *(u32x4*)(dst + (size_t)(n0 + nl2) * K + k0 + 8 * kg) = pack8(v);
    __syncthreads();
}

__device__ __forceinline__ void p0_phase(const Params& p, LAS unsigned char* lds) {
    const int tid = tid_fresh();
    unsigned char* ws = p.ws;
    constexpr int N_MOD = 192, N_ROPE = 256, N_WS = 64;
    constexpr int T0 = N_MOD + N_ROPE + N_WS;
    constexpr int T1 = T0 + 2 * 40 * 16;
    constexpr int T2 = T1 + 2 * 12 * 4 + 2 * 16 * 2;
    constexpr int T3 = T2 + 2 * 16 * 16;
    constexpr int T4 = T3 + 2 * 96 * 16;
    constexpr int T5 = T4 + 2 * 16 * 32;
    LAS float* tl = (LAS float*)lds;
    for (int it = blockIdx.x; it < T5; it += gridDim.x) {
        if (it < N_MOD) {
            const int l = it / 48, jc = it % 48;
            LAS float* sc = (LAS float*)lds;
            LAS float* red = (LAS float*)(lds + 32768);
            for (int i = tid; i < 8192; i += 512) { const float cv = p.in[I_C][i]; sc[i] = silu_f(cv); }
            __syncthreads();
            const int cgp = tid & 15, kg = tid >> 4;
            float acc[8][4];
#pragma unroll
            for (int b = 0; b < 8; ++b)
#pragma unroll
                for (int c = 0; c < 4; ++c) acc[b][c] = 0.f;
            const float* wp = p.in[I_WMOD] + ((size_t)l * 1024 + 32 * kg) * 3072 + 64 * jc + 4 * cgp;
#pragma unroll 4
            for (int kk = 0; kk < 32; ++kk) {
                const f32x4 w = *(const f32x4*)(wp + (size_t)kk * 3072);
#pragma unroll
                for (int b = 0; b < 8; ++b) { const float s = sc[b * 1024 + 32 * kg + kk];
#pragma unroll
                    for (int c = 0; c < 4; ++c) acc[b][c] += s * w[c]; } }
#pragma unroll
            for (int b = 0; b < 8; ++b)
#pragma unroll
                for (int c = 0; c < 4; ++c) red[(kg * 8 + b) * 64 + 4 * cgp + c] = acc[b][c];
            __syncthreads();
            { const int b = tid >> 6, col = tid & 63; float s = p.in[I_BMOD][l * 3072 + 64 * jc + col];
              for (int q = 0; q < 32; ++q) s += red[(q * 8 + b) * 64 + col];
              ((float*)(ws + WS_MOD))[((size_t)l * 8 + b) * 3072 + 64 * jc + col] = s; }
            __syncthreads();
        } else if (it < N_MOD + N_ROPE) {
            const int r0 = (it - N_MOD) * 4096;
            for (int i = tid; i < 4096; i += 512) { const int idx = r0 + i, row = idx >> 5, fi = idx & 31;
                const float pos = (float)((const int*)p.in[I_POS])[row];
                const float inv = 1.0f / powf(10000.0f, (float)(2 * fi) * (1.0f / 64.0f));
                const float ang = pos * inv; f32x2 cs; cs.x = cosf(ang); cs.y = sinf(ang);
                ((f32x2*)(ws + WS_ROPE))[idx] = cs; }
        } else if (it < T0) {
            const int r0 = (it - N_MOD - N_ROPE) * 4096;
            for (int i = tid; i < 2048; i += 512) { const int idx = r0 + 2 * i; const f32x2 v = *(const f32x2*)(p.in[I_SGW] + idx);
                ((unsigned*)(ws + WS_WS))[idx >> 1] = cvtpk(v.x, v.y); }
        } else if (it < T1) { const int q = it - T0, e = q / 640, r = q % 640, nt = r / 16, kt = r % 16;
            prep_tile<0>(p, tl, (bf16_t*)(ws + WS_WINE) + (size_t)e * 2560 * 1024, 1024, e, nt * 64, kt * 64);
        } else if (it < T2) { const int q = it - T1;
            if (q < 96) { const int e = q / 48, r = q % 48, nt = r / 4, kt = r % 4;
                prep_tile<1>(p, tl, (bf16_t*)(ws + WS_WUP) + (size_t)e * WUP_E, 256, e, nt * 64, kt * 64); }
            else { const int q2 = q - 96, e = q2 / 32, r = q2 % 32, nt = r / 2, kt = r % 2;
                prep_tile<5>(p, tl, (bf16_t*)(ws + WS_WUP) + (size_t)e * WUP_E + WUP_KV, 128, e, nt * 64, kt * 64); }
        } else if (it < T3) { const int q = it - T2, e = q / 256, r = q % 256, nt = r / 16, kt = r % 16;
            prep_tile<2>(p, tl, (bf16_t*)(ws + WS_WOUTE) + (size_t)e * 1024 * 1024, 1024, e, nt * 64, kt * 64);
        } else if (it < T4) { const int q = it - T3, e = q / 1536, r = q % 1536, nt = r / 16, kt = r % 16;
            prep_tile<3>(p, tl, (bf16_t*)(ws + WS_WINO) + (size_t)e * 6144 * 1024, 1024, e, nt * 64, kt * 64);
        } else { const int q = it - T4, e = q / 512, r = q % 512, nt = r / 32, kt = r % 32;
            prep_tile<4>(p, tl, (bf16_t*)(ws + WS_WOUTO) + (size_t)e * 1024 * 2048, 2048, e, nt * 64, kt * 64);
        }
    }
}

__device__ __forceinline__ void norm_phase(const Params& p, int l_post, int l_pre, const bf16_t* y, const float* xin) {
    const int tid = tid_fresh(), lane = tid & 63, wave = tid >> 6;
    const float* mod = (const float*)(p.ws + WS_MOD);
    bf16_t* H = (bf16_t*)(p.ws + WS_H);
    for (int row = blockIdx.x * 8 + wave; row < T_; row += gridDim.x * 8) {
        const int b = row >> 12;
        f32x4 xv[4];
#pragma unroll
        for (int i = 0; i < 4; ++i) xv[i] = *(const f32x4*)(xin + (size_t)row * 1024 + 256 * i + 4 * lane);
        if (l_post >= 0) {
            f32x4 yv[4]; float ss = 0.f;
#pragma unroll
            for (int i = 0; i < 4; ++i) { const u32x2 yw = *(const u32x2*)(y + (size_t)row * 1024 + 256 * i + 4 * lane); yv[i] = (f32x4){bflo(yw.x), bfhi(yw.x), bflo(yw.y), bfhi(yw.y)}; ss += yv[i][0] * yv[i][0] + yv[i][1] * yv[i][1] + yv[i][2] * yv[i][2] + yv[i][3] * yv[i][3]; }
            ss = wave_sum(ss); const float rs = rsqrtf(ss * (1.0f / 1024.0f) + EPS);
            const float* gate = mod + ((size_t)l_post * 8 + b) * 3072 + 2048; const float* gp = p.in[I_GPOST] + l_post * 1024;
#pragma unroll
            for (int i = 0; i < 4; ++i) { const f32x4 g = *(const f32x4*)(gate + 256 * i + 4 * lane), w = *(const f32x4*)(gp + 256 * i + 4 * lane);
                xv[i] = xv[i] + g * (yv[i] * rs * w);
#ifdef DEBUG_SANITIZE
                if (l_post == 3) { for (int q = 0; q < 4; ++q) if (!(fabsf(xv[i][q]) < 1e30f)) xv[i][q] = 12345.f; }
#endif
                *(f32x4*)(p.out + (size_t)row * 1024 + 256 * i + 4 * lane) = xv[i]; }
        }
        if (l_pre >= 0) {
            float ss = 0.f;
#pragma unroll
            for (int i = 0; i < 4; ++i) ss += xv[i][0] * xv[i][0] + xv[i][1] * xv[i][1] + xv[i][2] * xv[i][2] + xv[i][3] * xv[i][3];
            ss = wave_sum(ss); const float rs = rsqrtf(ss * (1.0f / 1024.0f) + EPS);
            const float* sh = mod + ((size_t)l_pre * 8 + b) * 3072; const float* sc = sh + 1024; const float* gp = p.in[I_GPRE] + l_pre * 1024;
#pragma unroll
            for (int i = 0; i < 4; ++i) { const f32x4 s0 = *(const f32x4*)(sh + 256 * i + 4 * lane), s1 = *(const f32x4*)(sc + 256 * i + 4 * lane), w = *(const f32x4*)(gp + 256 * i + 4 * lane);
                const f32x4 hv = (xv[i] * rs * w) * (s1 + 1.0f) + s0; u32x2 o; o.x = cvtpk(hv[0], hv[1]); o.y = cvtpk(hv[2], hv[3]);
                *(u32x2*)(H + (size_t)row * 1024 + 256 * i + 4 * lane) = o; }
        }
    }
}

#define XB_TMO      128
#define XB_XCNT(j)  (256  + 64 * (j))
#define XB_XSUB(j)  (1280 + 64 * (j))
#define XB_XGEN(j)  (2304 + 64 * (j))
#define XB_TOP      3328
#define XB_TOPGEN   3392
#define XCD_BAR_WORDS 3456
#define XB_SPIN_CAP (1u << 18)

__device__ __forceinline__ unsigned xb_ld(unsigned* p)              { return __hip_atomic_load(p, __ATOMIC_RELAXED, __HIP_MEMORY_SCOPE_AGENT); }
__device__ __forceinline__ unsigned xb_add(unsigned* p, unsigned v) { return __hip_atomic_fetch_add(p, v, __ATOMIC_RELAXED, __HIP_MEMORY_SCOPE_AGENT); }
__device__ __forceinline__ unsigned xb_xcc_id() { return (unsigned)__builtin_amdgcn_s_getreg((3 << 11) | 20) & 0xFu; }
#define XB_SPIN(cond, bar) do { unsigned _sp = 0; while (cond) { __builtin_amdgcn_s_sleep(1); \
    if ((++_sp & 255u) == 0u) { if (xb_ld(&(bar)[XB_TMO])) break; if (_sp > XB_SPIN_CAP) { atomicAdd(&(bar)[XB_TMO], 1u); break; } } } } while (0)

struct XcdBarrier {
    unsigned* bar; unsigned x;
    volatile LAS unsigned* st;
};

__device__ __forceinline__ XcdBarrier xcd_barrier_post(unsigned* bar, volatile LAS unsigned* st) {
    XcdBarrier b; b.bar = bar; b.x = xb_xcc_id(); b.st = st;
    if (threadIdx.x == 0) (void)xb_add(&bar[XB_XCNT(b.x)], 1u);
    return b;
}
__device__ __forceinline__ void xcd_barrier_complete(unsigned* bar, unsigned x, unsigned& nloc, unsigned& nx) {
    const unsigned G = gridDim.x * gridDim.y * gridDim.z;
    unsigned sum, cnt, mine, sp = 0u;
    for (;;) {
        sum = 0u; cnt = 0u; mine = 0u;
#pragma unroll
        for (unsigned j = 0; j < 16; ++j) { const unsigned c = xb_ld(&bar[XB_XCNT(j)]); sum += c; cnt += (c > 0u) ? 1u : 0u; mine = (j == x) ? c : mine; }
        if (sum == G) break;
        __builtin_amdgcn_s_sleep(1);
        if ((++sp & 255u) == 0u) { if (xb_ld(&bar[XB_TMO])) break; if (sp > XB_SPIN_CAP) { atomicAdd(&bar[XB_TMO], 1u); break; } }
    }
    nloc = mine > 0u ? mine : 1u; nx = cnt > 0u ? cnt : 1u;
}

__device__ __forceinline__ void xcd_barrier(const XcdBarrier& b) {
    asm volatile("s_waitcnt vmcnt(0)" ::: "memory");
    __syncthreads();
    if (threadIdx.x == 0) {
        unsigned* bar = b.bar;
        __builtin_amdgcn_s_waitcnt(0);
        unsigned nloc = b.st[0], nx = b.st[1];
        if (nloc == 0u) { xcd_barrier_complete(bar, b.x, nloc, nx); b.st[0] = nloc; b.st[1] = nx; }
        const unsigned old = xb_add(&bar[XB_XSUB(b.x)], 1u);
        const unsigned gen = old / nloc;
        if (old + 1u == (gen + 1u) * nloc) {
            __builtin_amdgcn_fence(__ATOMIC_RELEASE, "agent");
            asm volatile("s_waitcnt vmcnt(0)" ::: "memory");
            const unsigned og = xb_add(&bar[XB_TOP], 1u);
            const unsigned tg = og / nx;
            if (og + 1u == (tg + 1u) * nx) xb_add(&bar[XB_TOPGEN], 1u);
            else XB_SPIN(xb_ld(&bar[XB_TOPGEN]) == tg, bar);
            __builtin_amdgcn_fence(__ATOMIC_ACQUIRE, "agent");
            xb_add(&bar[XB_XGEN(b.x)], 1u);
            asm volatile("s_waitcnt vmcnt(0)" ::: "memory");
        } else {
            XB_SPIN(xb_ld(&bar[XB_XGEN(b.x)]) == gen, bar);
            __builtin_amdgcn_fence(__ATOMIC_ACQUIRE, "agent");
            asm volatile("s_waitcnt vmcnt(0)" ::: "memory");
        }
    }
    __syncthreads();
}


struct EpiEvenIn {
    static constexpr bool PERM = true, AFTER_DRAIN = false;
    unsigned char* ws;
    __device__ __forceinline__ void operator()(const f32x4 (&acc)[2][2][4][2], const pg8::Unit& u, int wr, int wc, int fr_, int fq_) const {
        int fr = fr_, fq = fq_; asm volatile("" : "+v"(fr), "+v"(fq));
        const int row0 = u.pm * 256 + wr * 64 + fr, pn = u.pn, cu = 32 * wc + 8 * fq;
        if (pn < 9) {
            bf16_t* base; int ld;
            if (pn == 0) { base = (bf16_t*)(ws + WS_GQ); ld = 256; }
            else if (pn == 1) { base = (bf16_t*)(ws + WS_GK); ld = 256; }
            else if (pn < 4) { base = (bf16_t*)(ws + WS_GV) + (pn - 2) * 256; ld = 512; }
            else if (pn < 6) { base = (bf16_t*)(ws + WS_GZ) + (pn - 4) * 256; ld = 512; }
            else if (pn < 8) { base = (bf16_t*)(ws + WS_MZ) + (pn - 6) * 256; ld = 512; }
            else { base = (bf16_t*)(ws + WS_CQ); ld = 256; }
#pragma unroll
            for (int ai = 0; ai < 2; ++ai)
#pragma unroll
                for (int m = 0; m < 4; ++m) { bf16_t* rowp = base + (size_t)(row0 + ai * 128 + m * 16) * ld + cu;
#pragma unroll
                    for (int bj = 0; bj < 2; ++bj) { const f32x4 v0 = acc[ai][bj][m][0], v1 = acc[ai][bj][m][1];
                        u32x4 w; w.x = cvtpk(v0[0], v0[1]); w.y = cvtpk(v0[2], v0[3]); w.z = cvtpk(v1[0], v1[1]); w.w = cvtpk(v1[2], v1[3]);
                        *(u32x4*)(rowp + bj * 128) = w; } }
        } else {
            bf16_t* ckv = (bf16_t*)(ws + WS_CKV); bf16_t* kr = (bf16_t*)(ws + WS_KR); float* ga = (float*)(ws + WS_GA);
#pragma unroll
            for (int ai = 0; ai < 2; ++ai)
#pragma unroll
                for (int m = 0; m < 4; ++m) { const size_t row = (size_t)(row0 + ai * 128 + m * 16);
                    { const f32x4 v0 = acc[ai][0][m][0], v1 = acc[ai][0][m][1];
                      u32x4 w; w.x = cvtpk(v0[0], v0[1]); w.y = cvtpk(v0[2], v0[3]); w.z = cvtpk(v1[0], v1[1]); w.w = cvtpk(v1[2], v1[3]);
                      *(u32x4*)(ckv + row * 128 + cu) = w; }
                    { const f32x4 v0 = acc[ai][1][m][0], v1 = acc[ai][1][m][1];
                      if (wc < 2) { u32x4 w; w.x = cvtpk(v0[0], v0[1]); w.y = cvtpk(v0[2], v0[3]); w.z = cvtpk(v1[0], v1[1]); w.w = cvtpk(v1[2], v1[3]);
                          *(u32x4*)(kr + row * 64 + cu) = w; }
                      else if (wc == 2) { *(f32x4*)(ga + row * 32 + 8 * fq) = v0; *(f32x4*)(ga + row * 32 + 8 * fq + 4) = v1; } } }
        }
    }
};
struct EpiY {
    static constexpr bool PERM = true, AFTER_DRAIN = false;
    bf16_t* Y;
    __device__ __forceinline__ void operator()(const f32x4 (&acc)[2][2][4][2], const pg8::Unit& u, int wr, int wc, int fr_, int fq_) const {
        int fr = fr_, fq = fq_; asm volatile("" : "+v"(fr), "+v"(fq));
        const int row0 = u.pm * 256 + wr * 64 + fr, col0 = u.pn * 256 + 32 * wc + 8 * fq;
#pragma unroll
        for (int ai = 0; ai < 2; ++ai)
#pragma unroll
            for (int m = 0; m < 4; ++m) { bf16_t* rowp = Y + (size_t)(row0 + ai * 128 + m * 16) * 1024 + col0;
#pragma unroll
                for (int bj = 0; bj < 2; ++bj) { const f32x4 v0 = acc[ai][bj][m][0], v1 = acc[ai][bj][m][1];
                    u32x4 w; w.x = cvtpk(v0[0], v0[1]); w.y = cvtpk(v0[2], v0[3]); w.z = cvtpk(v1[0], v1[1]); w.w = cvtpk(v1[2], v1[3]);
                    *(u32x4*)(rowp + bj * 128) = w; } }
    }
};
template <bool KV> struct EpiUp {
    static constexpr bool PERM = true, AFTER_DRAIN = false;
    unsigned char* ws;
    __device__ __forceinline__ void operator()(const f32x4 (&acc)[2][2][4][2], const pg8::Unit& u, int wr, int wc, int fr_, int fq_) const {
        int fr = fr_, fq = fq_; asm volatile("" : "+v"(fr), "+v"(fq));
        const int row0 = u.pm * 256 + wr * 64 + fr, pn = u.pn;
        bf16_t* Q = (bf16_t*)(ws + WS_Q); bf16_t* K = (bf16_t*)(ws + WS_K); bf16_t* V = (bf16_t*)(ws + WS_V);
        const float* RS = (const float*)(ws + WS_RS); const f32x2* ROPE = (const f32x2*)(ws + WS_ROPE);
#pragma unroll
        for (int ai = 0; ai < 2; ++ai)
#pragma unroll
            for (int m = 0; m < 4; ++m) { const int row = row0 + ai * 128 + m * 16, b = row >> 12, s = row & 4095;
                const f32x2 rs = *(const f32x2*)(RS + 2 * (size_t)row);
#pragma unroll
                for (int bj = 0; bj < 2; ++bj) { f32x4 v0 = acc[ai][bj][m][0], v1 = acc[ai][bj][m][1];
                    if (!KV) {
                        v0 = v0 * rs.x; v1 = v1 * rs.x;
                        const int n = 256 * pn + 128 * bj + 32 * wc + 8 * fq, hh = n / 192, j = n - hh * 192;
                        bf16_t* qrow = Q + ((size_t)(b * 4 + hh) * 4096 + s) * 192;
                        if (j < 128) { u32x4 w; w.x = cvtpk(v0[0], v0[1]); w.y = cvtpk(v0[2], v0[3]); w.z = cvtpk(v1[0], v1[1]); w.w = cvtpk(v1[2], v1[3]);
                            *(u32x4*)(qrow + j) = w; }
                        else { const int i0 = (j - 128) >> 1;
                            const f32x4 c01 = *(const f32x4*)(ROPE + (size_t)row * 32 + i0), c23 = *(const f32x4*)(ROPE + (size_t)row * 32 + i0 + 2);
                            const float cs[4] = {c01[0], c01[2], c23[0], c23[2]}, sn[4] = {c01[1], c01[3], c23[1], c23[3]};
                            float o1[4], o2[4];
#pragma unroll
                            for (int q = 0; q < 4; ++q) { o1[q] = v0[q] * cs[q] - v1[q] * sn[q]; o2[q] = v1[q] * cs[q] + v0[q] * sn[q]; }
                            u32x2 w1, w2; w1.x = cvtpk(o1[0], o1[1]); w1.y = cvtpk(o1[2], o1[3]); w2.x = cvtpk(o2[0], o2[1]); w2.y = cvtpk(o2[2], o2[3]);
                            *(u32x2*)(qrow + 128 + i0) = w1; *(u32x2*)(qrow + 160 + i0) = w2; }
                    } else {
                        v0 = v0 * rs.y; v1 = v1 * rs.y; const int hh = pn, jj = 32 * wc + 8 * fq;
                        u32x4 w; w.x = cvtpk(v0[0], v0[1]); w.y = cvtpk(v0[2], v0[3]); w.z = cvtpk(v1[0], v1[1]); w.w = cvtpk(v1[2], v1[3]);
                        if (bj == 0) *(u32x4*)(K + ((size_t)(b * 4 + hh) * 4096 + s) * 192 + jj) = w;
                        else         *(u32x4*)(V + ((size_t)(b * 4 + hh) * 4096 + s) * 128 + jj) = w;
                    } }
                asm volatile("" ::: "memory"); }
    }
};
struct EpiOddIn {
    static constexpr bool PERM = true, AFTER_DRAIN = false;
    unsigned char* ws;
    __device__ __forceinline__ void operator()(const f32x4 (&acc)[2][2][4][2], const pg8::Unit& u, int wr, int wc, int fr_, int fq_) const {
        int fr = fr_, fq = fq_; asm volatile("" : "+v"(fr), "+v"(fq));
        const int row0 = u.pm * 256 + wr * 64 + fr, pn = u.pn, cu = 32 * wc + 8 * fq;
        typedef float f2 __attribute__((ext_vector_type(2)));
        if (pn < 16) {
            bf16_t* UZ = (bf16_t*)(ws + WS_UZ);
#pragma unroll
            for (int ai = 0; ai < 2; ++ai)
#pragma unroll
                for (int m = 0; m < 4; ++m) { const size_t row = (size_t)(row0 + ai * 128 + m * 16); float o[8];
#pragma unroll
                    for (int n = 0; n < 2; ++n) { const f32x4 uu = acc[ai][0][m][n], zz = acc[ai][1][m][n];
                        const f2 ga = pg8::gelu_pk((f2){uu[0], uu[1]}), gb = pg8::gelu_pk((f2){uu[2], uu[3]});
                        o[4 * n + 0] = ga.x * silu_f(zz[0]); o[4 * n + 1] = ga.y * silu_f(zz[1]); o[4 * n + 2] = gb.x * silu_f(zz[2]); o[4 * n + 3] = gb.y * silu_f(zz[3]); }
                    *(u32x4*)(UZ + row * 2048 + 128 * pn + cu) = pack8(o); }
        } else {
            bf16_t* V2 = (bf16_t*)(ws + WS_V2); f32x2* PART = (f32x2*)(ws + WS_PART);
#pragma unroll
            for (int ai = 0; ai < 2; ++ai)
#pragma unroll
                for (int m = 0; m < 4; ++m) { const size_t row = (size_t)(row0 + ai * 128 + m * 16); float s = 0.f, ss = 0.f;
#pragma unroll
                    for (int bj = 0; bj < 2; ++bj) { float o[8];
#pragma unroll
                        for (int n = 0; n < 2; ++n) { const f32x4 vv = acc[ai][bj][m][n];
                            const f2 ga = pg8::gelu_pk((f2){vv[0], vv[1]}), gb = pg8::gelu_pk((f2){vv[2], vv[3]});
                            o[4 * n + 0] = ga.x; o[4 * n + 1] = ga.y; o[4 * n + 2] = gb.x; o[4 * n + 3] = gb.y; }
#pragma unroll
                        for (int q = 0; q < 8; ++q) { s += o[q]; ss += o[q] * o[q]; }
                        *(u32x4*)(V2 + row * 2048 + 256 * (pn - 16) + 128 * bj + cu) = pack8(o); }
                    s += __shfl_xor(s, 16); ss += __shfl_xor(ss, 16); s += __shfl_xor(s, 32); ss += __shfl_xor(ss, 32);
                    if (fq == 0) PART[row * 32 + (pn - 16) * 4 + wc] = (f32x2){s, ss}; }
        }
    }
};

__device__ __forceinline__ void rs_rope_phase(const Params& p) {
    const int tid = tid_fresh(), lane = tid & 63, wave = tid >> 6, sub = lane & 7, rg = lane >> 3;
    unsigned char* ws = p.ws;
    const bf16_t* CQ = (const bf16_t*)(ws + WS_CQ); const bf16_t* CKV = (const bf16_t*)(ws + WS_CKV); const bf16_t* KR = (const bf16_t*)(ws + WS_KR);
    float* RS = (float*)(ws + WS_RS); const f32x2* ROPE = (const f32x2*)(ws + WS_ROPE); bf16_t* K = (bf16_t*)(ws + WS_K);
    for (int row0 = (blockIdx.x * 8 + wave) * 8; row0 < T_; row0 += gridDim.x * 64) {
        const int row = row0 + rg, b = row >> 12, s = row & 4095;
        float sq = 0.f, sk = 0.f;
#pragma unroll
        for (int q = 0; q < 4; ++q) { const u32x4 a = *(const u32x4*)(CQ + (size_t)row * 256 + sub * 32 + 8 * q); float f[8]; unpack8(a, f);
#pragma unroll
            for (int j = 0; j < 8; ++j) sq += f[j] * f[j]; }
#pragma unroll
        for (int q = 0; q < 2; ++q) { const u32x4 a = *(const u32x4*)(CKV + (size_t)row * 128 + sub * 16 + 8 * q); float f[8]; unpack8(a, f);
#pragma unroll
            for (int j = 0; j < 8; ++j) sk += f[j] * f[j]; }
        sq += __shfl_xor(sq, 1); sk += __shfl_xor(sk, 1); sq += __shfl_xor(sq, 2); sk += __shfl_xor(sk, 2); sq += __shfl_xor(sq, 4); sk += __shfl_xor(sk, 4);
        if (sub == 0) { f32x2 o; o.x = rsqrtf(sq * (1.0f / 256.0f) + EPS); o.y = rsqrtf(sk * (1.0f / 128.0f) + EPS); *(f32x2*)(RS + 2 * (size_t)row) = o; }
        const int i0 = 4 * sub;
        const u32x2 x1w = *(const u32x2*)(KR + (size_t)row * 64 + i0), x2w = *(const u32x2*)(KR + (size_t)row * 64 + 32 + i0);
        const f32x4 c01 = *(const f32x4*)(ROPE + (size_t)row * 32 + i0), c23 = *(const f32x4*)(ROPE + (size_t)row * 32 + i0 + 2);
        const float x1[4] = {bflo(x1w.x), bfhi(x1w.x), bflo(x1w.y), bfhi(x1w.y)}, x2[4] = {bflo(x2w.x), bfhi(x2w.x), bflo(x2w.y), bfhi(x2w.y)};
        const float cs[4] = {c01[0], c01[2], c23[0], c23[2]}, sn[4] = {c01[1], c01[3], c23[1], c23[3]};
        float o1[4], o2[4];
#pragma unroll
        for (int j = 0; j < 4; ++j) { o1[j] = x1[j] * cs[j] - x2[j] * sn[j]; o2[j] = x2[j] * cs[j] + x1[j] * sn[j]; }
        u32x2 w1, w2; w1.x = cvtpk(o1[0], o1[1]); w1.y = cvtpk(o1[2], o1[3]); w2.x = cvtpk(o2[0], o2[1]); w2.y = cvtpk(o2[2], o2[3]);
#pragma unroll
        for (int h = 0; h < 4; ++h) { bf16_t* kp = K + ((size_t)(b * 4 + h) * 4096 + s) * 192 + 128; *(u32x2*)(kp + i0) = w1; *(u32x2*)(kp + 32 + i0) = w2; }
    }
}

constexpr int GL_QF = 0, GL_KF = 9216, GL_QB = 18432, GL_KB = 27648, GL_VT = 36864, GL_ATT = 55296, GL_GRP = 64512, GL_W2 = 129024, GL_B2 = 137216, GL_ROW = 144;
static_assert(GL_B2 + 512 <= LDS_BYTES, "gla lds");

__device__ __forceinline__ void gla_stage_w2(const Params& p, int e, int h, LAS unsigned char* lds) {
    LAS float* W2L = (LAS float*)(lds + GL_W2); LAS float* B2L = (LAS float*)(lds + GL_B2);
    const int tid = tid_fresh();
    for (int idx = tid; idx < 2048; idx += 512) { const int dir = idx >> 10, d = (idx >> 4) & 63, r = idx & 15;
        W2L[idx] = p.in[dir ? I_W2B : I_W2F][((size_t)e * 16 + r) * 256 + h * 64 + d]; }
    if (tid < 128) { const int dir = tid >> 6, d = tid & 63; B2L[tid] = p.in[dir ? I_B2B : I_B2F][e * 256 + h * 64 + d]; }
}
__device__ __forceinline__ void gla_stage_vt(const Params& p, int b, int h, int chunk, LAS unsigned char* G, int gt) {
    const bf16_t* GV = (const bf16_t*)(p.ws + WS_GV);
    const int wv = gt >> 6, ln = gt & 63, c0 = 8 * ((ln >> 4) + 4 * wv);
#pragma unroll
    for (int i = 0; i < 2; ++i) { const int tp = (ln & 15) + 16 * i; const size_t tokA = (size_t)b * 4096 + chunk * 64 + 2 * tp;
        const u32x4 ra = *(const u32x4*)(GV + tokA * 512 + h * 128 + c0), rb = *(const u32x4*)(GV + (tokA + 1) * 512 + h * 128 + c0);
        const unsigned wa[4] = {ra.x, ra.y, ra.z, ra.w}, wb[4] = {rb.x, rb.y, rb.z, rb.w};
#pragma unroll
        for (int q = 0; q < 4; ++q) { const unsigned lo = (wa[q] & 0xffffu) | (wb[q] << 16), hi = (wa[q] >> 16) | (wb[q] & 0xffff0000u);
            *(LAS unsigned*)(G + GL_VT + (c0 + 2 * q) * GL_ROW + 4 * tp) = lo; *(LAS unsigned*)(G + GL_VT + (c0 + 2 * q + 1) * GL_ROW + 4 * tp) = hi; } }
}
__device__ __forceinline__ void gla_stage_ga(const Params& p, int b, int chunk, LAS unsigned char* G, int gt) {
    const float* ga = (const float*)(p.ws + WS_GA) + ((size_t)b * 4096 + chunk * 64) * 32;
#pragma unroll
    for (int i = 0; i < 2; ++i) { const int pc = gt + 256 * i; *(LAS f32x4*)(G + GL_ATT + (pc >> 3) * GL_ROW + (pc & 7) * 16) = *(const f32x4*)(ga + pc * 4); }
}
template <int CTRL, int ROWMASK> __device__ __forceinline__ float dpp_f(float src) {
    return __int_as_float(__builtin_amdgcn_update_dpp(0, __float_as_int(src), CTRL, ROWMASK, 0xf, false)); }
__device__ __forceinline__ float wave_incl_scan(float v) {
    v += dpp_f<0x111, 0xf>(v); v += dpp_f<0x112, 0xf>(v); v += dpp_f<0x114, 0xf>(v); v += dpp_f<0x118, 0xf>(v);
    v += dpp_f<0x142, 0xa>(v);
    v += dpp_f<0x143, 0xc>(v);
    return v; }
template <bool FOR_A>
__device__ __forceinline__ void gla_prep(const Params& p, int e, int b, int h, int chunk, LAS unsigned char* lds, LAS unsigned char* G, int wv, int lane) {
    const LAS float* W2L = (const LAS float*)(lds + GL_W2); const LAS float* B2L = (const LAS float*)(lds + GL_B2);
    const size_t tok = (size_t)b * 4096 + chunk * 64 + lane;
    float af[16], ab[16];
#pragma unroll
    for (int q = 0; q < 4; ++q) { const f32x4 x = *(const LAS f32x4*)(G + GL_ATT + lane * GL_ROW + 16 * q), y = *(const LAS f32x4*)(G + GL_ATT + lane * GL_ROW + 64 + 16 * q);
        af[4 * q] = x[0]; af[4 * q + 1] = x[1]; af[4 * q + 2] = x[2]; af[4 * q + 3] = x[3]; ab[4 * q] = y[0]; ab[4 * q + 1] = y[1]; ab[4 * q + 2] = y[2]; ab[4 * q + 3] = y[3]; }
    float pf[16], pb[16], gbv[16];
#pragma unroll
    for (int dd = 0; dd < 16; ++dd) { const int d = 16 * wv + dd; float xf = B2L[d], xb = B2L[64 + d];
#pragma unroll
        for (int q = 0; q < 4; ++q) { const f32x4 wf = *(const LAS f32x4*)(W2L + d * 16 + 4 * q), wb = *(const LAS f32x4*)(W2L + 1024 + d * 16 + 4 * q);
            xf += af[4 * q] * wf[0] + af[4 * q + 1] * wf[1] + af[4 * q + 2] * wf[2] + af[4 * q + 3] * wf[3];
            xb += ab[4 * q] * wb[0] + ab[4 * q + 1] * wb[1] + ab[4 * q + 2] * wb[2] + ab[4 * q + 3] * wb[3]; }
        pf[dd] = logsig_f(xf) * 0.0625f; gbv[dd] = logsig_f(xb) * 0.0625f; pb[dd] = gbv[dd]; }
#pragma unroll
    for (int dd = 0; dd < 16; ++dd) { pf[dd] = wave_incl_scan(pf[dd]); pb[dd] = wave_incl_scan(pb[dd]); }
#pragma unroll
    for (int dd = 0; dd < 16; ++dd) { const float tot = __int_as_float(__builtin_amdgcn_readlane(__float_as_int(pb[dd]), 63)); pb[dd] = tot - pb[dd] + gbv[dd]; }
    if (FOR_A) {
        float* EV = (float*)(p.ws + WS_EV);
#pragma unroll
        for (int dd = 0; dd < 16; ++dd) { const float tf = __int_as_float(__builtin_amdgcn_readlane(__float_as_int(pf[dd]), 63)), tb = __int_as_float(__builtin_amdgcn_readlane(__float_as_int(pb[dd]), 0));
            if (lane == 0) { EV[((size_t)((b * 4 + h) * 2 + 0) * 64 + chunk) * 64 + 16 * wv + dd] = __expf(tf); EV[((size_t)((b * 4 + h) * 2 + 1) * 64 + chunk) * 64 + 16 * wv + dd] = __expf(tb); } }
    }
#ifdef DBG_MAXP
    if (FOR_A) { float mx = 0.f;
        for (int dd = 0; dd < 16; ++dd) { mx = fmaxf(mx, DBG_MAXP); }
        atomicMax((int*)(p.ws + WS_PART) + 41, __float_as_int(mx)); }
#endif
    float kv[16], qv[16];
    { const bf16_t* kp = (const bf16_t*)(p.ws + WS_GK) + tok * 256 + h * 64 + 16 * wv; const u32x4 k0 = *(const u32x4*)kp, k1 = *(const u32x4*)(kp + 8);
      float t0[8], t1[8]; unpack8(k0, t0); unpack8(k1, t1);
#pragma unroll
      for (int q = 0; q < 8; ++q) { kv[q] = t0[q]; kv[8 + q] = t1[q]; } }
    if (!FOR_A) { const bf16_t* qp = (const bf16_t*)(p.ws + WS_GQ) + tok * 256 + h * 64 + 16 * wv; const u32x4 q0 = *(const u32x4*)qp, q1 = *(const u32x4*)(qp + 8);
      float t0[8], t1[8]; unpack8(q0, t0); unpack8(q1, t1);
#pragma unroll
      for (int q = 0; q < 8; ++q) { qv[q] = t0[q] * 0.125f; qv[8 + q] = t1[q] * 0.125f; } }
    if (FOR_A) {
#pragma unroll
        for (int dd = 0; dd < 16; ++dd) { const int d = 16 * wv + dd;
#ifdef DBG_NOEXP
            const float kf = kv[dd], kb = kv[dd];
#else
            const float kf = kv[dd] * __expf(-pf[dd]), kb = kv[dd] * __expf(-pb[dd]);
#endif
#ifdef DBG_KEXPR
            { const float vv = DBG_KEXPR; const float mv = (vv != vv) ? 7.7e7f : fabsf(vv); atomicMax((int*)(p.ws + WS_PART) + 41, __float_as_int(mv)); }
#endif

            *(LAS bf16_t*)(G + GL_QF + d * GL_ROW + 2 * lane) = (bf16_t)(cvtpk(kf, kf) & 0xffff);
            *(LAS bf16_t*)(G + GL_KF + d * GL_ROW + 2 * lane) = (bf16_t)(cvtpk(kb, kb) & 0xffff); }
    } else {
        float o[8];
#define GLA_PUT(OFF, EXPR0) do { _Pragma("unroll") for (int hf = 0; hf < 2; ++hf) { _Pragma("unroll") for (int q = 0; q < 8; ++q) { const int dd = 8 * hf + q; o[q] = (EXPR0); } \
            *(LAS u32x4*)(G + (OFF) + lane * GL_ROW + (16 * wv + 8 * hf) * 2) = pack8(o); } } while (0)
        GLA_PUT(GL_QF, qv[dd] * __expf(pf[dd]));
        GLA_PUT(GL_KF, kv[dd] * __expf(-pf[dd]));
        GLA_PUT(GL_QB, qv[dd] * __expf(pb[dd]));
        GLA_PUT(GL_KB, kv[dd] * __expf(-pb[dd]));
#undef GLA_PUT
    }
}

__device__ __forceinline__ void gla_a_phase(const Params& p, int e, LAS unsigned char* lds) {
    const int tid = tid_fresh(), grp = __builtin_amdgcn_readfirstlane(tid >> 8), wv = __builtin_amdgcn_readfirstlane((tid & 255) >> 6);
    LAS unsigned char* G = lds + grp * GL_GRP;
    bf16_t* ST = (bf16_t*)(p.ws + WS_ST);
    int h_staged = -1;
    for (int it = blockIdx.x; it < 1024; it += gridDim.x) {
        int lane = tid & 63; asm volatile("" : "+v"(lane));
        const int gt = 64 * wv + lane, tq = lane & 15, quad = lane >> 4;
        const int b = it >> 7, h = (it >> 5) & 3, chunk = 2 * (it & 31) + grp;
        __syncthreads();
        if (h != h_staged) { gla_stage_w2(p, e, h, lds); h_staged = h; }
        gla_stage_ga(p, b, chunk, G, gt);
        __syncthreads();
        gla_prep<true>(p, e, b, h, chunk, lds, G, wv, lane);
        gla_stage_vt(p, b, h, chunk, G, gt);
        __syncthreads();
        const int dir = wv >> 1, ch = wv & 1;
        LAS unsigned char* KT = G + (dir ? GL_KF : GL_QF);
        f32x4 acc[4][4];
#pragma unroll
        for (int mb = 0; mb < 4; ++mb)
#pragma unroll
            for (int nb = 0; nb < 4; ++nb) acc[mb][nb] = (f32x4){0.f, 0.f, 0.f, 0.f};
#pragma unroll
        for (int ks = 0; ks < 2; ++ks) { bf16x8 a[4], bb[4];
#pragma unroll
            for (int mb = 0; mb < 4; ++mb) a[mb] = *(const LAS bf16x8*)(KT + (16 * mb + tq) * GL_ROW + (32 * ks + 8 * quad) * 2);
#pragma unroll
            for (int nb = 0; nb < 4; ++nb) bb[nb] = *(const LAS bf16x8*)(G + GL_VT + (64 * ch + 16 * nb + tq) * GL_ROW + (32 * ks + 8 * quad) * 2);
#pragma unroll
            for (int mb = 0; mb < 4; ++mb)
#pragma unroll
                for (int nb = 0; nb < 4; ++nb) acc[mb][nb] = MFMA16(a[mb], bb[nb], acc[mb][nb]); }
        bf16_t* slot = ST + ((size_t)((b * 4 + h) * 2 + dir) * 64 + chunk) * 8192;
#pragma unroll
        for (int mb = 0; mb < 4; ++mb)
#pragma unroll
            for (int nb = 0; nb < 4; ++nb) { const int c = 64 * ch + 16 * nb + tq, d = 16 * mb + 4 * quad; const f32x4 v = acc[mb][nb];
                u32x2 w; w.x = cvtpk(v[0], v[1]); w.y = cvtpk(v[2], v[3]); *(u32x2*)(slot + c * 64 + d) = w; }
    }
}
__device__ __forceinline__ void gla_b_phase(const Params& p, bool dry = false) {
    bf16_t* ST = (bf16_t*)(p.ws + WS_ST); const float* EV = (const float*)(p.ws + WS_EV);
    const int tid = tid_fresh();
    for (int e = blockIdx.x * 512 + tid; e < 131072; e += gridDim.x * 512) {
        const int seq = e >> 11, within = e & 2047, dq = within & 15, dir = seq & 1;
        bf16_t* sp = ST + (size_t)seq * 64 * 8192 + within * 4; const float* ep = EV + (size_t)seq * 64 * 64 + dq * 4;
        float S0 = 0.f, S1 = 0.f, S2 = 0.f, S3 = 0.f;
        for (int k0 = 0; k0 < 64; k0 += 8) { u32x2 uu[8]; f32x4 ee[8];
#pragma unroll
            for (int q = 0; q < 8; ++q) { const int ck = dir ? 63 - (k0 + q) : (k0 + q); uu[q] = *(const u32x2*)(sp + (size_t)ck * 8192); ee[q] = *(const f32x4*)(ep + ck * 64); }
#pragma unroll
            for (int q = 0; q < 8; ++q) { const int ck = dir ? 63 - (k0 + q) : (k0 + q);
                u32x2 w; w.x = cvtpk(S0, S1); w.y = cvtpk(S2, S3); if (!dry || S0 == 1.2345e33f) *(u32x2*)(sp + (size_t)ck * 8192) = w;
                S0 = ee[q][0] * (S0 + bflo(uu[q].x)); S1 = ee[q][1] * (S1 + bfhi(uu[q].x)); S2 = ee[q][2] * (S2 + bflo(uu[q].y)); S3 = ee[q][3] * (S3 + bfhi(uu[q].y)); } }
    }
}
__device__ __forceinline__ void gla_c_phase(const Params& p, int e, LAS unsigned char* lds) {
    const int tid = tid_fresh(), grp = __builtin_amdgcn_readfirstlane(tid >> 8), wv = __builtin_amdgcn_readfirstlane((tid & 255) >> 6);
    LAS unsigned char* G = lds + grp * GL_GRP;
    const bf16_t* ST = (const bf16_t*)(p.ws + WS_ST); const bf16_t* GZ = (const bf16_t*)(p.ws + WS_GZ); bf16_t* O = (bf16_t*)(p.ws + WS_H);
    int h_staged = -1;
    for (int it = blockIdx.x; it < 1024; it += gridDim.x) {
        int lane = tid & 63; asm volatile("" : "+v"(lane));
        const int gt = 64 * wv + lane, tq = lane & 15, quad = lane >> 4;
        const int b = it >> 7, h = (it >> 5) & 3, chunk = 2 * (it & 31) + grp;
        __syncthreads();
        if (h != h_staged) { gla_stage_w2(p, e, h, lds); h_staged = h; }
        gla_stage_ga(p, b, chunk, G, gt);
        __syncthreads();
        gla_prep<false>(p, e, b, h, chunk, lds, G, wv, lane);
        gla_stage_vt(p, b, h, chunk, G, gt);
        __syncthreads();
        const int t = 16 * wv + tq;
        u32x4 stf[4], stb[4];
        { const bf16_t* slf = ST + ((size_t)((b * 4 + h) * 2 + 0) * 64 + chunk) * 8192; const bf16_t* slb = ST + ((size_t)((b * 4 + h) * 2 + 1) * 64 + chunk) * 8192;
#pragma unroll
          for (int i = 0; i < 4; ++i) { const int pc = gt + 256 * i; stf[i] = *(const u32x4*)(slf + pc * 8); stb[i] = *(const u32x4*)(slb + pc * 8); } }
        bf16x8 bqf[2], bqb[2];
        {
            f32x4 sf[4], sb[4];
#pragma unroll
            for (int mb = 0; mb < 4; ++mb) { sf[mb] = (f32x4){0.f, 0.f, 0.f, 0.f}; sb[mb] = (f32x4){0.f, 0.f, 0.f, 0.f}; }
#pragma unroll
            for (int ks = 0; ks < 2; ++ks) { const int ko = (32 * ks + 8 * quad) * 2;
                bqf[ks] = *(const LAS bf16x8*)(G + GL_QF + t * GL_ROW + ko); bqb[ks] = *(const LAS bf16x8*)(G + GL_QB + t * GL_ROW + ko);
#pragma unroll
                for (int mb = 0; mb < 4; ++mb) { const bf16x8 akf = *(const LAS bf16x8*)(G + GL_KF + (16 * mb + tq) * GL_ROW + ko), akb = *(const LAS bf16x8*)(G + GL_KB + (16 * mb + tq) * GL_ROW + ko);
                    sf[mb] = MFMA16(akf, bqf[ks], sf[mb]); sb[mb] = MFMA16(akb, bqb[ks], sb[mb]); } }
#pragma unroll
            for (int mb = 0; mb < 4; ++mb) { const int s0 = 16 * mb + 4 * quad; float v[4];
#pragma unroll
                for (int j = 0; j < 4; ++j) v[j] = (s0 + j <= t) ? sf[mb][j] : sb[mb][j];
                u32x2 w; w.x = cvtpk(v[0], v[1]); w.y = cvtpk(v[2], v[3]); *(LAS u32x2*)(G + GL_ATT + t * GL_ROW + s0 * 2) = w; }
        }
        __syncthreads();
#pragma unroll
        for (int i = 0; i < 4; ++i) { const int pc = gt + 256 * i, c = pc >> 3, c8 = pc & 7;
            *(LAS u32x4*)(G + c * GL_ROW + c8 * 16) = stf[i]; *(LAS u32x4*)(G + 18432 + c * GL_ROW + c8 * 16) = stb[i]; }
        f32x4 o[8];
#pragma unroll
        for (int mb = 0; mb < 8; ++mb) o[mb] = (f32x4){0.f, 0.f, 0.f, 0.f};
        const int crow0 = 8 * (tq >> 2) + (tq & 3);
#pragma unroll
        for (int ks = 0; ks < 2; ++ks) { const int ko = (32 * ks + 8 * quad) * 2; const bf16x8 batt = *(const LAS bf16x8*)(G + GL_ATT + t * GL_ROW + ko);
#pragma unroll
            for (int mb = 0; mb < 8; ++mb) { const int c = 32 * (mb >> 1) + crow0 + 4 * (mb & 1);
                const bf16x8 av = *(const LAS bf16x8*)(G + GL_VT + c * GL_ROW + ko); o[mb] = MFMA16(av, batt, o[mb]); } }
        __syncthreads();
#pragma unroll
        for (int dir = 0; dir < 2; ++dir) {
#pragma unroll
            for (int ks = 0; ks < 2; ++ks) { const int ko = (32 * ks + 8 * quad) * 2; const bf16x8 bq = dir ? bqb[ks] : bqf[ks];
#pragma unroll
                for (int mb = 0; mb < 8; ++mb) { const int c = 32 * (mb >> 1) + crow0 + 4 * (mb & 1);
                    const bf16x8 as = *(const LAS bf16x8*)(G + dir * 18432 + c * GL_ROW + ko); o[mb] = MFMA16(as, bq, o[mb]); } } }
        float ss = 0.f;
#pragma unroll
        for (int mb = 0; mb < 8; ++mb) ss += o[mb][0] * o[mb][0] + o[mb][1] * o[mb][1] + o[mb][2] * o[mb][2] + o[mb][3] * o[mb][3];
        ss += __shfl_xor(ss, 16); ss += __shfl_xor(ss, 32);
        const float rs = rsqrtf(ss * (1.0f / 128.0f) + EPS);
        const size_t tok = (size_t)b * 4096 + chunk * 64 + t;
#pragma unroll
        for (int pp = 0; pp < 4; ++pp) { const int c0 = 32 * pp + 8 * quad;
            const u32x4 gzw = *(const u32x4*)(GZ + tok * 512 + h * 128 + c0); float z[8]; unpack8(gzw, z);
            const f32x4 g0 = *(const f32x4*)(p.in[I_GNORM] + e * 128 + c0), g1 = *(const f32x4*)(p.in[I_GNORM] + e * 128 + c0 + 4);
            float r[8];
#pragma unroll
            for (int j = 0; j < 4; ++j) { r[j] = o[2 * pp][j] * rs * g0[j] * silu_f(z[j]); r[4 + j] = o[2 * pp + 1][j] * rs * g1[j] * silu_f(z[4 + j]); }
            *(u32x4*)(O + tok * 1024 + h * 128 + c0) = pack8(r); }
    }
}

#ifndef ATT_EARLY
#define ATT_EARLY 1
#endif
namespace att {
constexpr int DQK = 192, DV = 128, NW = 8, QBLK = 32, KVBLK = 64;
constexpr float SCALE = 0.07216878364870323f;
constexpr float THR = 8.f;
constexpr int SDEPTH = ATT_SDEPTH;
constexpr int SHM_V = KVBLK * DV * 2, SHM_K = KVBLK * DQK * 2;
constexpr int SHM_QR = 2 * SHM_V + 2 * SHM_K + NW * 64 * 4;
constexpr int NQR = ATT_NQR;
constexpr int SHM_ATTN = SHM_QR + NW * (12 - NQR) * 1024;
#define KSWZ(row, colB) ((row) * 384 + ((colB) ^ (((row) & 7) << 4)))
#define SBAR() __builtin_amdgcn_sched_barrier(0)
__device__ __forceinline__ int crow(int r, int hi) { return (r & 3) + 8 * (r >> 2) + 4 * hi; }
__device__ __forceinline__ unsigned cvtpkv(float lo, float hi) { unsigned r; asm volatile("v_cvt_pk_bf16_f32 %0, %1, %2" : "=v"(r) : "v"(lo), "v"(hi)); return r; }

__device__ __forceinline__ void partialSM(f32x16& p0, f32x16& p1, float& m_reg, float& mn, float& alpha) {
  constexpr float C = SCALE * 1.4426950408889634f;
  float pmax = p0[0];
#pragma unroll
  for (int r = 1; r < 16; ++r) pmax = fmaxf(pmax, p0[r]);
#pragma unroll
  for (int r = 0; r < 16; ++r) pmax = fmaxf(pmax, p1[r]);
  { auto rr = __builtin_amdgcn_permlane32_swap(__float_as_uint(pmax), __float_as_uint(pmax), false, false);
    pmax = fmaxf(__uint_as_float(rr[0]), __uint_as_float(rr[1])); }
  if (__builtin_expect(__all(pmax - m_reg <= THR / SCALE), 1)) { mn = m_reg; alpha = 1.f; }
  else { mn = fmaxf(m_reg, pmax); alpha = __builtin_amdgcn_exp2f((m_reg - mn) * C); m_reg = mn; }
  float mnC = -mn * C;
#pragma unroll
  for (int r = 0; r < 16; ++r) p0[r] = fmaf(p0[r], C, mnC);
#pragma unroll
  for (int r = 0; r < 16; ++r) p1[r] = fmaf(p1[r], C, mnC);
#pragma unroll
  for (int r = 0; r < 16; ++r) p0[r] = __builtin_amdgcn_exp2f(p0[r]);
}
__device__ __forceinline__ void finishSM(f32x16& p0, f32x16& p1, float alpha, float& l_reg, bf16x8& pa0, bf16x8& pa1, bf16x8& pa2, bf16x8& pa3) {
#pragma unroll
  for (int r = 0; r < 16; ++r) p1[r] = __builtin_amdgcn_exp2f(p1[r]);
  float ps = 0;
#pragma unroll
  for (int r = 0; r < 16; ++r) ps += p0[r];
#pragma unroll
  for (int r = 0; r < 16; ++r) ps += p1[r];
  { auto rr = __builtin_amdgcn_permlane32_swap(__float_as_uint(ps), __float_as_uint(ps), false, false);
    ps = __uint_as_float(rr[0]) + __uint_as_float(rr[1]); }
  l_reg = l_reg * alpha + ps;
#define PK4(P, BASE, OUT) do { unsigned a0 = cvtpkv(P[BASE + 0], P[BASE + 1]), a1 = cvtpkv(P[BASE + 2], P[BASE + 3]);   \
    unsigned b0 = cvtpkv(P[BASE + 4], P[BASE + 5]), b1 = cvtpkv(P[BASE + 6], P[BASE + 7]);                              \
    auto r0 = __builtin_amdgcn_permlane32_swap(a0, b0, false, false); auto r1 = __builtin_amdgcn_permlane32_swap(a1, b1, false, false); \
    u32x4 w = {r0[0], r1[0], r0[1], r1[1]}; OUT = *reinterpret_cast<bf16x8*>(&w); } while (0)
  PK4(p0, 0, pa0); PK4(p0, 8, pa1); PK4(p1, 0, pa2); PK4(p1, 8, pa3);
#undef PK4
}
__device__ __forceinline__ void qkt(f32x16& p0, f32x16& p1, const char* Ks, const bf16x8* qr, const char* qrl, int r32, int hi) {
  p0 = f32x16{}; p1 = f32x16{};
#pragma unroll
  for (int d0 = 0; d0 < 12; ++d0) { int cb = (d0 * 16 + hi * 8) * 2;
    bf16x8 b0 = *reinterpret_cast<const bf16x8*>(Ks + KSWZ(r32, cb));
    bf16x8 b1 = *reinterpret_cast<const bf16x8*>(Ks + KSWZ(32 + r32, cb));
    const bf16x8 q = d0 < NQR ? qr[d0 < NQR ? d0 : 0] : *reinterpret_cast<const bf16x8*>(qrl + (d0 - NQR) * 1024);
    p0 = __builtin_amdgcn_mfma_f32_32x32x16_bf16(b0, q, p0, 0, 0, 0);
    p1 = __builtin_amdgcn_mfma_f32_32x32x16_bf16(b1, q, p1, 0, 0, 0); }
}
__device__ __forceinline__ int v_st(int k, int c) { const int kk = (k & ~0xC) | ((k & 4) << 1) | ((k & 8) >> 1); return ((kk >> 3) * 4 + (c >> 5)) * 512 + ((kk & 7) * 32 + (c & 31)) * 2; }
__device__ __forceinline__ int v_rd_base(int lane) { return ((lane & 3) << 3) | (((lane >> 2) & 3) << 6) | (((lane >> 4) & 1) << 5) | (((lane >> 5) & 1) << 8); }
constexpr int v_rd_off(int d0, int ks, int half) { return d0 * 512 + ks * 4096 + half * 2048; }
template <int OFF> __device__ __forceinline__ s16x4 tr_read(int vb) {
  s16x4 r; asm volatile("ds_read_b64_tr_b16 %0, %1 offset:%2" : "=&v"(r) : "v"(vb), "i"(OFF) : "memory"); return r;
}
template <int D0> __device__ __forceinline__ void pv_one(f32x16& od, int vb, bf16x8 pa0, bf16x8 pa1, bf16x8 pa2, bf16x8 pa3) {
  const s16x4 l0 = tr_read<v_rd_off(D0, 0, 0)>(vb), h0 = tr_read<v_rd_off(D0, 0, 1)>(vb), l1 = tr_read<v_rd_off(D0, 1, 0)>(vb), h1 = tr_read<v_rd_off(D0, 1, 1)>(vb);
  const s16x4 l2 = tr_read<v_rd_off(D0, 2, 0)>(vb), h2 = tr_read<v_rd_off(D0, 2, 1)>(vb), l3 = tr_read<v_rd_off(D0, 3, 0)>(vb), h3 = tr_read<v_rd_off(D0, 3, 1)>(vb);
  asm volatile("s_waitcnt lgkmcnt(0)" ::: "memory"); SBAR();
#define PK(L, H) (bf16x8){L[0], L[1], L[2], L[3], H[0], H[1], H[2], H[3]}
  od = __builtin_amdgcn_mfma_f32_32x32x16_bf16(pa0, PK(l0, h0), od, 0, 0, 0);
  od = __builtin_amdgcn_mfma_f32_32x32x16_bf16(pa1, PK(l1, h1), od, 0, 0, 0);
  od = __builtin_amdgcn_mfma_f32_32x32x16_bf16(pa2, PK(l2, h2), od, 0, 0, 0);
  od = __builtin_amdgcn_mfma_f32_32x32x16_bf16(pa3, PK(l3, h3), od, 0, 0, 0);
#undef PK
}
__device__ __forceinline__ void pv_d0(f32x16* o, int vb, bf16x8 pa0, bf16x8 pa1, bf16x8 pa2, bf16x8 pa3) {
  pv_one<0>(o[0], vb, pa0, pa1, pa2, pa3); pv_one<1>(o[1], vb, pa0, pa1, pa2, pa3); pv_one<2>(o[2], vb, pa0, pa1, pa2, pa3); pv_one<3>(o[3], vb, pa0, pa1, pa2, pa3);
}

template <int OFF> __device__ __forceinline__ bf16x8 lds_rd128(int a) { bf16x8 r; asm volatile("ds_read_b128 %0, %1 offset:%2" : "=&v"(r) : "v"(a), "i"(OFF) : "memory"); return r; }
template <int N> __device__ __forceinline__ void lgkm_wait2(bf16x8& a, bf16x8& b) { asm volatile("s_waitcnt lgkmcnt(%2)" : "+v"(a), "+v"(b) : "n"(N) : "memory"); }
template <int N> __device__ __forceinline__ void lgkm_wait3(bf16x8& a, bf16x8& b, bf16x8& c) { asm volatile("s_waitcnt lgkmcnt(%3)" : "+v"(a), "+v"(b), "+v"(c) : "n"(N) : "memory"); }
template <int N> __device__ __forceinline__ void lgkm_wait2s(s16x4& a, s16x4& b) { asm volatile("s_waitcnt lgkmcnt(%2)" : "+v"(a), "+v"(b) : "n"(N) : "memory"); }
constexpr int k_off(int buf, int d0, int half) { return buf * SHM_K + (d0 >> 2) * 128 + half * 12288; }
constexpr int q_off(int d0) { return (d0 >= NQR ? d0 - NQR : 0) * 1024; }
template <int BUF, int D0> __device__ __forceinline__ void k_fetch(bf16x8& b0, bf16x8& b1, bf16x8& qx, const int (&ka)[4], int qa) {
  b0 = lds_rd128<k_off(BUF, D0, 0)>(ka[D0 & 3]); b1 = lds_rd128<k_off(BUF, D0, 1)>(ka[D0 & 3]);
  if constexpr (D0 >= NQR) qx = lds_rd128<q_off(D0)>(qa);
}
template <int BUF, int D0> __device__ __forceinline__ void qk_step(f32x16& p0, f32x16& p1, bf16x8 (&b0)[2], bf16x8 (&b1)[2], bf16x8 (&qx)[2], const bf16x8* qr, const int (&ka)[4], int qa) {
  if constexpr (D0 < 11) k_fetch<BUF, D0 + 1>(b0[(D0 + 1) & 1], b1[(D0 + 1) & 1], qx[(D0 + 1) & 1], ka, qa);
  constexpr int PEND = D0 < 11 ? (2 + ((D0 + 1) >= NQR ? 1 : 0)) : 0;
  if constexpr (D0 >= NQR) lgkm_wait3<PEND>(b0[D0 & 1], b1[D0 & 1], qx[D0 & 1]); else lgkm_wait2<PEND>(b0[D0 & 1], b1[D0 & 1]);
  const bf16x8 q = D0 < NQR ? qr[D0 < NQR ? D0 : 0] : qx[D0 & 1];
  p0 = __builtin_amdgcn_mfma_f32_32x32x16_bf16(b0[D0 & 1], q, p0, 0, 0, 0);
  p1 = __builtin_amdgcn_mfma_f32_32x32x16_bf16(b1[D0 & 1], q, p1, 0, 0, 0);
}
template <int BUF> __device__ __forceinline__ void qkt2(f32x16& p0, f32x16& p1, const bf16x8* qr, const int (&ka)[4], int qa) {
  p0 = f32x16{}; p1 = f32x16{};
  bf16x8 b0[2], b1[2], qx[2];
  k_fetch<BUF, 0>(b0[0], b1[0], qx[0], ka, qa);
  qk_step<BUF, 0>(p0, p1, b0, b1, qx, qr, ka, qa); qk_step<BUF, 1>(p0, p1, b0, b1, qx, qr, ka, qa); qk_step<BUF, 2>(p0, p1, b0, b1, qx, qr, ka, qa); qk_step<BUF, 3>(p0, p1, b0, b1, qx, qr, ka, qa);
  qk_step<BUF, 4>(p0, p1, b0, b1, qx, qr, ka, qa); qk_step<BUF, 5>(p0, p1, b0, b1, qx, qr, ka, qa); qk_step<BUF, 6>(p0, p1, b0, b1, qx, qr, ka, qa); qk_step<BUF, 7>(p0, p1, b0, b1, qx, qr, ka, qa);
  qk_step<BUF, 8>(p0, p1, b0, b1, qx, qr, ka, qa); qk_step<BUF, 9>(p0, p1, b0, b1, qx, qr, ka, qa); qk_step<BUF, 10>(p0, p1, b0, b1, qx, qr, ka, qa); qk_step<BUF, 11>(p0, p1, b0, b1, qx, qr, ka, qa);
}
template <int BUF, int S> __device__ __forceinline__ void v_fetch(s16x4& l, s16x4& h, int vb) {
  l = tr_read<BUF * SHM_V + v_rd_off(S & 3, S >> 2, 0)>(vb); h = tr_read<BUF * SHM_V + v_rd_off(S & 3, S >> 2, 1)>(vb);
}
template <int BUF, int S> __device__ __forceinline__ void pv_step(f32x16* o, s16x4 (&l)[3], s16x4 (&h)[3], int vb, const bf16x8 (&pa)[4]) {
  if constexpr (S + 2 < 16) v_fetch<BUF, S + 2>(l[(S + 2) % 3], h[(S + 2) % 3], vb);
  constexpr int PEND = S + 2 < 16 ? 4 : (S + 1 < 16 ? 2 : 0);
  lgkm_wait2s<PEND>(l[S % 3], h[S % 3]);
  const s16x4 L = l[S % 3], H = h[S % 3];
  o[S & 3] = __builtin_amdgcn_mfma_f32_32x32x16_bf16(pa[S >> 2], (bf16x8){L[0], L[1], L[2], L[3], H[0], H[1], H[2], H[3]}, o[S & 3], 0, 0, 0);
}
template <int BUF> __device__ __forceinline__ void pv2(f32x16* o, int vb, bf16x8 pa0, bf16x8 pa1, bf16x8 pa2, bf16x8 pa3) {
  s16x4 l[3], h[3]; const bf16x8 pa[4] = {pa0, pa1, pa2, pa3};
  v_fetch<BUF, 0>(l[0], h[0], vb); v_fetch<BUF, 1>(l[1], h[1], vb);
  pv_step<BUF, 0>(o, l, h, vb, pa); pv_step<BUF, 1>(o, l, h, vb, pa); pv_step<BUF, 2>(o, l, h, vb, pa); pv_step<BUF, 3>(o, l, h, vb, pa);
  pv_step<BUF, 4>(o, l, h, vb, pa); pv_step<BUF, 5>(o, l, h, vb, pa); pv_step<BUF, 6>(o, l, h, vb, pa); pv_step<BUF, 7>(o, l, h, vb, pa);
  pv_step<BUF, 8>(o, l, h, vb, pa); pv_step<BUF, 9>(o, l, h, vb, pa); pv_step<BUF, 10>(o, l, h, vb, pa); pv_step<BUF, 11>(o, l, h, vb, pa);
  pv_step<BUF, 12>(o, l, h, vb, pa); pv_step<BUF, 13>(o, l, h, vb, pa); pv_step<BUF, 14>(o, l, h, vb, pa); pv_step<BUF, 15>(o, l, h, vb, pa);
}

__device__ __forceinline__ void attn_body(const bf16_t* __restrict__ Qb, const bf16_t* __restrict__ Kh, const bf16_t* __restrict__ Vh,
                                          const bf16_t* __restrict__ MZb, bf16_t* __restrict__ Ob, int seq, char* lds) {
  const int tid = tid_fresh(), wid = __builtin_amdgcn_readfirstlane(tid >> 6), lane = tid & 63, r32 = lane & 31, hi = lane >> 5;
  char* V_lds = lds; char* K_lds = lds + 2 * SHM_V;
  float* wsl = (float*)(lds + 2 * SHM_V + 2 * SHM_K) + wid * 64; float* li_l = wsl; float* al_l = wsl + 32;
  float m_reg = -1e30f, l_reg = 0; f32x16 o[4] = {}; bf16x8 qr[NQR];
  char* qrl = lds + SHM_QR + wid * ((12 - NQR) * 1024) + lane * 16;
  const bf16_t* Qw = Qb + (long)(wid * QBLK + r32) * DQK + hi * 8;
#pragma unroll
  for (int d0 = 0; d0 < NQR; ++d0) qr[d0] = *reinterpret_cast<const bf16x8*>(Qw + d0 * 16);
#pragma unroll
  for (int d0 = NQR; d0 < 12; ++d0) *reinterpret_cast<bf16x8*>(qrl + (d0 - NQR) * 1024) = *reinterpret_cast<const bf16x8*>(Qw + d0 * 16);
  const int sr = tid >> 4, sc = (tid & 15) * 8, vst0 = v_st(sr, sc);
  const int sr2 = tid >> 3, sl2 = 16 + (tid & 7);
  const unsigned kg0 = sr * DQK + sc, kg2 = sr2 * DQK + sl2 * 8, voff0 = sr * DV + sc;
  const int kl0 = KSWZ(sr, sc * 2), kl2 = KSWZ(sr2, sl2 * 16);
  const int vb0 = (int)(uintptr_t)(LAS char*)V_lds + v_rd_base(lane);
  int ka[4]; { const int kbase = (int)(uintptr_t)(LAS char*)K_lds + r32 * 384;
#pragma unroll
    for (int j = 0; j < 4; ++j) ka[j] = kbase + ((j * 32 + hi * 16) ^ ((r32 & 7) << 4)); }
  const int qa = (int)(uintptr_t)(LAS char*)qrl;
  struct { bf16x8 vs0, vs1, ks0, ks1, ks2; } sr_[SDEPTH];
#define SLOAD(i, k0) do { const bf16_t* Kt = Kh + (size_t)(k0) * DQK; const bf16_t* Vt = Vh + (size_t)(k0) * DV; \
    sr_[i].vs0 = *(const bf16x8*)(Vt + voff0); sr_[i].vs1 = *(const bf16x8*)(Vt + voff0 + 32 * DV); \
    sr_[i].ks0 = *(const bf16x8*)(Kt + kg0); sr_[i].ks1 = *(const bf16x8*)(Kt + kg0 + 32 * DQK); sr_[i].ks2 = *(const bf16x8*)(Kt + kg2); } while (0)
#define SWRITE(b, i) do { *(bf16x8*)(V_lds + (b) * SHM_V + vst0) = sr_[i].vs0; *(bf16x8*)(V_lds + (b) * SHM_V + vst0 + 8192) = sr_[i].vs1; \
    *(bf16x8*)(K_lds + (b) * SHM_K + kl0) = sr_[i].ks0; *(bf16x8*)(K_lds + (b) * SHM_K + kl0 + 32 * 384) = sr_[i].ks1; *(bf16x8*)(K_lds + (b) * SHM_K + kl2) = sr_[i].ks2; } while (0)
#define SWAIT() do { if constexpr (SDEPTH == 2) asm volatile("s_waitcnt vmcnt(5)" ::: "memory"); else asm volatile("s_waitcnt vmcnt(0)" ::: "memory"); } while (0)
#define RESC(a) do { if (__any((a) < 1.f)) { if (hi == 0) al_l[r32] = (a); asm volatile("s_waitcnt lgkmcnt(0)" ::: "memory"); \
    _Pragma("unroll") for (int d = 0; d < 4; ++d) _Pragma("unroll") for (int r = 0; r < 16; ++r) o[d][r] *= al_l[crow(r, hi)]; } } while (0)
  f32x16 pA0, pA1, pB0, pB1; float mnA, mnB, alA, alB; bf16x8 pa0, pa1, pa2, pa3; const int NT = seq / KVBLK;
  constexpr int SE = 0, SO = SDEPTH - 1;
  SLOAD(SE, 0); asm volatile("s_waitcnt vmcnt(0)" ::: "memory"); SWRITE(0, SE); __syncthreads();
  qkt2<0>(pA0, pA1, qr, ka, qa); partialSM(pA0, pA1, m_reg, mnA, alA);
  SLOAD(SO, KVBLK); if constexpr (SDEPTH == 2) { if (2 < NT) SLOAD(SE, 2 * KVBLK); }
  SWAIT(); SWRITE(1, SO); __syncthreads();
  for (int j = 1; j + 1 < NT; j += 2) {
#if ATT_EARLY
    SBAR(); SLOAD(SO, (j + SDEPTH) * KVBLK); SBAR();
#endif
    SBAR(); qkt2<1>(pB0, pB1, qr, ka, qa);
    finishSM(pA0, pA1, alA, l_reg, pa0, pa1, pa2, pa3); SBAR();
#if !ATT_EARLY
    SLOAD(SO, (j + SDEPTH) * KVBLK); SBAR();
#endif
    pv2<0>(o, vb0, pa0, pa1, pa2, pa3); partialSM(pB0, pB1, m_reg, mnB, alB);
    __syncthreads(); SWAIT(); SWRITE(0, SE);
    RESC(alB); __syncthreads();
#if ATT_EARLY
    SBAR(); if (SDEPTH == 1 || j + 3 < NT) SLOAD(SE, (j + 1 + SDEPTH) * KVBLK); SBAR();
#endif
    SBAR(); qkt2<0>(pA0, pA1, qr, ka, qa);
    finishSM(pB0, pB1, alB, l_reg, pa0, pa1, pa2, pa3); SBAR();
#if !ATT_EARLY
    if (SDEPTH == 1 || j + 3 < NT) SLOAD(SE, (j + 1 + SDEPTH) * KVBLK); SBAR();
#endif
    pv2<1>(o, vb0, pa0, pa1, pa2, pa3); partialSM(pA0, pA1, m_reg, mnA, alA);
    __syncthreads(); SWAIT(); SWRITE(1, SO);
    RESC(alA); __syncthreads();
  }
  SBAR(); qkt2<1>(pB0, pB1, qr, ka, qa);
  finishSM(pA0, pA1, alA, l_reg, pa0, pa1, pa2, pa3); SBAR();
  pv2<0>(o, vb0, pa0, pa1, pa2, pa3); partialSM(pB0, pB1, m_reg, mnB, alB);
  __syncthreads(); RESC(alB);
  finishSM(pB0, pB1, alB, l_reg, pa0, pa1, pa2, pa3); SBAR();
  pv2<1>(o, vb0, pa0, pa1, pa2, pa3);
  if (hi == 0) li_l[r32] = l_reg; asm volatile("s_waitcnt lgkmcnt(0)" ::: "memory");
  float rli[16];
#pragma unroll
  for (int r = 0; r < 16; ++r) rli[r] = __builtin_amdgcn_rcpf(li_l[crow(r, hi)]);
  int hil = hi; asm volatile("" : "+v"(hil));
  bf16_t* Ow = Ob + (size_t)(wid * QBLK) * 1024; const bf16_t* Zw = MZb + (size_t)(wid * QBLK) * 512;
  const unsigned oo = 4 * hil * 1024 + r32, zo = 4 * hil * 512 + r32;
#pragma unroll
  for (int r = 0; r < 16; ++r) { const int ro = (r & 3) + 8 * (r >> 2);
#pragma unroll
    for (int d0 = 0; d0 < 4; ++d0) { const float z = bf2f(Zw[zo + (unsigned)(ro * 512 + d0 * 32)]); const float v = o[d0][r] * rli[r] * silu_f(z);
      Ow[oo + (unsigned)(ro * 1024 + d0 * 32)] = (bf16_t)(cvtpk(v, v) & 0xffff); } }
#undef SLOAD
#undef SWRITE
#undef SWAIT
#undef RESC
}
}

__device__ __forceinline__ void attn_phase(const Params& p, unsigned char* lds_generic) {
    const bf16_t* Q = (const bf16_t*)(p.ws + WS_Q); const bf16_t* K = (const bf16_t*)(p.ws + WS_K); const bf16_t* V = (const bf16_t*)(p.ws + WS_V);
    const bf16_t* MZ = (const bf16_t*)(p.ws + WS_MZ); bf16_t* O = (bf16_t*)(p.ws + WS_H);
    for (int it = blockIdx.x; it < 512; it += gridDim.x) {
        const int xcd = it & 7, r = it >> 3, bh = xcd * 4 + (r >> 4), qb = r & 15, b = bh >> 2, h = bh & 3;
        __syncthreads();
        const size_t tok0 = (size_t)b * 4096 + qb * 256;
        att::attn_body(Q + ((size_t)bh * 4096 + qb * 256) * 192, K + (size_t)bh * 4096 * 192, V + (size_t)bh * 4096 * 128,
                       MZ + tok0 * 512 + h * 128, O + tok0 * 1024 + 512 + h * 128, 4096, (char*)lds_generic);
    }
    __syncthreads();
}

constexpr int MX_WL = 0, MX_VT = 34816, MX_ST = 104448, MX_ROW = 272;
__device__ __forceinline__ void mix_phase(const Params& p, int oi, LAS unsigned char* lds, bool dry = false) {
    const int tid = tid_fresh(), w = __builtin_amdgcn_readfirstlane(tid >> 6), lane = tid & 63, tq = lane & 15, quad = lane >> 4;
    const bf16_t* Wsb = (const bf16_t*)(p.ws + WS_WS); const bf16_t* V2 = (const bf16_t*)(p.ws + WS_V2); bf16_t* UZ = (bf16_t*)(p.ws + WS_UZ);
    const f32x2* PART = (const f32x2*)(p.ws + WS_PART);
    LAS f32x2* STAT = (LAS f32x2*)(lds + MX_ST);
    const int per = 2048 / gridDim.x; int last_g = -1;
    for (int i = 0; i < per; ++i) {
        const int it = blockIdx.x * per + i, g = it >> 8, bn = it & 255, b = bn >> 5, n = bn & 31; const size_t tok0 = (size_t)b * 4096 + n * 128;
        __syncthreads();
        if (g != last_g) { last_g = g;
#pragma unroll
            for (int q = 0; q < 4; ++q) { const int pc = tid + 512 * q, row = pc >> 4, cgp = pc & 15;
                *(LAS u32x4*)(lds + MX_WL + row * MX_ROW + cgp * 16) = *(const u32x4*)(Wsb + ((size_t)(oi * 8 + g) * 128 + row) * 128 + cgp * 8); } }
        {
            const int tl = tid >> 2, part = tid & 3; const f32x4* pp = (const f32x4*)(PART + (tok0 + tl) * 32 + part * 8);
            const f32x4 p0 = pp[0], p1 = pp[1], p2 = pp[2], p3 = pp[3];
            float s = (p0[0] + p0[2]) + (p1[0] + p1[2]) + (p2[0] + p2[2]) + (p3[0] + p3[2]), ss = (p0[1] + p0[3]) + (p1[1] + p1[3]) + (p2[1] + p2[3]) + (p3[1] + p3[3]);
            s += __shfl_xor(s, 1); ss += __shfl_xor(ss, 1); s += __shfl_xor(s, 2); ss += __shfl_xor(ss, 2);
            const float mu = s * (1.0f / 2048.0f), var = ss * (1.0f / 2048.0f) - mu * mu; if (part == 0) STAT[tl] = (f32x2){mu, rsqrtf(var + EPS)}; }
        u32x4 uzw[8];
#pragma unroll
        for (int nb = 0; nb < 8; ++nb) uzw[nb] = *(const u32x4*)(UZ + (tok0 + 16 * nb + tq) * 2048 + g * 256 + 32 * w + 8 * quad);
        __syncthreads();
        {
            const int c0 = 8 * ((lane >> 4) + 4 * w);
            const f32x4 gl0 = *(const f32x4*)(p.in[I_SGG] + oi * 2048 + g * 256 + c0), gl1 = *(const f32x4*)(p.in[I_SGG] + oi * 2048 + g * 256 + c0 + 4);
            const f32x4 bl0 = *(const f32x4*)(p.in[I_SGB] + oi * 2048 + g * 256 + c0), bl1 = *(const f32x4*)(p.in[I_SGB] + oi * 2048 + g * 256 + c0 + 4);
#pragma unroll
            for (int q = 0; q < 4; ++q) { const int rp = (lane & 15) + 16 * q; const size_t tokA = tok0 + 2 * rp; const f32x2 sa = STAT[2 * rp], sb = STAT[2 * rp + 1];
                const u32x4 ra = *(const u32x4*)(V2 + tokA * 2048 + g * 256 + c0), rb = *(const u32x4*)(V2 + (tokA + 1) * 2048 + g * 256 + c0);
                float fa[8], fb[8]; unpack8(ra, fa); unpack8(rb, fb);
#pragma unroll
                for (int e = 0; e < 8; ++e) { const float gg = e < 4 ? gl0[e & 3] : gl1[e & 3], bb = e < 4 ? bl0[e & 3] : bl1[e & 3];
                    const float va = (fa[e] - sa.x) * sa.y * gg + bb, vb = (fb[e] - sb.x) * sb.y * gg + bb;
                    *(LAS unsigned*)(lds + MX_VT + (c0 + e) * MX_ROW + 4 * rp) = cvtpk(va, vb); } }
        }
        __syncthreads();
        bf16x8 A[2][4];
#pragma unroll
        for (int mb = 0; mb < 2; ++mb)
#pragma unroll
            for (int ks = 0; ks < 4; ++ks) { const int c = 32 * w + 8 * (tq >> 2) + 4 * mb + (tq & 3);
                A[mb][ks] = *(const LAS bf16x8*)(lds + MX_VT + c * MX_ROW + (32 * ks + 8 * quad) * 2); }
#pragma unroll
        for (int nb = 0; nb < 8; ++nb) {
            f32x4 a0 = (f32x4){0.f, 0.f, 0.f, 0.f}, a1 = (f32x4){0.f, 0.f, 0.f, 0.f};
#pragma unroll
            for (int ks = 0; ks < 4; ++ks) { const bf16x8 bw = *(const LAS bf16x8*)(lds + MX_WL + (16 * nb + tq) * MX_ROW + (32 * ks + 8 * quad) * 2);
                a0 = MFMA16(A[0][ks], bw, a0); a1 = MFMA16(A[1][ks], bw, a1); }
            const int ti = 16 * nb + tq; const size_t tok = tok0 + ti; const float bias = p.in[I_SGBS][(oi * 8 + g) * 128 + ti];
            bf16_t* up = UZ + tok * 2048 + g * 256 + 32 * w + 8 * quad;
            float f[8]; unpack8(uzw[nb], f);
#pragma unroll
            for (int j = 0; j < 4; ++j) { f[j] *= (a0[j] + bias); f[4 + j] *= (a1[j] + bias); }
            if (!dry || f[0] == 1.2345e33f) *(u32x4*)up = pack8(f);
        }
    }
    __syncthreads();
}

constexpr size_t WS_BAR = (WS_TOTAL + 255) / 256 * 256;
constexpr size_t WS_NEED = WS_BAR + (size_t)XCD_BAR_WORDS * 4;
__device__ __forceinline__ int opq(int x) { asm volatile("" : "+s"(x)); return x; }
__global__ void __launch_bounds__(512, 2) mega(Params p) {
    extern __shared__ __attribute__((aligned(16))) unsigned char lds_[];
    LAS unsigned char* lds = (LAS unsigned char*)lds_;
    cg::grid_group grid = cg::this_grid();
    const int lo = p.ph_lo, hi = p.ph_hi;
    unsigned char* ws = p.ws;
#ifdef ONLY_PH
#define IN(k) ((((k) - 2) % 10 + 2 == ONLY_PH || (k) == ONLY_PH) && lo <= (k) && (k) < hi)
#else
#define IN(k) (lo <= (k) && (k) < hi)
#endif
    volatile LAS unsigned* xb_st = (volatile LAS unsigned*)(lds + LDS_BYTES - 16);
    if (threadIdx.x < 4) xb_st[threadIdx.x] = 0u;
    __syncthreads();
    XcdBarrier xbar = xcd_barrier_post((unsigned*)(ws + WS_BAR), xb_st);
    if (p.ph_lo < 0) grid.sync();
#ifdef DBL_BAR
#define SEAM(k) do { if (IN(k) && IN((k) + 1)) { xcd_barrier(xbar); xcd_barrier(xbar); } } while (0)
#else
#define SEAM(k) do { if (IN(k) && IN((k) + 1)) xcd_barrier(xbar); } while (0)
#endif
#if defined(DBG_MAXP) || defined(DBG_KEXPR)
    if (blockIdx.x == 0 && threadIdx.x == 0) ((int*)(ws + WS_PART))[41] = 0;
#endif
#ifndef REP
#define REP 0
#endif
#define REPN(bit) (((REP) >> (bit)) & 1 ? 2 : 1)
    if (IN(0)) for (int rep = 0; rep < REPN(8); ++rep) p0_phase(p, lds);
    SEAM(0);
    if (IN(1)) for (int rep = 0; rep < (((REP) >> 10) & 1 ? 5 : 1); ++rep) norm_phase(p, -1, 0, nullptr, p.in[I_X]);
    SEAM(1);
    if (((REP) >> 11) & 1) for (int rep = 0; rep < 20; ++rep) grid.sync();
    for (int lp = 0; lp < 2; ++lp) {
        const int base = 2 + 10 * lp, le = 2 * lp, lod = 2 * lp + 1;
        if (IN(base + 0)) for (int rep = 0; rep < REPN(0); ++rep) {
            pg8::Gemm g{(const bf16_t*)(ws + WS_H), (const bf16_t*)(ws + WS_WINE) + (size_t)lp * 2560 * 1024, T_, opq(2560), opq(1024)};
            pg8::StaticOrder S; S.init(T_, 2560, (int)gridDim.x, (int)blockIdx.x); EpiEvenIn E{ws};
            pg8::gemm_phase<EpiEvenIn, pg8::StaticOrder, false>(lds, g, S, E, nullptr);
        }
        SEAM(base + 0);
        if (IN(base + 1)) { for (int rep = 0; rep < REPN(9); ++rep) rs_rope_phase(p); for (int rep = 0; rep < REPN(1); ++rep) gla_a_phase(p, lp, lds); }
        SEAM(base + 1);
        if (IN(base + 2)) {
          for (int rep = 0; rep < REPN(2); ++rep) {
            { pg8::Gemm g{(const bf16_t*)(ws + WS_CQ), (const bf16_t*)(ws + WS_WUP) + (size_t)lp * WUP_E, T_, opq(768), opq(256)};
              pg8::StaticOrder S; S.init(T_, 768, (int)gridDim.x, (int)blockIdx.x); EpiUp<false> E{ws};
              pg8::gemm_phase<EpiUp<false>, pg8::StaticOrder, false>(lds, g, S, E, nullptr); }
            { pg8::Gemm g{(const bf16_t*)(ws + WS_CKV), (const bf16_t*)(ws + WS_WUP) + (size_t)lp * WUP_E + WUP_KV, T_, opq(1024), opq(128)};
              pg8::StaticOrder S; S.init(T_, 1024, (int)gridDim.x, (int)blockIdx.x); EpiUp<true> E{ws};
              pg8::gemm_phase<EpiUp<true>, pg8::StaticOrder, false>(lds, g, S, E, nullptr); } }
            if (((REP) >> 12) & 1) gla_b_phase(p, true);
            gla_b_phase(p);
        }
        SEAM(base + 2);
        if (IN(base + 3)) {
#ifdef ATT_VAR
            attn_phase<ATT_VAR>(p, lds_);
#endif
            for (int rep = 0; rep < REPN(3); ++rep) attn_phase(p, lds_); for (int rep = 0; rep < REPN(4); ++rep) gla_c_phase(p, lp, lds); }
        SEAM(base + 3);
        if (IN(base + 4)) for (int rep = 0; rep < REPN(5); ++rep) {
            pg8::Gemm g{(const bf16_t*)(ws + WS_H), (const bf16_t*)(ws + WS_WOUTE) + (size_t)lp * 1024 * 1024, T_, opq(1024), opq(1024)};
            pg8::StaticOrder S; S.init(T_, 1024, (int)gridDim.x, (int)blockIdx.x); EpiY E{(bf16_t*)(ws + WS_YE)};
            pg8::gemm_phase<EpiY, pg8::StaticOrder, false>(lds, g, S, E, nullptr);
        }
        SEAM(base + 4);
        if (IN(base + 5)) norm_phase(p, le, le + 1, (const bf16_t*)(ws + WS_YE), le == 0 ? p.in[I_X] : p.out);
        SEAM(base + 5);
        if (IN(base + 6)) for (int rep = 0; rep < REPN(6); ++rep) {
            pg8::Gemm g{(const bf16_t*)(ws + WS_H), (const bf16_t*)(ws + WS_WINO) + (size_t)lp * 6144 * 1024, T_, opq(6144), opq(1024)};
            pg8::StaticOrder S; S.init(T_, 6144, (int)gridDim.x, (int)blockIdx.x); EpiOddIn E{ws};
            pg8::gemm_phase<EpiOddIn, pg8::StaticOrder, false>(lds, g, S, E, nullptr);
        }
        SEAM(base + 6);
        if (IN(base + 7)) { if (((REP) >> 13) & 1) mix_phase(p, lp, lds, true); mix_phase(p, lp, lds); }
        SEAM(base + 7);
        if (IN(base + 8)) for (int rep = 0; rep < REPN(7); ++rep) {
            pg8::Gemm g{(const bf16_t*)(ws + WS_UZ), (const bf16_t*)(ws + WS_WOUTO) + (size_t)lp * 1024 * 2048, T_, opq(1024), opq(2048)};
            pg8::StaticOrder S; S.init(T_, 1024, (int)gridDim.x, (int)blockIdx.x); EpiY E{(bf16_t*)(ws + WS_YO)};
            pg8::gemm_phase<EpiY, pg8::StaticOrder, false>(lds, g, S, E, nullptr);
        }
        SEAM(base + 8);
        if (IN(base + 9)) norm_phase(p, lod, lod < 3 ? lod + 1 : -1, (const bf16_t*)(ws + WS_YO), p.out);
        SEAM(base + 9);
    }
#ifdef DEBUG_HI
    {
        int* DIAG = (int*)(ws + WS_PART);
        const int tid = tid_fresh(); const size_t gtid = (size_t)blockIdx.x * 512 + tid, gsz = (size_t)gridDim.x * 512;
        grid.sync();
        if (blockIdx.x == 0 && tid < 64 && tid != 41) DIAG[tid] = 0;
        for (size_t i = gtid; i < (size_t)T_ * 1024; i += gsz) p.out[i] = DBG_KEEP_OUT ? p.out[i] : 0.f;
        grid.sync();
#define DBG_CHECK(bi, off_, n_, isf32) { int bad = 0; \
            if (isf32) { const float* q = (const float*)(ws + (off_)); for (size_t i = gtid; i < (size_t)(n_); i += gsz) { const float v = q[i]; if (!(fabsf(v) < DBG_LIM)) bad = 1; } } \
            else { const bf16_t* q = (const bf16_t*)(ws + (off_)); for (size_t i = gtid; i < (size_t)(n_); i += gsz) { const float v = bf2f(q[i]); if (!(fabsf(v) < DBG_LIM)) bad = 1; } } \
            if (bad) atomicAdd(&DIAG[bi], 1); }
        DEBUG_BUFS
#ifdef DBG_FRAC
        { int cnt = 0; const bf16_t* q = (const bf16_t*)(ws + DBG_FRAC_OFF); for (size_t i = gtid; i < (size_t)(DBG_FRAC_N); i += gsz) { const float v = bf2f(q[i]); if (!(fabsf(v) < DBG_LIM)) ++cnt; } if (cnt) atomicAdd(&DIAG[40], cnt); }
#endif
        const int nb = DBG_NB;
        grid.sync();
        if (blockIdx.x == 0 && tid == 0) { int first = -1; for (int bi = 0; bi < nb; ++bi) if (first < 0 && __hip_atomic_load(&DIAG[bi], __ATOMIC_RELAXED, __HIP_MEMORY_SCOPE_AGENT) != 0) first = bi; p.out[0] = 1000.f * (float)(first + 1);
#if defined(DBG_MAXP) || defined(DBG_KEXPR)
            p.out[0] = 100.f * __int_as_float(__hip_atomic_load(&DIAG[41], __ATOMIC_RELAXED, __HIP_MEMORY_SCOPE_AGENT));
#endif
#ifdef DBG_FRAC
            p.out[0] = 100.f * (float)__hip_atomic_load(&DIAG[40], __ATOMIC_RELAXED, __HIP_MEMORY_SCOPE_AGENT);
#endif
        }
    }
#endif
}

extern "C" void kernel_launch(void* const* d_in, const int* in_sizes, int n_in, void* d_out, int out_size, void* d_ws, size_t ws_size, hipStream_t stream) {
    static int grid_blocks = 0;
    if (!grid_blocks) {
        if (n_in != 24 || out_size != T_ * 1024 || ws_size < WS_NEED) { fprintf(stderr, "kernel_launch: unexpected shapes (n_in %d out %d ws %zu need %zu)\n", n_in, out_size, ws_size, (size_t)WS_NEED); return; }
        if (hipFuncSetAttribute((const void*)mega, hipFuncAttributeMaxDynamicSharedMemorySize, (int)LDS_BYTES) != hipSuccess) { fprintf(stderr, "hipFuncSetAttribute failed\n"); return; }
        int dev = 0, cus = 0, per_cu = 0;
        (void)hipGetDevice(&dev);
        (void)hipDeviceGetAttribute(&cus, hipDeviceAttributeMultiprocessorCount, dev);
        (void)hipOccupancyMaxActiveBlocksPerMultiprocessor(&per_cu, mega, 512, LDS_BYTES);
        if (per_cu < 1 || cus != 256) { fprintf(stderr, "kernel_launch: occupancy %d cus %d\n", per_cu, cus); }
        grid_blocks = 256;
    }
    Params p{};
    for (int i = 0; i < 24; ++i) p.in[i] = (const float*)d_in[i];
    p.out = (float*)d_out; p.ws = (unsigned char*)d_ws;
#if N_LAUNCH_MODE == 0
    (void)hipMemsetAsync((unsigned char*)d_ws + WS_BAR, 0, (size_t)XCD_BAR_WORDS * 4, stream);
#ifdef DEBUG_HI
    p.ph_lo = 0; p.ph_hi = DEBUG_HI;
#else
    p.ph_lo = 0; p.ph_hi = NPHASE;
#endif
    void* args[] = {&p};
    hipError_t e = hipLaunchCooperativeKernel((void*)mega, dim3(grid_blocks), dim3(512), args, LDS_BYTES, stream);
    if (e != hipSuccess) fprintf(stderr, "cooperative launch failed: %s (grid %d)\n", hipGetErrorString(e), grid_blocks);
#else
    for (int k = 0; k < NPHASE; ++k) { p.ph_lo = k; p.ph_hi = k + 1; hipLaunchKernelGGL(mega, dim3(grid_blocks), dim3(512), LDS_BYTES, stream, p); }
#endif
}
```

```cpp
#ifndef ATT_SDEPTH
#define ATT_SDEPTH 1
#endif
#ifndef ATT_NQR
#define ATT_NQR 8
#endif
#include <hip/hip_runtime.h>
namespace pg8 {
#define PG8_LAS __attribute__((address_space(3)))
typedef unsigned short bf16_t;
typedef short bf16x8 __attribute__((ext_vector_type(8)));
typedef float f32x4 __attribute__((ext_vector_type(4)));
typedef unsigned u32x4 __attribute__((ext_vector_type(4)));
constexpr int BM = 256, BK = 64, HALF = 128, HTB = HALF * BK * 2  , STAGE_BYTES = 8 * HTB, NXCD = 8, WGM = 8;

__host__ __device__ __forceinline__ int lds_byte(int r, int c) { const int st = (r >> 4) * 2 + (c >> 5), rr = r & 15, cc = c & 31, ob = rr * 64 + cc * 2; return st * 1024 + (ob ^ (((ob >> 9) & 1) << 5)); }
__host__ __device__ __forceinline__ void stage_rc(int b, int& R, int& C) { const int st = b / 1024, sb = b % 1024, swz = sb ^ (((sb >> 9) & 1) << 5); R = (st >> 1) * 16 + swz / 64; C = (st & 1) * 32 + (swz % 64) / 2; }
__host__ __device__ __forceinline__ int perm32(int rho) { const int n = rho >> 4, i = rho & 15; return 8 * (i >> 2) + 4 * n + (i & 3); }

struct Unit { int pm, pn; };
struct Gemm { const bf16_t* A; const bf16_t* Bt; int M, N, K; };

struct StaticOrder {
    int nM, nN, nwg, G, c;
    __host__ __device__ void init(int M, int N, int G_, int c_) { nM = M / BM; nN = N / BM; nwg = nM * nN; G = G_; c = c_; }
    __host__ __device__ bool next(int i, Unit& u) const {
        const long L = (long)i * G + c; if (L >= nwg) return false;
        int wgid = (int)L; { const int q = nwg / NXCD, r = nwg % NXCD, xcd = wgid % NXCD, off = wgid / NXCD; wgid = (xcd < r ? xcd * (q + 1) : r * (q + 1) + (xcd - r) * q) + off; }
        const int nig = WGM * nN, gid = wgid / nig, fm = gid * WGM, gsz = (nM - fm) < WGM ? (nM - fm) : WGM;
        u.pm = fm + ((wgid % nig) % gsz); u.pn = (wgid % nig) / gsz; return true;
    }
    __device__ __forceinline__ void a_ready(const Unit&) const {}
    __device__ __forceinline__ void done(const Unit&) const {}
};
__device__ __forceinline__ unsigned cvt_pk_bf16(float lo, float hi) { unsigned r; asm volatile("v_cvt_pk_bf16_f32 %0, %1, %2" : "=v"(r) : "v"(lo), "v"(hi)); return r; }
typedef float f32x2 __attribute__((ext_vector_type(2)));
__device__ __forceinline__ f32x2 gelu_pk(f32x2 v) {
    const f32x2 av = __builtin_elementwise_abs(v), d = av * 0.2316418882f + 1.0f;
    f32x2 t; t.x = __builtin_amdgcn_rcpf(d.x); t.y = __builtin_amdgcn_rcpf(d.y);
    f32x2 q = t * 0.5307027145f + (-0.7265760135f); q = q * t + 0.7107068705f; q = q * t + (-0.142248368f); q = q * t + 0.127414796f; q = q * t;
    const f32x2 s = (v * v) * (-0.72134752044f);
    f32x2 e; e.x = __builtin_amdgcn_exp2f(s.x); e.y = __builtin_amdgcn_exp2f(s.y);
    const f32x2 m = v * (q * e), r = v - m;
    f32x2 o; o.x = v.x < 0.f ? m.x : r.x; o.y = v.y < 0.f ? m.y : r.y; return o;
}

struct EpiF32 {
    static constexpr bool PERM = false, AFTER_DRAIN = false;
    float* C; int ldc; const float* bias;
    __device__ __forceinline__ void operator()(const f32x4 (&acc)[2][2][4][2], const Unit& u, int wr, int wc, int fr, int fq) const {
        const int row0 = u.pm * BM + wr * 64 + fr, col0 = u.pn * BM + wc * 32 + 4 * fq;
        f32x4 bv[2][2];
#pragma unroll
        for (int bj = 0; bj < 2; ++bj)
#pragma unroll
            for (int n = 0; n < 2; ++n) bv[bj][n] = bias ? *(const f32x4*)(bias + col0 + bj * HALF + n * 16) : (f32x4){0.f, 0.f, 0.f, 0.f};
#pragma unroll
        for (int ai = 0; ai < 2; ++ai)
#pragma unroll
            for (int m = 0; m < 4; ++m) { float* rowp = C + (size_t)(row0 + ai * HALF + m * 16) * ldc + col0;
#pragma unroll
                for (int bj = 0; bj < 2; ++bj)
#pragma unroll
                    for (int n = 0; n < 2; ++n) *(f32x4*)(rowp + bj * HALF + n * 16) = acc[ai][bj][m][n] + bv[bj][n]; }
    }
};
template <class Epi, class Sched, bool STAMP = false>
__device__ __forceinline__ void gemm_phase(PG8_LAS unsigned char* lds, const Gemm g, const Sched& S, const Epi& E, unsigned long long* stamps) {
    int tid = threadIdx.x; asm volatile("" : "+v"(tid));
    const int wid = __builtin_amdgcn_readfirstlane(tid >> 6), lane = tid & 63, wr = wid >> 2, wc = wid & 3, fr = lane & 15, fq = lane >> 4;
    const int K = g.K, nt = K / BK;
    int ts_lo = 0, ts_hi = 0, nts = 0; const unsigned long long rt_entry = STAMP ? (unsigned long long)wall_clock64() : 0ull;
#define PG8_STAMP() do { if (STAMP && wid == 0 && nts < 64) { const unsigned long long _c = (unsigned long long)clock64(); \
        ts_lo = (lane == nts) ? (int)(unsigned)_c : ts_lo; ts_hi = (lane == nts) ? (int)(unsigned)(_c >> 32) : ts_hi; ++nts; } } while (0)
    PG8_STAMP();
    unsigned voffA[2], voffB[2];
#pragma unroll
    for (int i = 0; i < 2; ++i) { int R, C; stage_rc(tid * 16 + i * 8192, R, C); const int Rb = Epi::PERM ? ((R & ~31) + perm32(R & 31)) : R;
        voffA[i] = (unsigned)(R * K + C) * 2u; voffB[i] = (unsigned)(Rb * K + C) * 2u; }
    const size_t kstep = (size_t)(BK * 2);
    const size_t hstep = (size_t)HALF * K * 2;
    const size_t tstep = 2 * hstep;
    const unsigned ldsw = (unsigned)wid * 1024u;
    const int aoff = lds_byte(wr * 64 + fr, fq * 8), boff = lds_byte(wc * 32 + fr, fq * 8);
#define PG8_SA(b, h) (((b) * 2 + (h)) * HTB)
#define PG8_SB(b, h) ((4 + (b) * 2 + (h)) * HTB)
#define PG8_STAGE(bufoff, gbase, voff) do { _Pragma("unroll") for (int _i = 0; _i < 2; ++_i) \
        __builtin_amdgcn_global_load_lds((const unsigned*)((const char*)(gbase) + (voff)[_i]), (PG8_LAS unsigned*)(lds + (bufoff) + ldsw + _i * 8192), 16, 0, 0); } while (0)
#define PG8_LDA(dst, b, h) do { _Pragma("unroll") for (int m = 0; m < 4; ++m) _Pragma("unroll") for (int k = 0; k < 2; ++k) dst[m][k] = *(const PG8_LAS bf16x8*)(lds + PG8_SA(b, h) + aoff + m * 2048 + k * 1024); } while (0)
#define PG8_LDB(dst, b, h) do { _Pragma("unroll") for (int n = 0; n < 2; ++n) _Pragma("unroll") for (int k = 0; k < 2; ++k) dst[n][k] = *(const PG8_LAS bf16x8*)(lds + PG8_SB(b, h) + boff + n * 2048 + k * 1024); } while (0)
#define PG8_MMA(ai, bj, At, Bt) do { __builtin_amdgcn_s_setprio(1); _Pragma("unroll") for (int m = 0; m < 4; ++m) _Pragma("unroll") for (int n = 0; n < 2; ++n) _Pragma("unroll") for (int k = 0; k < 2; ++k) \
        acc[ai][bj][m][n] = __builtin_amdgcn_mfma_f32_16x16x32_bf16(Bt[n][k], At[m][k], acc[ai][bj][m][n], 0, 0, 0); __builtin_amdgcn_s_setprio(0); } while (0)
#define PG8_WAIT_V(n) asm volatile("s_waitcnt vmcnt(" #n ")" ::: "memory")
#define PG8_WAIT_L(n) asm volatile("s_waitcnt lgkmcnt(" #n ")" ::: "memory")
#define PG8_BAR __builtin_amdgcn_s_barrier()
#define PG8_SCHED __builtin_amdgcn_sched_barrier(0)
    Unit cur, nxt; int ui = 0;
    if (!S.next(0, cur)) return;
    f32x4 acc[2][2][4][2];
#pragma unroll
    for (int a = 0; a < 2; ++a)
#pragma unroll
        for (int b = 0; b < 2; ++b)
#pragma unroll
            for (int m = 0; m < 4; ++m)
#pragma unroll
                for (int n = 0; n < 2; ++n) acc[a][b][m][n] = (f32x4){0.f, 0.f, 0.f, 0.f};
    bf16x8 At[4][2], B0[2][2], B1[2][2];
    const char* cA = (const char*)g.A + (size_t)cur.pm * tstep; const char* cB = (const char*)g.Bt + (size_t)cur.pn * tstep;
    S.a_ready(cur);
    PG8_STAGE(PG8_SB(0, 0), cB, voffB); PG8_STAGE(PG8_SA(0, 0), cA, voffA); PG8_STAGE(PG8_SB(0, 1), cB + hstep, voffB); PG8_STAGE(PG8_SA(0, 1), cA + hstep, voffA);
    if (wr == 1) PG8_BAR;
    PG8_WAIT_V(4); PG8_BAR;
    PG8_STAGE(PG8_SB(1, 0), cB + kstep, voffB); PG8_STAGE(PG8_SA(1, 0), cA + kstep, voffA); PG8_STAGE(PG8_SB(1, 1), cB + hstep + kstep, voffB);
    PG8_WAIT_V(6); PG8_BAR;
    PG8_STAMP();
    for (;;) {
        const bool has_next = S.next(ui + 1, nxt);
        const char* nA = has_next ? (const char*)g.A + (size_t)nxt.pm * tstep : cA; const char* nB = has_next ? (const char*)g.Bt + (size_t)nxt.pn * tstep : cB;
        for (int t = 0; t < nt; t += 2) {
            const bool last = (t == nt - 2);
            const char* a1 = cA + (size_t)(t + 1) * kstep;
            const char* a2 = last ? nA : cA + (size_t)(t + 2) * kstep; const char* b2 = last ? nB : cB + (size_t)(t + 2) * kstep;
            const char* a3 = a2 + kstep; const char* b3 = b2 + kstep;
            if (last && has_next) S.a_ready(nxt);
            PG8_LDB(B0, 0, 0); PG8_SCHED; PG8_LDA(At, 0, 0); PG8_STAGE(PG8_SA(1, 1), a1 + hstep, voffA);
            PG8_WAIT_L(8); PG8_BAR; PG8_WAIT_L(0); PG8_MMA(0, 0, At, B0); PG8_BAR; PG8_SCHED;
            PG8_LDB(B1, 0, 1); PG8_STAGE(PG8_SB(0, 0), b2, voffB);
            PG8_BAR; PG8_WAIT_L(0); PG8_MMA(0, 1, At, B1); PG8_BAR;
            PG8_LDA(At, 0, 1); PG8_STAGE(PG8_SA(0, 0), a2, voffA);
            PG8_BAR; PG8_WAIT_L(0); PG8_MMA(1, 0, At, B0); PG8_BAR; PG8_SCHED;
            PG8_STAGE(PG8_SB(0, 1), b2 + hstep, voffB);
            PG8_WAIT_V(6); PG8_BAR; PG8_MMA(1, 1, At, B1); PG8_BAR;
            PG8_LDB(B0, 1, 0); PG8_SCHED; PG8_LDA(At, 1, 0); PG8_STAGE(PG8_SA(0, 1), a2 + hstep, voffA);
            PG8_WAIT_L(8); PG8_BAR; PG8_WAIT_L(0); PG8_MMA(0, 0, At, B0); PG8_BAR; PG8_SCHED;
            PG8_LDB(B1, 1, 1); PG8_STAGE(PG8_SB(1, 0), b3, voffB);
            PG8_BAR; PG8_WAIT_L(0); PG8_MMA(0, 1, At, B1); PG8_BAR;
            PG8_LDA(At, 1, 1); PG8_STAGE(PG8_SA(1, 0), a3, voffA);
            PG8_BAR; PG8_WAIT_L(0); PG8_MMA(1, 0, At, B0); PG8_BAR; PG8_SCHED;
            PG8_STAGE(PG8_SB(1, 1), b3 + hstep, voffB);
            PG8_WAIT_V(6); PG8_BAR; PG8_MMA(1, 1, At, B1); PG8_BAR;
        }
        PG8_STAMP();
        if constexpr (!Epi::AFTER_DRAIN) { E(acc, cur, wr, wc, fr, fq); S.done(cur); }
        PG8_STAMP();
        if (!has_next) break;
#pragma unroll
        for (int a = 0; a < 2; ++a)
#pragma unroll
            for (int b = 0; b < 2; ++b)
#pragma unroll
                for (int m = 0; m < 4; ++m)
#pragma unroll
                    for (int n = 0; n < 2; ++n) acc[a][b][m][n] = (f32x4){0.f, 0.f, 0.f, 0.f};
        cur = nxt; cA = nA; cB = nB; ++ui;
    }
    PG8_WAIT_V(0);
    if (wr == 0) PG8_BAR;
    PG8_BAR;
    if constexpr (Epi::AFTER_DRAIN) { E.fused(acc, cur, wr, wc, fr, fq, lds, wid, lane); S.done(cur); }
    PG8_STAMP();
    if (STAMP && wid == 0) { stamps[lane] = lane < nts ? (((unsigned long long)(unsigned)ts_hi << 32) | (unsigned)ts_lo) : 0ull;
        if (lane == 62) stamps[62] = rt_entry; if (lane == 63) stamps[63] = (unsigned long long)wall_clock64(); }
#undef PG8_STAMP
#undef PG8_SA
#undef PG8_SB
#undef PG8_STAGE
#undef PG8_LDA
#undef PG8_LDB
#undef PG8_MMA
#undef PG8_WAIT_V
#undef PG8_WAIT_L
#undef PG8_BAR
#undef PG8_SCHED
}
}


#include <hip/hip_cooperative_groups.h>
#include <cstdio>
namespace cg = cooperative_groups;
#define LAS __attribute__((address_space(3)))
typedef unsigned short bf16_t;
typedef short bf16x8 __attribute__((ext_vector_type(8)));
typedef short s16x4 __attribute__((ext_vector_type(4)));
typedef float f32x4 __attribute__((ext_vector_type(4)));
typedef float f32x2 __attribute__((ext_vector_type(2)));
typedef float f32x16 __attribute__((ext_vector_type(16)));
typedef unsigned u32x4 __attribute__((ext_vector_type(4)));
typedef unsigned u32x2 __attribute__((ext_vector_type(2)));

#ifndef N_LAUNCH_MODE
#define N_LAUNCH_MODE 0
#endif

constexpr int T_ = 32768, DM = 1024, NBAT = 8, SEQ = 4096;
constexpr float EPS = 1e-6f;
constexpr int NPHASE = 22;
constexpr size_t LDS_BYTES = 163840;

constexpr size_t al256(size_t x) { return (x + 255) / 256 * 256; }
constexpr size_t WS_WINE  = 0;
constexpr size_t WS_WUP   = WS_WINE  + al256((size_t)2 * 2560 * 1024 * 2);
constexpr size_t WS_WOUTE = WS_WUP   + al256((size_t)2 * 1792 * 384 * 2);
constexpr size_t WS_WINO  = WS_WOUTE + al256((size_t)2 * 1024 * 1024 * 2);
constexpr size_t WS_WOUTO = WS_WINO  + al256((size_t)2 * 6144 * 1024 * 2);
constexpr size_t WS_WS    = WS_WOUTO + al256((size_t)2 * 1024 * 2048 * 2);
constexpr size_t WS_MOD   = WS_WS    + al256((size_t)2 * 8 * 128 * 128 * 2);
constexpr size_t WS_ROPE  = WS_MOD   + al256((size_t)4 * 8 * 3072 * 4);
constexpr size_t WS_RS    = WS_ROPE  + al256((size_t)T_ * 32 * 8);
constexpr size_t WS_EV    = WS_RS    + al256((size_t)T_ * 2 * 4);
constexpr size_t WS_PART  = WS_EV    + al256((size_t)4096 * 64 * 4);
constexpr size_t WS_H     = WS_PART  + al256((size_t)T_ * 32 * 8);
constexpr size_t WS_R2    = WS_H     + al256((size_t)T_ * 1024 * 2);
constexpr size_t WS_GQ    = WS_R2;
constexpr size_t WS_GK    = WS_GQ   + (size_t)T_ * 256 * 2;
constexpr size_t WS_GV    = WS_GK   + (size_t)T_ * 256 * 2;
constexpr size_t WS_GZ    = WS_GV   + (size_t)T_ * 512 * 2;
constexpr size_t WS_MZ    = WS_GZ   + (size_t)T_ * 512 * 2;
constexpr size_t WS_CQKV  = WS_MZ   + (size_t)T_ * 512 * 2;
constexpr size_t WS_KR    = WS_CQKV + (size_t)T_ * 384 * 2;
constexpr size_t WS_GA    = WS_KR   + (size_t)T_ * 64 * 2;
constexpr size_t WS_Q     = WS_GA   + (size_t)T_ * 32 * 4;
constexpr size_t WS_K     = WS_Q    + (size_t)T_ * 4 * 192 * 2;
constexpr size_t WS_V     = WS_K    + (size_t)T_ * 4 * 192 * 2;
constexpr size_t WS_ST    = WS_V    + (size_t)T_ * 4 * 128 * 2;
constexpr size_t WS_EVEN_END = WS_ST + (size_t)4096 * 8192 * 2;
constexpr size_t WS_YE    = WS_Q;
constexpr size_t WS_UZ    = WS_R2;
constexpr size_t WS_V2    = WS_UZ   + (size_t)T_ * 2048 * 2;
constexpr size_t WS_YO    = WS_V2;
constexpr size_t WS_ODD_END = WS_V2 + (size_t)T_ * 2048 * 2;
constexpr size_t WS_TOTAL = WS_EVEN_END > WS_ODD_END ? WS_EVEN_END : WS_ODD_END;
static_assert(WS_Q + (size_t)T_ * 1024 * 4 == WS_ST, "Y_even must cover exactly Q|K|V");

constexpr size_t WUP_E = 768 * 256 + 1024 * 128, WUP_KV = 768 * 256;
constexpr size_t WS_CQ = WS_CQKV, WS_CKV = WS_CQKV + (size_t)T_ * 256 * 2;
struct Params { const float* in[24]; float* out; unsigned char* ws; int ph_lo, ph_hi; };
enum { I_X = 0, I_C, I_POS, I_WMOD, I_BMOD, I_GPRE, I_GPOST, I_WINE, I_W2F, I_B2F, I_W2B, I_B2B, I_GNORM, I_GQ, I_WUQ, I_GKV, I_WUKV, I_WOUTE,
       I_WINO, I_SGG, I_SGB, I_SGW, I_SGBS, I_WOUTO };

typedef __bf16 bf16v2 __attribute__((ext_vector_type(2)));
__device__ __forceinline__ unsigned cvtpk(float lo, float hi) { const f32x2 v = {lo, hi}; return __builtin_bit_cast(unsigned, __builtin_convertvector(v, bf16v2)); }
__device__ __forceinline__ float bflo(unsigned w) { return __uint_as_float(w << 16); }
__device__ __forceinline__ float bfhi(unsigned w) { return __uint_as_float(w & 0xffff0000u); }
__device__ __forceinline__ float bf2f(unsigned short b) { return __uint_as_float(((unsigned)b) << 16); }
__device__ __forceinline__ int tid_fresh() { int t = threadIdx.x; asm volatile("" : "+v"(t)); return t; }
__device__ __forceinline__ float wave_sum(float v) {
#pragma unroll
    for (int o = 32; o >= 1; o >>= 1) v += __shfl_xor(v, o);
    return v; }
__device__ __forceinline__ float silu_f(float z) { return z * __builtin_amdgcn_rcpf(1.0f + __expf(-z)); }
__device__ __forceinline__ float logsig_f(float x) { return fminf(x, 0.f) - __logf(1.0f + __expf(-fabsf(x))); }
__device__ __forceinline__ void unpack8(const u32x4 w, float (&f)[8]) {
    f[0] = bflo(w.x); f[1] = bfhi(w.x); f[2] = bflo(w.y); f[3] = bfhi(w.y); f[4] = bflo(w.z); f[5] = bfhi(w.z); f[6] = bflo(w.w); f[7] = bfhi(w.w); }
__device__ __forceinline__ u32x4 pack8(const float (&f)[8]) { u32x4 w; w.x = cvtpk(f[0], f[1]); w.y = cvtpk(f[2], f[3]); w.z = cvtpk(f[4], f[5]); w.w = cvtpk(f[6], f[7]); return w; }
#define MFMA16(a, b, c) __builtin_amdgcn_mfma_f32_16x16x32_bf16((a), (b), (c), 0, 0, 0)

__device__ __forceinline__ int map_even_col(int n) {
    if (n < 1024) return n;
    if (n < 1536) return n - 1024 + 1056;
    if (n < 2048) return n - 1536 + 2016;
    if (n < 2304) return n - 2048 + 1568;
    if (n < 2432) return n - 2304 + 1824;
    if (n < 2496) return n - 2432 + 1952;
    if (n < 2528) return n - 2496 + 1024;
    return -1; }
__device__ __forceinline__ int map_q_col(int n) {
    const int hh = n / 192, j = n - hh * 192;
    if (j < 128) return n;
    const int jj = j - 128, g8 = jj >> 3, w = jj & 7;
    return hh * 192 + 128 + ((w < 4) ? (4 * g8 + w) : (32 + 4 * g8 + (w - 4))); }
__device__ __forceinline__ int map_odd_col(int n) {
    const int pn = n >> 8;
    if (pn < 16) { const int half = (n >> 7) & 1, idx = n & 127; return (half ? 4096 : 0) + 128 * pn + idx; }
    return 2048 + (n - 4096); }

template <int MAT> __device__ __forceinline__ float prep_val(const Params& p, int e, int n, int k) {
    if (MAT == 0) { const int sc = map_even_col(n); return sc < 0 ? 0.f : p.in[I_WINE][((size_t)e * 1024 + k) * 2528 + sc]; }
    if (MAT == 1) return p.in[I_GQ][e * 256 + k] * p.in[I_WUQ][((size_t)e * 256 + k) * 768 + map_q_col(n)];
    if (MAT == 5) return p.in[I_GKV][e * 128 + k] * p.in[I_WUKV][((size_t)e * 128 + k) * 1024 + n];
    if (MAT == 2) return p.in[I_WOUTE][((size_t)e * 1024 + k) * 1024 + n];
    if (MAT == 3) return p.in[I_WINO][((size_t)e * 1024 + k) * 6144 + map_odd_col(n)];
    return p.in[I_WOUTO][((size_t)e * 2048 + k) * 1024 + n];
}
template <int MAT> __device__ __forceinline__ void prep_tile(const Params& p, LAS float* tl, bf16_t* dst, int K, int e, int n0, int k0) {
    const int tid = tid_fresh(), nl = tid & 63, kl = tid >> 6;
#pragma unroll
    for (int r = 0; r < 8; ++r) { const int k = kl + 8 * r; tl[k * 65 + nl] = prep_val<MAT>(p, e, n0 + nl, k0 + k); }
    __syncthreads();
    const int nl2 = tid >> 3, kg = tid & 7; float v[8];
#pragma unroll
    for (int q = 0; q < 8; ++q) v[q] = tl[(8 * kg + q) * 65 + nl2];
    *(u32x4*)(dst + (size_t)(n0 + nl2) * K + k0 + 8 * kg) = pack8(v);
    __syncthreads();
}

__device__ __forceinline__ void p0_phase(const Params& p, LAS unsigned char* lds) {
    const int tid = tid_fresh();
    unsigned char* ws = p.ws;
    constexpr int N_MOD = 192, N_ROPE = 256, N_WS = 64;
    constexpr int T0 = N_MOD + N_ROPE + N_WS;
    constexpr int T1 = T0 + 2 * 40 * 16;
    constexpr int T2 = T1 + 2 * 12 * 4 + 2 * 16 * 2;
    constexpr int T3 = T2 + 2 * 16 * 16;
    constexpr int T4 = T3 + 2 * 96 * 16;
    constexpr int T5 = T4 + 2 * 16 * 32;
    LAS float* tl = (LAS float*)lds;
    for (int it = blockIdx.x; it < T5; it += gridDim.x) {
        if (it < N_MOD) {
            const int l = it / 48, jc = it % 48;
            LAS float* sc = (LAS float*)lds;
            LAS float* red = (LAS float*)(lds + 32768);
            for (int i = tid; i < 8192; i += 512) { const float cv = p.in[I_C][i]; sc[i] = silu_f(cv); }
            __syncthreads();
            const int cgp = tid & 15, kg = tid >> 4;
            float acc[8][4];
#pragma unroll
            for (int b = 0; b < 8; ++b)
#pragma unroll
                for (int c = 0; c < 4; ++c) acc[b][c] = 0.f;
            const float* wp = p.in[I_WMOD] + ((size_t)l * 1024 + 32 * kg) * 3072 + 64 * jc + 4 * cgp;
#pragma unroll 4
            for (int kk = 0; kk < 32; ++kk) {
                const f32x4 w = *(const f32x4*)(wp + (size_t)kk * 3072);
#pragma unroll
                for (int b = 0; b < 8; ++b) { const float s = sc[b * 1024 + 32 * kg + kk];
#pragma unroll
                    for (int c = 0; c < 4; ++c) acc[b][c] += s * w[c]; } }
#pragma unroll
            for (int b = 0; b < 8; ++b)
#pragma unroll
                for (int c = 0; c < 4; ++c) red[(kg * 8 + b) * 64 + 4 * cgp + c] = acc[b][c];
            __syncthreads();
            { const int b = tid >> 6, col = tid & 63; float s = p.in[I_BMOD][l * 3072 + 64 * jc + col];
              for (int q = 0; q < 32; ++q) s += red[(q * 8 + b) * 64 + col];
              ((float*)(ws + WS_MOD))[((size_t)l * 8 + b) * 3072 + 64 * jc + col] = s; }
            __syncthreads();
        } else if (it < N_MOD + N_ROPE) {
            const int r0 = (it - N_MOD) * 4096;
            for (int i = tid; i < 4096; i += 512) { const int idx = r0 + i, row = idx >> 5, fi = idx & 31;
                const float pos = (float)((const int*)p.in[I_POS])[row];
                const float inv = 1.0f / powf(10000.0f, (float)(2 * fi) * (1.0f / 64.0f));
                const float ang = pos * inv; f32x2 cs; cs.x = cosf(ang); cs.y = sinf(ang);
                ((f32x2*)(ws + WS_ROPE))[idx] = cs; }
        } else if (it < T0) {
            const int r0 = (it - N_MOD - N_ROPE) * 4096;
            for (int i = tid; i < 2048; i += 512) { const int idx = r0 + 2 * i; const f32x2 v = *(const f32x2*)(p.in[I_SGW] + idx);
                ((unsigned*)(ws + WS_WS))[idx >> 1] = cvtpk(v.x, v.y); }
        } else if (it < T1) { const int q = it - T0, e = q / 640, r = q % 640, nt = r / 16, kt = r % 16;
            prep_tile<0>(p, tl, (bf16_t*)(ws + WS_WINE) + (size_t)e * 2560 * 1024, 1024, e, nt * 64, kt * 64);
        } else if (it < T2) { const int q = it - T1;
            if (q < 96) { const int e = q / 48, r = q % 48, nt = r / 4, kt = r % 4;
                prep_tile<1>(p, tl, (bf16_t*)(ws + WS_WUP) + (size_t)e * WUP_E, 256, e, nt * 64, kt * 64); }
            else { const int q2 = q - 96, e = q2 / 32, r = q2 % 32, nt = r / 2, kt = r % 2;
                prep_tile<5>(p, tl, (bf16_t*)(ws + WS_WUP) + (size_t)e * WUP_E + WUP_KV, 128, e, nt * 64, kt * 64); }
        } else if (it < T3) { const int q = it - T2, e = q / 256, r = q % 256, nt = r / 16, kt = r % 16;
            prep_tile<2>(p, tl, (bf16_t*)(ws + WS_WOUTE) + (size_t)e * 1024 * 1024, 1024, e, nt * 64, kt * 64);
        } else if (it < T4) { const int q = it - T3, e = q / 1536, r = q % 1536, nt = r / 16, kt = r % 16;
            prep_tile<3>(p, tl, (bf16_t*)(ws + WS_WINO) + (size_t)e * 6144 * 1024, 1024, e, nt * 64, kt * 64);
        } else { const int q = it - T4, e = q / 512, r = q % 512, nt = r / 32, kt = r % 32;
            prep_tile<4>(p, tl, (bf16_t*)(ws + WS_WOUTO) + (size_t)e * 1024 * 2048, 2048, e, nt * 64, kt * 64);
        }
    }
}

__device__ __forceinline__ void norm_phase(const Params& p, int l_post, int l_pre, const bf16_t* y, const float* xin) {
    const int tid = tid_fresh(), lane = tid & 63, wave = tid >> 6;
    const float* mod = (const float*)(p.ws + WS_MOD);
    bf16_t* H = (bf16_t*)(p.ws + WS_H);
    for (int row = blockIdx.x * 8 + wave; row < T_; row += gridDim.x * 8) {
        const int b = row >> 12;
        f32x4 xv[4];
#pragma unroll
        for (int i = 0; i < 4; ++i) xv[i] = *(const f32x4*)(xin + (size_t)row * 1024 + 256 * i + 4 * lane);
        if (l_post >= 0) {
            f32x4 yv[4]; float ss = 0.f;
#pragma unroll
            for (int i = 0; i < 4; ++i) { const u32x2 yw = *(const u32x2*)(y + (size_t)row * 1024 + 256 * i + 4 * lane); yv[i] = (f32x4){bflo(yw.x), bfhi(yw.x), bflo(yw.y), bfhi(yw.y)}; ss += yv[i][0] * yv[i][0] + yv[i][1] * yv[i][1] + yv[i][2] * yv[i][2] + yv[i][3] * yv[i][3]; }
            ss = wave_sum(ss); const float rs = rsqrtf(ss * (1.0f / 1024.0f) + EPS);
            const float* gate = mod + ((size_t)l_post * 8 + b) * 3072 + 2048; const float* gp = p.in[I_GPOST] + l_post * 1024;
#pragma unroll
            for (int i = 0; i < 4; ++i) { const f32x4 g = *(const f32x4*)(gate + 256 * i + 4 * lane), w = *(const f32x4*)(gp + 256 * i + 4 * lane);
                xv[i] = xv[i] + g * (yv[i] * rs * w);
#ifdef DEBUG_SANITIZE
                if (l_post == 3) { for (int q = 0; q < 4; ++q) if (!(fabsf(xv[i][q]) < 1e30f)) xv[i][q] = 12345.f; }
#endif
                *(f32x4*)(p.out + (size_t)row * 1024 + 256 * i + 4 * lane) = xv[i]; }
        }
        if (l_pre >= 0) {
            float ss = 0.f;
#pragma unroll
            for (int i = 0; i < 4; ++i) ss += xv[i][0] * xv[i][0] + xv[i][1] * xv[i][1] + xv[i][2] * xv[i][2] + xv[i][3] * xv[i][3];
            ss = wave_sum(ss); const float rs = rsqrtf(ss * (1.0f / 1024.0f) + EPS);
            const float* sh = mod + ((size_t)l_pre * 8 + b) * 3072; const float* sc = sh + 1024; const float* gp = p.in[I_GPRE] + l_pre * 1024;
#pragma unroll
            for (int i = 0; i < 4; ++i) { const f32x4 s0 = *(const f32x4*)(sh + 256 * i + 4 * lane), s1 = *(const f32x4*)(sc + 256 * i + 4 * lane), w = *(const f32x4*)(gp + 256 * i + 4 * lane);
                const f32x4 hv = (xv[i] * rs * w) * (s1 + 1.0f) + s0; u32x2 o; o.x = cvtpk(hv[0], hv[1]); o.y = cvtpk(hv[2], hv[3]);
                *(u32x2*)(H + (size_t)row * 1024 + 256 * i + 4 * lane) = o; }
        }
    }
}

#define XB_TMO      128
#define XB_XCNT(j)  (256  + 64 * (j))
#define XB_XSUB(j)  (1280 + 64 * (j))
#define XB_XGEN(j)  (2304 + 64 * (j))
#define XB_TOP      3328
#define XB_TOPGEN   3392
#define XCD_BAR_WORDS 3456
#define XB_SPIN_CAP (1u << 18)

__device__ __forceinline__ unsigned xb_ld(unsigned* p)              { return __hip_atomic_load(p, __ATOMIC_RELAXED, __HIP_MEMORY_SCOPE_AGENT); }
__device__ __forceinline__ unsigned xb_add(unsigned* p, unsigned v) { return __hip_atomic_fetch_add(p, v, __ATOMIC_RELAXED, __HIP_MEMORY_SCOPE_AGENT); }
__device__ __forceinline__ unsigned xb_xcc_id() { return (unsigned)__builtin_amdgcn_s_getreg((3 << 11) | 20) & 0xFu; }
#define XB_SPIN(cond, bar) do { unsigned _sp = 0; while (cond) { __builtin_amdgcn_s_sleep(1); \
    if ((++_sp & 255u) == 0u) { if (xb_ld(&(bar)[XB_TMO])) break; if (_sp > XB_SPIN_CAP) { atomicAdd(&(bar)[XB_TMO], 1u); break; } } } } while (0)

struct XcdBarrier {
    unsigned* bar; unsigned x;
    volatile LAS unsigned* st;
};

__device__ __forceinline__ XcdBarrier xcd_barrier_post(unsigned* bar, volatile LAS unsigned* st) {
    XcdBarrier b; b.bar = bar; b.x = xb_xcc_id(); b.st = st;
    if (threadIdx.x == 0) (void)xb_add(&bar[XB_XCNT(b.x)], 1u);
    return b;
}
__device__ __forceinline__ void xcd_barrier_complete(unsigned* bar, unsigned x, unsigned& nloc, unsigned& nx) {
    const unsigned G = gridDim.x * gridDim.y * gridDim.z;
    unsigned sum, cnt, mine, sp = 0u;
    for (;;) {
        sum = 0u; cnt = 0u; mine = 0u;
#pragma unroll
        for (unsigned j = 0; j < 16; ++j) { const unsigned c = xb_ld(&bar[XB_XCNT(j)]); sum += c; cnt += (c > 0u) ? 1u : 0u; mine = (j == x) ? c : mine; }
        if (sum == G) break;
        __builtin_amdgcn_s_sleep(1);
        if ((++sp & 255u) == 0u) { if (xb_ld(&bar[XB_TMO])) break; if (sp > XB_SPIN_CAP) { atomicAdd(&bar[XB_TMO], 1u); break; } }
    }
    nloc = mine > 0u ? mine : 1u; nx = cnt > 0u ? cnt : 1u;
}

__device__ __forceinline__ void xcd_barrier(const XcdBarrier& b) {
    asm volatile("s_waitcnt vmcnt(0)" ::: "memory");
    __syncthreads();
    if (threadIdx.x == 0) {
        unsigned* bar = b.bar;
        __builtin_amdgcn_s_waitcnt(0);
        unsigned nloc = b.st[0], nx = b.st[1];
        if (nloc == 0u) { xcd_barrier_complete(bar, b.x, nloc, nx); b.st[0] = nloc; b.st[1] = nx; }
        const unsigned old = xb_add(&bar[XB_XSUB(b.x)], 1u);
        const unsigned gen = old / nloc;
        if (old + 1u == (gen + 1u) * nloc) {
            __builtin_amdgcn_fence(__ATOMIC_RELEASE, "agent");
            asm volatile("s_waitcnt vmcnt(0)" ::: "memory");
            const unsigned og = xb_add(&bar[XB_TOP], 1u);
            const unsigned tg = og / nx;
            if (og + 1u == (tg + 1u) * nx) xb_add(&bar[XB_TOPGEN], 1u);
            else XB_SPIN(xb_ld(&bar[XB_TOPGEN]) == tg, bar);
            __builtin_amdgcn_fence(__ATOMIC_ACQUIRE, "agent");
            xb_add(&bar[XB_XGEN(b.x)], 1u);
            asm volatile("s_waitcnt vmcnt(0)" ::: "memory");
        } else {
            XB_SPIN(xb_ld(&bar[XB_XGEN(b.x)]) == gen, bar);
            __builtin_amdgcn_fence(__ATOMIC_ACQUIRE, "agent");
            asm volatile("s_waitcnt vmcnt(0)" ::: "memory");
        }
    }
    __syncthreads();
}


struct EpiEvenIn {
    static constexpr bool PERM = true, AFTER_DRAIN = false;
    unsigned char* ws;
    __device__ __forceinline__ void operator()(const f32x4 (&acc)[2][2][4][2], const pg8::Unit& u, int wr, int wc, int fr_, int fq_) const {
        int fr = fr_, fq = fq_; asm volatile("" : "+v"(fr), "+v"(fq));
        const int row0 = u.pm * 256 + wr * 64 + fr, pn = u.pn, cu = 32 * wc + 8 * fq;
        if (pn < 9) {
            bf16_t* base; int ld;
            if (pn == 0) { base = (bf16_t*)(ws + WS_GQ); ld = 256; }
            else if (pn == 1) { base = (bf16_t*)(ws + WS_GK); ld = 256; }
            else if (pn < 4) { base = (bf16_t*)(ws + WS_GV) + (pn - 2) * 256; ld = 512; }
            else if (pn < 6) { base = (bf16_t*)(ws + WS_GZ) + (pn - 4) * 256; ld = 512; }
            else if (pn < 8) { base = (bf16_t*)(ws + WS_MZ) + (pn - 6) * 256; ld = 512; }
            else { base = (bf16_t*)(ws + WS_CQ); ld = 256; }
#pragma unroll
            for (int ai = 0; ai < 2; ++ai)
#pragma unroll
                for (int m = 0; m < 4; ++m) { bf16_t* rowp = base + (size_t)(row0 + ai * 128 + m * 16) * ld + cu;
#pragma unroll
                    for (int bj = 0; bj < 2; ++bj) { const f32x4 v0 = acc[ai][bj][m][0], v1 = acc[ai][bj][m][1];
                        u32x4 w; w.x = cvtpk(v0[0], v0[1]); w.y = cvtpk(v0[2], v0[3]); w.z = cvtpk(v1[0], v1[1]); w.w = cvtpk(v1[2], v1[3]);
                        *(u32x4*)(rowp + bj * 128) = w; } }
        } else {
            bf16_t* ckv = (bf16_t*)(ws + WS_CKV); bf16_t* kr = (bf16_t*)(ws + WS_KR); float* ga = (float*)(ws + WS_GA);
#pragma unroll
            for (int ai = 0; ai < 2; ++ai)
#pragma unroll
                for (int m = 0; m < 4; ++m) { const size_t row = (size_t)(row0 + ai * 128 + m * 16);
                    { const f32x4 v0 = acc[ai][0][m][0], v1 = acc[ai][0][m][1];
                      u32x4 w; w.x = cvtpk(v0[0], v0[1]); w.y = cvtpk(v0[2], v0[3]); w.z = cvtpk(v1[0], v1[1]); w.w = cvtpk(v1[2], v1[3]);
                      *(u32x4*)(ckv + row * 128 + cu) = w; }
                    { const f32x4 v0 = acc[ai][1][m][0], v1 = acc[ai][1][m][1];
                      if (wc < 2) { u32x4 w; w.x = cvtpk(v0[0], v0[1]); w.y = cvtpk(v0[2], v0[3]); w.z = cvtpk(v1[0], v1[1]); w.w = cvtpk(v1[2], v1[3]);
                          *(u32x4*)(kr + row * 64 + cu) = w; }
                      else if (wc == 2) { *(f32x4*)(ga + row * 32 + 8 * fq) = v0; *(f32x4*)(ga + row * 32 + 8 * fq + 4) = v1; } } }
        }
    }
};
struct EpiY {
    static constexpr bool PERM = true, AFTER_DRAIN = false;
    bf16_t* Y;
    __device__ __forceinline__ void operator()(const f32x4 (&acc)[2][2][4][2], const pg8::Unit& u, int wr, int wc, int fr_, int fq_) const {
        int fr = fr_, fq = fq_; asm volatile("" : "+v"(fr), "+v"(fq));
        const int row0 = u.pm * 256 + wr * 64 + fr, col0 = u.pn * 256 + 32 * wc + 8 * fq;
#pragma unroll
        for (int ai = 0; ai < 2; ++ai)
#pragma unroll
            for (int m = 0; m < 4; ++m) { bf16_t* rowp = Y + (size_t)(row0 + ai * 128 + m * 16) * 1024 + col0;
#pragma unroll
                for (int bj = 0; bj < 2; ++bj) { const f32x4 v0 = acc[ai][bj][m][0], v1 = acc[ai][bj][m][1];
                    u32x4 w; w.x = cvtpk(v0[0], v0[1]); w.y = cvtpk(v0[2], v0[3]); w.z = cvtpk(v1[0], v1[1]); w.w = cvtpk(v1[2], v1[3]);
                    *(u32x4*)(rowp + bj * 128) = w; } }
    }
};
template <bool KV> struct EpiUp {
    static constexpr bool PERM = true, AFTER_DRAIN = false;
    unsigned char* ws;
    __device__ __forceinline__ void operator()(const f32x4 (&acc)[2][2][4][2], const pg8::Unit& u, int wr, int wc, int fr_, int fq_) const {
        int fr = fr_, fq = fq_; asm volatile("" : "+v"(fr), "+v"(fq));
        const int row0 = u.pm * 256 + wr * 64 + fr, pn = u.pn;
        bf16_t* Q = (bf16_t*)(ws + WS_Q); bf16_t* K = (bf16_t*)(ws + WS_K); bf16_t* V = (bf16_t*)(ws + WS_V);
        const float* RS = (const float*)(ws + WS_RS); const f32x2* ROPE = (const f32x2*)(ws + WS_ROPE);
#pragma unroll
        for (int ai = 0; ai < 2; ++ai)
#pragma unroll
            for (int m = 0; m < 4; ++m) { const int row = row0 + ai * 128 + m * 16, b = row >> 12, s = row & 4095;
                const f32x2 rs = *(const f32x2*)(RS + 2 * (size_t)row);
#pragma unroll
                for (int bj = 0; bj < 2; ++bj) { f32x4 v0 = acc[ai][bj][m][0], v1 = acc[ai][bj][m][1];
                    if (!KV) {
                        v0 = v0 * rs.x; v1 = v1 * rs.x;
                        const int n = 256 * pn + 128 * bj + 32 * wc + 8 * fq, hh = n / 192, j = n - hh * 192;
                        bf16_t* qrow = Q + ((size_t)(b * 4 + hh) * 4096 + s) * 192;
                        if (j < 128) { u32x4 w; w.x = cvtpk(v0[0], v0[1]); w.y = cvtpk(v0[2], v0[3]); w.z = cvtpk(v1[0], v1[1]); w.w = cvtpk(v1[2], v1[3]);
                            *(u32x4*)(qrow + j) = w; }
                        else { const int i0 = (j - 128) >> 1;
                            const f32x4 c01 = *(const f32x4*)(ROPE + (size_t)row * 32 + i0), c23 = *(const f32x4*)(ROPE + (size_t)row * 32 + i0 + 2);
                            const float cs[4] = {c01[0], c01[2], c23[0], c23[2]}, sn[4] = {c01[1], c01[3], c23[1], c23[3]};
                            float o1[4], o2[4];
#pragma unroll
                            for (int q = 0; q < 4; ++q) { o1[q] = v0[q] * cs[q] - v1[q] * sn[q]; o2[q] = v1[q] * cs[q] + v0[q] * sn[q]; }
                            u32x2 w1, w2; w1.x = cvtpk(o1[0], o1[1]); w1.y = cvtpk(o1[2], o1[3]); w2.x = cvtpk(o2[0], o2[1]); w2.y = cvtpk(o2[2], o2[3]);
                            *(u32x2*)(qrow + 128 + i0) = w1; *(u32x2*)(qrow + 160 + i0) = w2; }
                    } else {
                        v0 = v0 * rs.y; v1 = v1 * rs.y; const int hh = pn, jj = 32 * wc + 8 * fq;
                        u32x4 w; w.x = cvtpk(v0[0], v0[1]); w.y = cvtpk(v0[2], v0[3]); w.z = cvtpk(v1[0], v1[1]); w.w = cvtpk(v1[2], v1[3]);
                        if (bj == 0) *(u32x4*)(K + ((size_t)(b * 4 + hh) * 4096 + s) * 192 + jj) = w;
                        else         *(u32x4*)(V + ((size_t)(b * 4 + hh) * 4096 + s) * 128 + jj) = w;
                    } }
                asm volatile("" ::: "memory"); }
    }
};
struct EpiOddIn {
    static constexpr bool PERM = true, AFTER_DRAIN = false;
    unsigned char* ws;
    __device__ __forceinline__ void operator()(const f32x4 (&acc)[2][2][4][2], const pg8::Unit& u, int wr, int wc, int fr_, int fq_) const {
        int fr = fr_, fq = fq_; asm volatile("" : "+v"(fr), "+v"(fq));
        const int row0 = u.pm * 256 + wr * 64 + fr, pn = u.pn, cu = 32 * wc + 8 * fq;
        typedef float f2 __attribute__((ext_vector_type(2)));
        if (pn < 16) {
            bf16_t* UZ = (bf16_t*)(ws + WS_UZ);
#pragma unroll
            for (int ai = 0; ai < 2; ++ai)
#pragma unroll
                for (int m = 0; m < 4; ++m) { const size_t row = (size_t)(row0 + ai * 128 + m * 16); float o[8];
#pragma unroll
                    for (int n = 0; n < 2; ++n) { const f32x4 uu = acc[ai][0][m][n], zz = acc[ai][1][m][n];
                        const f2 ga = pg8::gelu_pk((f2){uu[0], uu[1]}), gb = pg8::gelu_pk((f2){uu[2], uu[3]});
                        o[4 * n + 0] = ga.x * silu_f(zz[0]); o[4 * n + 1] = ga.y * silu_f(zz[1]); o[4 * n + 2] = gb.x * silu_f(zz[2]); o[4 * n + 3] = gb.y * silu_f(zz[3]); }
                    *(u32x4*)(UZ + row * 2048 + 128 * pn + cu) = pack8(o); }
        } else {
            bf16_t* V2 = (bf16_t*)(ws + WS_V2); f32x2* PART = (f32x2*)(ws + WS_PART);
#pragma unroll
            for (int ai = 0; ai < 2; ++ai)
#pragma unroll
                for (int m = 0; m < 4; ++m) { const size_t row = (size_t)(row0 + ai * 128 + m * 16); float s = 0.f, ss = 0.f;
#pragma unroll
                    for (int bj = 0; bj < 2; ++bj) { float o[8];
#pragma unroll
                        for (int n = 0; n < 2; ++n) { const f32x4 vv = acc[ai][bj][m][n];
                            const f2 ga = pg8::gelu_pk((f2){vv[0], vv[1]}), gb = pg8::gelu_pk((f2){vv[2], vv[3]});
                            o[4 * n + 0] = ga.x; o[4 * n + 1] = ga.y; o[4 * n + 2] = gb.x; o[4 * n + 3] = gb.y; }
#pragma unroll
                        for (int q = 0; q < 8; ++q) { s += o[q]; ss += o[q] * o[q]; }
                        *(u32x4*)(V2 + row * 2048 + 256 * (pn - 16) + 128 * bj + cu) = pack8(o); }
                    s += __shfl_xor(s, 16); ss += __shfl_xor(ss, 16); s += __shfl_xor(s, 32); ss += __shfl_xor(ss, 32);
                    if (fq == 0) PART[row * 32 + (pn - 16) * 4 + wc] = (f32x2){s, ss}; }
        }
    }
};

__device__ __forceinline__ void rs_rope_phase(const Params& p) {
    const int tid = tid_fresh(), lane = tid & 63, wave = tid >> 6, sub = lane & 7, rg = lane >> 3;
    unsigned char* ws = p.ws;
    const bf16_t* CQ = (const bf16_t*)(ws + WS_CQ); const bf16_t* CKV = (const bf16_t*)(ws + WS_CKV); const bf16_t* KR = (const bf16_t*)(ws + WS_KR);
    float* RS = (float*)(ws + WS_RS); const f32x2* ROPE = (const f32x2*)(ws + WS_ROPE); bf16_t* K = (bf16_t*)(ws + WS_K);
    for (int row0 = (blockIdx.x * 8 + wave) * 8; row0 < T_; row0 += gridDim.x * 64) {
        const int row = row0 + rg, b = row >> 12, s = row & 4095;
        float sq = 0.f, sk = 0.f;
#pragma unroll
        for (int q = 0; q < 4; ++q) { const u32x4 a = *(const u32x4*)(CQ + (size_t)row * 256 + sub * 32 + 8 * q); float f[8]; unpack8(a, f);
#pragma unroll
            for (int j = 0; j < 8; ++j) sq += f[j] * f[j]; }
#pragma unroll
        for (int q = 0; q < 2; ++q) { const u32x4 a = *(const u32x4*)(CKV + (size_t)row * 128 + sub * 16 + 8 * q); float f[8]; unpack8(a, f);
#pragma unroll
            for (int j = 0; j < 8; ++j) sk += f[j] * f[j]; }
        sq += __shfl_xor(sq, 1); sk += __shfl_xor(sk, 1); sq += __shfl_xor(sq, 2); sk += __shfl_xor(sk, 2); sq += __shfl_xor(sq, 4); sk += __shfl_xor(sk, 4);
        if (sub == 0) { f32x2 o; o.x = rsqrtf(sq * (1.0f / 256.0f) + EPS); o.y = rsqrtf(sk * (1.0f / 128.0f) + EPS); *(f32x2*)(RS + 2 * (size_t)row) = o; }
        const int i0 = 4 * sub;
        const u32x2 x1w = *(const u32x2*)(KR + (size_t)row * 64 + i0), x2w = *(const u32x2*)(KR + (size_t)row * 64 + 32 + i0);
        const f32x4 c01 = *(const f32x4*)(ROPE + (size_t)row * 32 + i0), c23 = *(const f32x4*)(ROPE + (size_t)row * 32 + i0 + 2);
        const float x1[4] = {bflo(x1w.x), bfhi(x1w.x), bflo(x1w.y), bfhi(x1w.y)}, x2[4] = {bflo(x2w.x), bfhi(x2w.x), bflo(x2w.y), bfhi(x2w.y)};
        const float cs[4] = {c01[0], c01[2], c23[0], c23[2]}, sn[4] = {c01[1], c01[3], c23[1], c23[3]};
        float o1[4], o2[4];
#pragma unroll
        for (int j = 0; j < 4; ++j) { o1[j] = x1[j] * cs[j] - x2[j] * sn[j]; o2[j] = x2[j] * cs[j] + x1[j] * sn[j]; }
        u32x2 w1, w2; w1.x = cvtpk(o1[0], o1[1]); w1.y = cvtpk(o1[2], o1[3]); w2.x = cvtpk(o2[0], o2[1]); w2.y = cvtpk(o2[2], o2[3]);
#pragma unroll
        for (int h = 0; h < 4; ++h) { bf16_t* kp = K + ((size_t)(b * 4 + h) * 4096 + s) * 192 + 128; *(u32x2*)(kp + i0) = w1; *(u32x2*)(kp + 32 + i0) = w2; }
    }
}

constexpr int GL_QF = 0, GL_KF = 9216, GL_QB = 18432, GL_KB = 27648, GL_VT = 36864, GL_ATT = 55296, GL_GRP = 64512, GL_W2 = 129024, GL_B2 = 137216, GL_ROW = 144;
static_assert(GL_B2 + 512 <= LDS_BYTES, "gla lds");

__device__ __forceinline__ void gla_stage_w2(const Params& p, int e, int h, LAS unsigned char* lds) {
    LAS float* W2L = (LAS float*)(lds + GL_W2); LAS float* B2L = (LAS float*)(lds + GL_B2);
    const int tid = tid_fresh();
    for (int idx = tid; idx < 2048; idx += 512) { const int dir = idx >> 10, d = (idx >> 4) & 63, r = idx & 15;
        W2L[idx] = p.in[dir ? I_W2B : I_W2F][((size_t)e * 16 + r) * 256 + h * 64 + d]; }
    if (tid < 128) { const int dir = tid >> 6, d = tid & 63; B2L[tid] = p.in[dir ? I_B2B : I_B2F][e * 256 + h * 64 + d]; }
}
__device__ __forceinline__ void gla_stage_vt(const Params& p, int b, int h, int chunk, LAS unsigned char* G, int gt) {
    const bf16_t* GV = (const bf16_t*)(p.ws + WS_GV);
    const int wv = gt >> 6, ln = gt & 63, c0 = 8 * ((ln >> 4) + 4 * wv);
#pragma unroll
    for (int i = 0; i < 2; ++i) { const int tp = (ln & 15) + 16 * i; const size_t tokA = (size_t)b * 4096 + chunk * 64 + 2 * tp;
        const u32x4 ra = *(const u32x4*)(GV + tokA * 512 + h * 128 + c0), rb = *(const u32x4*)(GV + (tokA + 1) * 512 + h * 128 + c0);
        const unsigned wa[4] = {ra.x, ra.y, ra.z, ra.w}, wb[4] = {rb.x, rb.y, rb.z, rb.w};
#pragma unroll
        for (int q = 0; q < 4; ++q) { const unsigned lo = (wa[q] & 0xffffu) | (wb[q] << 16), hi = (wa[q] >> 16) | (wb[q] & 0xffff0000u);
            *(LAS unsigned*)(G + GL_VT + (c0 + 2 * q) * GL_ROW + 4 * tp) = lo; *(LAS unsigned*)(G + GL_VT + (c0 + 2 * q + 1) * GL_ROW + 4 * tp) = hi; } }
}
__device__ __forceinline__ void gla_stage_ga(const Params& p, int b, int chunk, LAS unsigned char* G, int gt) {
    const float* ga = (const float*)(p.ws + WS_GA) + ((size_t)b * 4096 + chunk * 64) * 32;
#pragma unroll
    for (int i = 0; i < 2; ++i) { const int pc = gt + 256 * i; *(LAS f32x4*)(G + GL_ATT + (pc >> 3) * GL_ROW + (pc & 7) * 16) = *(const f32x4*)(ga + pc * 4); }
}
template <int CTRL, int ROWMASK> __device__ __forceinline__ float dpp_f(float src) {
    return __int_as_float(__builtin_amdgcn_update_dpp(0, __float_as_int(src), CTRL, ROWMASK, 0xf, false)); }
__device__ __forceinline__ float wave_incl_scan(float v) {
    v += dpp_f<0x111, 0xf>(v); v += dpp_f<0x112, 0xf>(v); v += dpp_f<0x114, 0xf>(v); v += dpp_f<0x118, 0xf>(v);
    v += dpp_f<0x142, 0xa>(v);
    v += dpp_f<0x143, 0xc>(v);
    return v; }
template <bool FOR_A>
__device__ __forceinline__ void gla_prep(const Params& p, int e, int b, int h, int chunk, LAS unsigned char* lds, LAS unsigned char* G, int wv, int lane) {
    const LAS float* W2L = (const LAS float*)(lds + GL_W2); const LAS float* B2L = (const LAS float*)(lds + GL_B2);
    const size_t tok = (size_t)b * 4096 + chunk * 64 + lane;
    float af[16], ab[16];
#pragma unroll
    for (int q = 0; q < 4; ++q) { const f32x4 x = *(const LAS f32x4*)(G + GL_ATT + lane * GL_ROW + 16 * q), y = *(const LAS f32x4*)(G + GL_ATT + lane * GL_ROW + 64 + 16 * q);
        af[4 * q] = x[0]; af[4 * q + 1] = x[1]; af[4 * q + 2] = x[2]; af[4 * q + 3] = x[3]; ab[4 * q] = y[0]; ab[4 * q + 1] = y[1]; ab[4 * q + 2] = y[2]; ab[4 * q + 3] = y[3]; }
    float pf[16], pb[16], gbv[16];
#pragma unroll
    for (int dd = 0; dd < 16; ++dd) { const int d = 16 * wv + dd; float xf = B2L[d], xb = B2L[64 + d];
#pragma unroll
        for (int q = 0; q < 4; ++q) { const f32x4 wf = *(const LAS f32x4*)(W2L + d * 16 + 4 * q), wb = *(const LAS f32x4*)(W2L + 1024 + d * 16 + 4 * q);
            xf += af[4 * q] * wf[0] + af[4 * q + 1] * wf[1] + af[4 * q + 2] * wf[2] + af[4 * q + 3] * wf[3];
            xb += ab[4 * q] * wb[0] + ab[4 * q + 1] * wb[1] + ab[4 * q + 2] * wb[2] + ab[4 * q + 3] * wb[3]; }
        pf[dd] = logsig_f(xf) * 0.0625f; gbv[dd] = logsig_f(xb) * 0.0625f; pb[dd] = gbv[dd]; }
#pragma unroll
    for (int dd = 0; dd < 16; ++dd) { pf[dd] = wave_incl_scan(pf[dd]); pb[dd] = wave_incl_scan(pb[dd]); }
#pragma unroll
    for (int dd = 0; dd < 16; ++dd) { const float tot = __int_as_float(__builtin_amdgcn_readlane(__float_as_int(pb[dd]), 63)); pb[dd] = tot - pb[dd] + gbv[dd]; }
    if (FOR_A) {
        float* EV = (float*)(p.ws + WS_EV);
#pragma unroll
        for (int dd = 0; dd < 16; ++dd) { const float tf = __int_as_float(__builtin_amdgcn_readlane(__float_as_int(pf[dd]), 63)), tb = __int_as_float(__builtin_amdgcn_readlane(__float_as_int(pb[dd]), 0));
            if (lane == 0) { EV[((size_t)((b * 4 + h) * 2 + 0) * 64 + chunk) * 64 + 16 * wv + dd] = __expf(tf); EV[((size_t)((b * 4 + h) * 2 + 1) * 64 + chunk) * 64 + 16 * wv + dd] = __expf(tb); } }
    }
#ifdef DBG_MAXP
    if (FOR_A) { float mx = 0.f;
        for (int dd = 0; dd < 16; ++dd) { mx = fmaxf(mx, DBG_MAXP); }
        atomicMax((int*)(p.ws + WS_PART) + 41, __float_as_int(mx)); }
#endif
    float kv[16], qv[16];
    { const bf16_t* kp = (const bf16_t*)(p.ws + WS_GK) + tok * 256 + h * 64 + 16 * wv; const u32x4 k0 = *(const u32x4*)kp, k1 = *(const u32x4*)(kp + 8);
      float t0[8], t1[8]; unpack8(k0, t0); unpack8(k1, t1);
#pragma unroll
      for (int q = 0; q < 8; ++q) { kv[q] = t0[q]; kv[8 + q] = t1[q]; } }
    if (!FOR_A) { const bf16_t* qp = (const bf16_t*)(p.ws + WS_GQ) + tok * 256 + h * 64 + 16 * wv; const u32x4 q0 = *(const u32x4*)qp, q1 = *(const u32x4*)(qp + 8);
      float t0[8], t1[8]; unpack8(q0, t0); unpack8(q1, t1);
#pragma unroll
      for (int q = 0; q < 8; ++q) { qv[q] = t0[q] * 0.125f; qv[8 + q] = t1[q] * 0.125f; } }
    if (FOR_A) {
#pragma unroll
        for (int dd = 0; dd < 16; ++dd) { const int d = 16 * wv + dd;
#ifdef DBG_NOEXP
            const float kf = kv[dd], kb = kv[dd];
#else
            const float kf = kv[dd] * __expf(-pf[dd]), kb = kv[dd] * __expf(-pb[dd]);
#endif
#ifdef DBG_KEXPR
            { const float vv = DBG_KEXPR; const float mv = (vv != vv) ? 7.7e7f : fabsf(vv); atomicMax((int*)(p.ws + WS_PART) + 41, __float_as_int(mv)); }
#endif

            *(LAS bf16_t*)(G + GL_QF + d * GL_ROW + 2 * lane) = (bf16_t)(cvtpk(kf, kf) & 0xffff);
            *(LAS bf16_t*)(G + GL_KF + d * GL_ROW + 2 * lane) = (bf16_t)(cvtpk(kb, kb) & 0xffff); }
    } else {
        float o[8];
#define GLA_PUT(OFF, EXPR0) do { _Pragma("unroll") for (int hf = 0; hf < 2; ++hf) { _Pragma("unroll") for (int q = 0; q < 8; ++q) { const int dd = 8 * hf + q; o[q] = (EXPR0); } \
            *(LAS u32x4*)(G + (OFF) + lane * GL_ROW + (16 * wv + 8 * hf) * 2) = pack8(o); } } while (0)
        GLA_PUT(GL_QF, qv[dd] * __expf(pf[dd]));
        GLA_PUT(GL_KF, kv[dd] * __expf(-pf[dd]));
        GLA_PUT(GL_QB, qv[dd] * __expf(pb[dd]));
        GLA_PUT(GL_KB, kv[dd] * __expf(-pb[dd]));
#undef GLA_PUT
    }
}

__device__ __forceinline__ void gla_a_phase(const Params& p, int e, LAS unsigned char* lds) {
    const int tid = tid_fresh(), grp = __builtin_amdgcn_readfirstlane(tid >> 8), wv = __builtin_amdgcn_readfirstlane((tid & 255) >> 6);
    LAS unsigned char* G = lds + grp * GL_GRP;
    bf16_t* ST = (bf16_t*)(p.ws + WS_ST);
    int h_staged = -1;
    for (int it = blockIdx.x; it < 1024; it += gridDim.x) {
        int lane = tid & 63; asm volatile("" : "+v"(lane));
        const int gt = 64 * wv + lane, tq = lane & 15, quad = lane >> 4;
        const int b = it >> 7, h = (it >> 5) & 3, chunk = 2 * (it & 31) + grp;
        __syncthreads();
        if (h != h_staged) { gla_stage_w2(p, e, h, lds); h_staged = h; }
        gla_stage_ga(p, b, chunk, G, gt);
        __syncthreads();
        gla_prep<true>(p, e, b, h, chunk, lds, G, wv, lane);
        gla_stage_vt(p, b, h, chunk, G, gt);
        __syncthreads();
        const int dir = wv >> 1, ch = wv & 1;
        LAS unsigned char* KT = G + (dir ? GL_KF : GL_QF);
        f32x4 acc[4][4];
#pragma unroll
        for (int mb = 0; mb < 4; ++mb)
#pragma unroll
            for (int nb = 0; nb < 4; ++nb) acc[mb][nb] = (f32x4){0.f, 0.f, 0.f, 0.f};
#pragma unroll
        for (int ks = 0; ks < 2; ++ks) { bf16x8 a[4], bb[4];
#pragma unroll
            for (int mb = 0; mb < 4; ++mb) a[mb] = *(const LAS bf16x8*)(KT + (16 * mb + tq) * GL_ROW + (32 * ks + 8 * quad) * 2);
#pragma unroll
            for (int nb = 0; nb < 4; ++nb) bb[nb] = *(const LAS bf16x8*)(G + GL_VT + (64 * ch + 16 * nb + tq) * GL_ROW + (32 * ks + 8 * quad) * 2);
#pragma unroll
            for (int mb = 0; mb < 4; ++mb)
#pragma unroll
                for (int nb = 0; nb < 4; ++nb) acc[mb][nb] = MFMA16(a[mb], bb[nb], acc[mb][nb]); }
        bf16_t* slot = ST + ((size_t)((b * 4 + h) * 2 + dir) * 64 + chunk) * 8192;
#pragma unroll
        for (int mb = 0; mb < 4; ++mb)
#pragma unroll
            for (int nb = 0; nb < 4; ++nb) { const int c = 64 * ch + 16 * nb + tq, d = 16 * mb + 4 * quad; const f32x4 v = acc[mb][nb];
                u32x2 w; w.x = cvtpk(v[0], v[1]); w.y = cvtpk(v[2], v[3]); *(u32x2*)(slot + c * 64 + d) = w; }
    }
}
__device__ __forceinline__ void gla_b_phase(const Params& p, bool dry = false) {
    bf16_t* ST = (bf16_t*)(p.ws + WS_ST); const float* EV = (const float*)(p.ws + WS_EV);
    const int tid = tid_fresh();
    for (int e = blockIdx.x * 512 + tid; e < 131072; e += gridDim.x * 512) {
        const int seq = e >> 11, within = e & 2047, dq = within & 15, dir = seq & 1;
        bf16_t* sp = ST + (size_t)seq * 64 * 8192 + within * 4; const float* ep = EV + (size_t)seq * 64 * 64 + dq * 4;
        float S0 = 0.f, S1 = 0.f, S2 = 0.f, S3 = 0.f;
        for (int k0 = 0; k0 < 64; k0 += 8) { u32x2 uu[8]; f32x4 ee[8];
#pragma unroll
            for (int q = 0; q < 8; ++q) { const int ck = dir ? 63 - (k0 + q) : (k0 + q); uu[q] = *(const u32x2*)(sp + (size_t)ck * 8192); ee[q] = *(const f32x4*)(ep + ck * 64); }
#pragma unroll
            for (int q = 0; q < 8; ++q) { const int ck = dir ? 63 - (k0 + q) : (k0 + q);
                u32x2 w; w.x = cvtpk(S0, S1); w.y = cvtpk(S2, S3); if (!dry || S0 == 1.2345e33f) *(u32x2*)(sp + (size_t)ck * 8192) = w;
                S0 = ee[q][0] * (S0 + bflo(uu[q].x)); S1 = ee[q][1] * (S1 + bfhi(uu[q].x)); S2 = ee[q][2] * (S2 + bflo(uu[q].y)); S3 = ee[q][3] * (S3 + bfhi(uu[q].y)); } }
    }
}
__device__ __forceinline__ void gla_c_phase(const Params& p, int e, LAS unsigned char* lds) {
    const int tid = tid_fresh(), grp = __builtin_amdgcn_readfirstlane(tid >> 8), wv = __builtin_amdgcn_readfirstlane((tid & 255) >> 6);
    LAS unsigned char* G = lds + grp * GL_GRP;
    const bf16_t* ST = (const bf16_t*)(p.ws + WS_ST); const bf16_t* GZ = (const bf16_t*)(p.ws + WS_GZ); bf16_t* O = (bf16_t*)(p.ws + WS_H);
    int h_staged = -1;
    for (int it = blockIdx.x; it < 1024; it += gridDim.x) {
        int lane = tid & 63; asm volatile("" : "+v"(lane));
        const int gt = 64 * wv + lane, tq = lane & 15, quad = lane >> 4;
        const int b = it >> 7, h = (it >> 5) & 3, chunk = 2 * (it & 31) + grp;
        __syncthreads();
        if (h != h_staged) { gla_stage_w2(p, e, h, lds); h_staged = h; }
        gla_stage_ga(p, b, chunk, G, gt);
        __syncthreads();
        gla_prep<false>(p, e, b, h, chunk, lds, G, wv, lane);
        gla_stage_vt(p, b, h, chunk, G, gt);
        __syncthreads();
        const int t = 16 * wv + tq;
        u32x4 stf[4], stb[4];
        { const bf16_t* slf = ST + ((size_t)((b * 4 + h) * 2 + 0) * 64 + chunk) * 8192; const bf16_t* slb = ST + ((size_t)((b * 4 + h) * 2 + 1) * 64 + chunk) * 8192;
#pragma unroll
          for (int i = 0; i < 4; ++i) { const int pc = gt + 256 * i; stf[i] = *(const u32x4*)(slf + pc * 8); stb[i] = *(const u32x4*)(slb + pc * 8); } }
        bf16x8 bqf[2], bqb[2];
        {
            f32x4 sf[4], sb[4];
#pragma unroll
            for (int mb = 0; mb < 4; ++mb) { sf[mb] = (f32x4){0.f, 0.f, 0.f, 0.f}; sb[mb] = (f32x4){0.f, 0.f, 0.f, 0.f}; }
#pragma unroll
            for (int ks = 0; ks < 2; ++ks) { const int ko = (32 * ks + 8 * quad) * 2;
                bqf[ks] = *(const LAS bf16x8*)(G + GL_QF + t * GL_ROW + ko); bqb[ks] = *(const LAS bf16x8*)(G + GL_QB + t * GL_ROW + ko);
#pragma unroll
                for (int mb = 0; mb < 4; ++mb) { const bf16x8 akf = *(const LAS bf16x8*)(G + GL_KF + (16 * mb + tq) * GL_ROW + ko), akb = *(const LAS bf16x8*)(G + GL_KB + (16 * mb + tq) * GL_ROW + ko);
                    sf[mb] = MFMA16(akf, bqf[ks], sf[mb]); sb[mb] = MFMA16(akb, bqb[ks], sb[mb]); } }
#pragma unroll
            for (int mb = 0; mb < 4; ++mb) { const int s0 = 16 * mb + 4 * quad; float v[4];
#pragma unroll
                for (int j = 0; j < 4; ++j) v[j] = (s0 + j <= t) ? sf[mb][j] : sb[mb][j];
                u32x2 w; w.x = cvtpk(v[0], v[1]); w.y = cvtpk(v[2], v[3]); *(LAS u32x2*)(G + GL_ATT + t * GL_ROW + s0 * 2) = w; }
        }
        __syncthreads();
#pragma unroll
        for (int i = 0; i < 4; ++i) { const int pc = gt + 256 * i, c = pc >> 3, c8 = pc & 7;
            *(LAS u32x4*)(G + c * GL_ROW + c8 * 16) = stf[i]; *(LAS u32x4*)(G + 18432 + c * GL_ROW + c8 * 16) = stb[i]; }
        f32x4 o[8];
#pragma unroll
        for (int mb = 0; mb < 8; ++mb) o[mb] = (f32x4){0.f, 0.f, 0.f, 0.f};
        const int crow0 = 8 * (tq >> 2) + (tq & 3);
#pragma unroll
        for (int ks = 0; ks < 2; ++ks) { const int ko = (32 * ks + 8 * quad) * 2; const bf16x8 batt = *(const LAS bf16x8*)(G + GL_ATT + t * GL_ROW + ko);
#pragma unroll
            for (int mb = 0; mb < 8; ++mb) { const int c = 32 * (mb >> 1) + crow0 + 4 * (mb & 1);
                const bf16x8 av = *(const LAS bf16x8*)(G + GL_VT + c * GL_ROW + ko); o[mb] = MFMA16(av, batt, o[mb]); } }
        __syncthreads();
#pragma unroll
        for (int dir = 0; dir < 2; ++dir) {
#pragma unroll
            for (int ks = 0; ks < 2; ++ks) { const int ko = (32 * ks + 8 * quad) * 2; const bf16x8 bq = dir ? bqb[ks] : bqf[ks];
#pragma unroll
                for (int mb = 0; mb < 8; ++mb) { const int c = 32 * (mb >> 1) + crow0 + 4 * (mb & 1);
                    const bf16x8 as = *(const LAS bf16x8*)(G + dir * 18432 + c * GL_ROW + ko); o[mb] = MFMA16(as, bq, o[mb]); } } }
        float ss = 0.f;
#pragma unroll
        for (int mb = 0; mb < 8; ++mb) ss += o[mb][0] * o[mb][0] + o[mb][1] * o[mb][1] + o[mb][2] * o[mb][2] + o[mb][3] * o[mb][3];
        ss += __shfl_xor(ss, 16); ss += __shfl_xor(ss, 32);
        const float rs = rsqrtf(ss * (1.0f / 128.0f) + EPS);
        const size_t tok = (size_t)b * 4096 + chunk * 64 + t;
#pragma unroll
        for (int pp = 0; pp < 4; ++pp) { const int c0 = 32 * pp + 8 * quad;
            const u32x4 gzw = *(const u32x4*)(GZ + tok * 512 + h * 128 + c0); float z[8]; unpack8(gzw, z);
            const f32x4 g0 = *(const f32x4*)(p.in[I_GNORM] + e * 128 + c0), g1 = *(const f32x4*)(p.in[I_GNORM] + e * 128 + c0 + 4);
            float r[8];
#pragma unroll
            for (int j = 0; j < 4; ++j) { r[j] = o[2 * pp][j] * rs * g0[j] * silu_f(z[j]); r[4 + j] = o[2 * pp + 1][j] * rs * g1[j] * silu_f(z[4 + j]); }
            *(u32x4*)(O + tok * 1024 + h * 128 + c0) = pack8(r); }
    }
}

#ifndef ATT_EARLY
#define ATT_EARLY 1
#endif
namespace att {
constexpr int DQK = 192, DV = 128, NW = 8, QBLK = 32, KVBLK = 64;
constexpr float SCALE = 0.07216878364870323f;
constexpr float THR = 8.f;
constexpr int SDEPTH = ATT_SDEPTH;
constexpr int SHM_V = KVBLK * DV * 2, SHM_K = KVBLK * DQK * 2;
constexpr int SHM_QR = 2 * SHM_V + 2 * SHM_K + NW * 64 * 4;
constexpr int NQR = ATT_NQR;
constexpr int SHM_ATTN = SHM_QR + NW * (12 - NQR) * 1024;
#define KSWZ(row, colB) ((row) * 384 + ((colB) ^ (((row) & 7) << 4)))
#define SBAR() __builtin_amdgcn_sched_barrier(0)
__device__ __forceinline__ int crow(int r, int hi) { return (r & 3) + 8 * (r >> 2) + 4 * hi; }
__device__ __forceinline__ unsigned cvtpkv(float lo, float hi) { unsigned r; asm volatile("v_cvt_pk_bf16_f32 %0, %1, %2" : "=v"(r) : "v"(lo), "v"(hi)); return r; }

__device__ __forceinline__ void partialSM(f32x16& p0, f32x16& p1, float& m_reg, float& mn, float& alpha) {
  constexpr float C = SCALE * 1.4426950408889634f;
  float pmax = p0[0];
#pragma unroll
  for (int r = 1; r < 16; ++r) pmax = fmaxf(pmax, p0[r]);
#pragma unroll
  for (int r = 0; r < 16; ++r) pmax = fmaxf(pmax, p1[r]);
  { auto rr = __builtin_amdgcn_permlane32_swap(__float_as_uint(pmax), __float_as_uint(pmax), false, false);
    pmax = fmaxf(__uint_as_float(rr[0]), __uint_as_float(rr[1])); }
  if (__builtin_expect(__all(pmax - m_reg <= THR / SCALE), 1)) { mn = m_reg; alpha = 1.f; }
  else { mn = fmaxf(m_reg, pmax); alpha = __builtin_amdgcn_exp2f((m_reg - mn) * C); m_reg = mn; }
  float mnC = -mn * C;
#pragma unroll
  for (int r = 0; r < 16; ++r) p0[r] = fmaf(p0[r], C, mnC);
#pragma unroll
  for (int r = 0; r < 16; ++r) p1[r] = fmaf(p1[r], C, mnC);
#pragma unroll
  for (int r = 0; r < 16; ++r) p0[r] = __builtin_amdgcn_exp2f(p0[r]);
}
__device__ __forceinline__ void finishSM(f32x16& p0, f32x16& p1, float alpha, float& l_reg, bf16x8& pa0, bf16x8& pa1, bf16x8& pa2, bf16x8& pa3) {
#pragma unroll
  for (int r = 0; r < 16; ++r) p1[r] = __builtin_amdgcn_exp2f(p1[r]);
  float ps = 0;
#pragma unroll
  for (int r = 0; r < 16; ++r) ps += p0[r];
#pragma unroll
  for (int r = 0; r < 16; ++r) ps += p1[r];
  { auto rr = __builtin_amdgcn_permlane32_swap(__float_as_uint(ps), __float_as_uint(ps), false, false);
    ps = __uint_as_float(rr[0]) + __uint_as_float(rr[1]); }
  l_reg = l_reg * alpha + ps;
#define PK4(P, BASE, OUT) do { unsigned a0 = cvtpkv(P[BASE + 0], P[BASE + 1]), a1 = cvtpkv(P[BASE + 2], P[BASE + 3]);   \
    unsigned b0 = cvtpkv(P[BASE + 4], P[BASE + 5]), b1 = cvtpkv(P[BASE + 6], P[BASE + 7]);                              \
    auto r0 = __builtin_amdgcn_permlane32_swap(a0, b0, false, false); auto r1 = __builtin_amdgcn_permlane32_swap(a1, b1, false, false); \
    u32x4 w = {r0[0], r1[0], r0[1], r1[1]}; OUT = *reinterpret_cast<bf16x8*>(&w); } while (0)
  PK4(p0, 0, pa0); PK4(p0, 8, pa1); PK4(p1, 0, pa2); PK4(p1, 8, pa3);
#undef PK4
}
__device__ __forceinline__ void qkt(f32x16& p0, f32x16& p1, const char* Ks, const bf16x8* qr, const char* qrl, int r32, int hi) {
  p0 = f32x16{}; p1 = f32x16{};
#pragma unroll
  for (int d0 = 0; d0 < 12; ++d0) { int cb = (d0 * 16 + hi * 8) * 2;
    bf16x8 b0 = *reinterpret_cast<const bf16x8*>(Ks + KSWZ(r32, cb));
    bf16x8 b1 = *reinterpret_cast<const bf16x8*>(Ks + KSWZ(32 + r32, cb));
    const bf16x8 q = d0 < NQR ? qr[d0 < NQR ? d0 : 0] : *reinterpret_cast<const bf16x8*>(qrl + (d0 - NQR) * 1024);
    p0 = __builtin_amdgcn_mfma_f32_32x32x16_bf16(b0, q, p0, 0, 0, 0);
    p1 = __builtin_amdgcn_mfma_f32_32x32x16_bf16(b1, q, p1, 0, 0, 0); }
}
__device__ __forceinline__ int v_st(int k, int c) { const int kk = (k & ~0xC) | ((k & 4) << 1) | ((k & 8) >> 1); return ((kk >> 3) * 4 + (c >> 5)) * 512 + ((kk & 7) * 32 + (c & 31)) * 2; }
__device__ __forceinline__ int v_rd_base(int lane) { return ((lane & 3) << 3) | (((lane >> 2) & 3) << 6) | (((lane >> 4) & 1) << 5) | (((lane >> 5) & 1) << 8); }
constexpr int v_rd_off(int d0, int ks, int half) { return d0 * 512 + ks * 4096 + half * 2048; }
template <int OFF> __device__ __forceinline__ s16x4 tr_read(int vb) {
  s16x4 r; asm volatile("ds_read_b64_tr_b16 %0, %1 offset:%2" : "=&v"(r) : "v"(vb), "i"(OFF) : "memory"); return r;
}
template <int D0> __device__ __forceinline__ void pv_one(f32x16& od, int vb, bf16x8 pa0, bf16x8 pa1, bf16x8 pa2, bf16x8 pa3) {
  const s16x4 l0 = tr_read<v_rd_off(D0, 0, 0)>(vb), h0 = tr_read<v_rd_off(D0, 0, 1)>(vb), l1 = tr_read<v_rd_off(D0, 1, 0)>(vb), h1 = tr_read<v_rd_off(D0, 1, 1)>(vb);
  const s16x4 l2 = tr_read<v_rd_off(D0, 2, 0)>(vb), h2 = tr_read<v_rd_off(D0, 2, 1)>(vb), l3 = tr_read<v_rd_off(D0, 3, 0)>(vb), h3 = tr_read<v_rd_off(D0, 3, 1)>(vb);
  asm volatile("s_waitcnt lgkmcnt(0)" ::: "memory"); SBAR();
#define PK(L, H) (bf16x8){L[0], L[1], L[2], L[3], H[0], H[1], H[2], H[3]}
  od = __builtin_amdgcn_mfma_f32_32x32x16_bf16(pa0, PK(l0, h0), od, 0, 0, 0);
  od = __builtin_amdgcn_mfma_f32_32x32x16_bf16(pa1, PK(l1, h1), od, 0, 0, 0);
  od = __builtin_amdgcn_mfma_f32_32x32x16_bf16(pa2, PK(l2, h2), od, 0, 0, 0);
  od = __builtin_amdgcn_mfma_f32_32x32x16_bf16(pa3, PK(l3, h3), od, 0, 0, 0);
#undef PK
}
__device__ __forceinline__ void pv_d0(f32x16* o, int vb, bf16x8 pa0, bf16x8 pa1, bf16x8 pa2, bf16x8 pa3) {
  pv_one<0>(o[0], vb, pa0, pa1, pa2, pa3); pv_one<1>(o[1], vb, pa0, pa1, pa2, pa3); pv_one<2>(o[2], vb, pa0, pa1, pa2, pa3); pv_one<3>(o[3], vb, pa0, pa1, pa2, pa3);
}

template <int OFF> __device__ __forceinline__ bf16x8 lds_rd128(int a) { bf16x8 r; asm volatile("ds_read_b128 %0, %1 offset:%2" : "=&v"(r) : "v"(a), "i"(OFF) : "memory"); return r; }
template <int N> __device__ __forceinline__ void lgkm_wait2(bf16x8& a, bf16x8& b) { asm volatile("s_waitcnt lgkmcnt(%2)" : "+v"(a), "+v"(b) : "n"(N) : "memory"); }
template <int N> __device__ __forceinline__ void lgkm_wait3(bf16x8& a, bf16x8& b, bf16x8& c) { asm volatile("s_waitcnt lgkmcnt(%3)" : "+v"(a), "+v"(b), "+v"(c) : "n"(N) : "memory"); }
template <int N> __device__ __forceinline__ void lgkm_wait2s(s16x4& a, s16x4& b) { asm volatile("s_waitcnt lgkmcnt(%2)" : "+v"(a), "+v"(b) : "n"(N) : "memory"); }
constexpr int k_off(int buf, int d0, int half) { return buf * SHM_K + (d0 >> 2) * 128 + half * 12288; }
constexpr int q_off(int d0) { return (d0 >= NQR ? d0 - NQR : 0) * 1024; }
template <int BUF, int D0> __device__ __forceinline__ void k_fetch(bf16x8& b0, bf16x8& b1, bf16x8& qx, const int (&ka)[4], int qa) {
  b0 = lds_rd128<k_off(BUF, D0, 0)>(ka[D0 & 3]); b1 = lds_rd128<k_off(BUF, D0, 1)>(ka[D0 & 3]);
  if constexpr (D0 >= NQR) qx = lds_rd128<q_off(D0)>(qa);
}
template <int BUF, int D0> __device__ __forceinline__ void qk_step(f32x16& p0, f32x16& p1, bf16x8 (&b0)[2], bf16x8 (&b1)[2], bf16x8 (&qx)[2], const bf16x8* qr, const int (&ka)[4], int qa) {
  if constexpr (D0 < 11) k_fetch<BUF, D0 + 1>(b0[(D0 + 1) & 1], b1[(D0 + 1) & 1], qx[(D0 + 1) & 1], ka, qa);
  constexpr int PEND = D0 < 11 ? (2 + ((D0 + 1) >= NQR ? 1 : 0)) : 0;
  if constexpr (D0 >= NQR) lgkm_wait3<PEND>(b0[D0 & 1], b1[D0 & 1], qx[D0 & 1]); else lgkm_wait2<PEND>(b0[D0 & 1], b1[D0 & 1]);
  const bf16x8 q = D0 < NQR ? qr[D0 < NQR ? D0 : 0] : qx[D0 & 1];
  p0 = __builtin_amdgcn_mfma_f32_32x32x16_bf16(b0[D0 & 1], q, p0, 0, 0, 0);
  p1 = __builtin_amdgcn_mfma_f32_32x32x16_bf16(b1[D0 & 1], q, p1, 0, 0, 0);
}
template <int BUF> __device__ __forceinline__ void qkt2(f32x16& p0, f32x16& p1, const bf16x8* qr, const int (&ka)[4], int qa) {
  p0 = f32x16{}; p1 = f32x16{};
  bf16x8 b0[2], b1[2], qx[2];
  k_fetch<BUF, 0>(b0[0], b1[0], qx[0], ka, qa);
  qk_step<BUF, 0>(p0, p1, b0, b1, qx, qr, ka, qa); qk_step<BUF, 1>(p0, p1, b0, b1, qx, qr, ka, qa); qk_step<BUF, 2>(p0, p1, b0, b1, qx, qr, ka, qa); qk_step<BUF, 3>(p0, p1, b0, b1, qx, qr, ka, qa);
  qk_step<BUF, 4>(p0, p1, b0, b1, qx, qr, ka, qa); qk_step<BUF, 5>(p0, p1, b0, b1, qx, qr, ka, qa); qk_step<BUF, 6>(p0, p1, b0, b1, qx, qr, ka, qa); qk_step<BUF, 7>(p0, p1, b0, b1, qx, qr, ka, qa);
  qk_step<BUF, 8>(p0, p1, b0, b1, qx, qr, ka, qa); qk_step<BUF, 9>(p0, p1, b0, b1, qx, qr, ka, qa); qk_step<BUF, 10>(p0, p1, b0, b1, qx, qr, ka, qa); qk_step<BUF, 11>(p0, p1, b0, b1, qx, qr, ka, qa);
}
template <int BUF, int S> __device__ __forceinline__ void v_fetch(s16x4& l, s16x4& h, int vb) {
  l = tr_read<BUF * SHM_V + v_rd_off(S & 3, S >> 2, 0)>(vb); h = tr_read<BUF * SHM_V + v_rd_off(S & 3, S >> 2, 1)>(vb);
}
template <int BUF, int S> __device__ __forceinline__ void pv_step(f32x16* o, s16x4 (&l)[3], s16x4 (&h)[3], int vb, const bf16x8 (&pa)[4]) {
  if constexpr (S + 2 < 16) v_fetch<BUF, S + 2>(l[(S + 2) % 3], h[(S + 2) % 3], vb);
  constexpr int PEND = S + 2 < 16 ? 4 : (S + 1 < 16 ? 2 : 0);
  lgkm_wait2s<PEND>(l[S % 3], h[S % 3]);
  const s16x4 L = l[S % 3], H = h[S % 3];
  o[S & 3] = __builtin_amdgcn_mfma_f32_32x32x16_bf16(pa[S >> 2], (bf16x8){L[0], L[1], L[2], L[3], H[0], H[1], H[2], H[3]}, o[S & 3], 0, 0, 0);
}
template <int BUF> __device__ __forceinline__ void pv2(f32x16* o, int vb, bf16x8 pa0, bf16x8 pa1, bf16x8 pa2, bf16x8 pa3) {
  s16x4 l[3], h[3]; const bf16x8 pa[4] = {pa0, pa1, pa2, pa3};
  v_fetch<BUF, 0>(l[0], h[0], vb); v_fetch<BUF, 1>(l[1], h[1], vb);
  pv_step<BUF, 0>(o, l, h, vb, pa); pv_step<BUF, 1>(o, l, h, vb, pa); pv_step<BUF, 2>(o, l, h, vb, pa); pv_step<BUF, 3>(o, l, h, vb, pa);
  pv_step<BUF, 4>(o, l, h, vb, pa); pv_step<BUF, 5>(o, l, h, vb, pa); pv_step<BUF, 6>(o, l, h, vb, pa); pv_step<BUF, 7>(o, l, h, vb, pa);
  pv_step<BUF, 8>(o, l, h, vb, pa); pv_step<BUF, 9>(o, l, h, vb, pa); pv_step<BUF, 10>(o, l, h, vb, pa); pv_step<BUF, 11>(o, l, h, vb, pa);
  pv_step<BUF, 12>(o, l, h, vb, pa); pv_step<BUF, 13>(o, l, h, vb, pa); pv_step<BUF, 14>(o, l, h, vb, pa); pv_step<BUF, 15>(o, l, h, vb, pa);
}

__device__ __forceinline__ void attn_body(const bf16_t* __restrict__ Qb, const bf16_t* __restrict__ Kh, const bf16_t* __restrict__ Vh,
                                          const bf16_t* __restrict__ MZb, bf16_t* __restrict__ Ob, int seq, char* lds) {
  const int tid = tid_fresh(), wid = __builtin_amdgcn_readfirstlane(tid >> 6), lane = tid & 63, r32 = lane & 31, hi = lane >> 5;
  char* V_lds = lds; char* K_lds = lds + 2 * SHM_V;
  float* wsl = (float*)(lds + 2 * SHM_V + 2 * SHM_K) + wid * 64; float* li_l = wsl; float* al_l = wsl + 32;
  float m_reg = -1e30f, l_reg = 0; f32x16 o[4] = {}; bf16x8 qr[NQR];
  char* qrl = lds + SHM_QR + wid * ((12 - NQR) * 1024) + lane * 16;
  const bf16_t* Qw = Qb + (long)(wid * QBLK + r32) * DQK + hi * 8;
#pragma unroll
  for (int d0 = 0; d0 < NQR; ++d0) qr[d0] = *reinterpret_cast<const bf16x8*>(Qw + d0 * 16);
#pragma unroll
  for (int d0 = NQR; d0 < 12; ++d0) *reinterpret_cast<bf16x8*>(qrl + (d0 - NQR) * 1024) = *reinterpret_cast<const bf16x8*>(Qw + d0 * 16);
  const int sr = tid >> 4, sc = (tid & 15) * 8, vst0 = v_st(sr, sc);
  const int sr2 = tid >> 3, sl2 = 16 + (tid & 7);
  const unsigned kg0 = sr * DQK + sc, kg2 = sr2 * DQK + sl2 * 8, voff0 = sr * DV + sc;
  const int kl0 = KSWZ(sr, sc * 2), kl2 = KSWZ(sr2, sl2 * 16);
  const int vb0 = (int)(uintptr_t)(LAS char*)V_lds + v_rd_base(lane);
  int ka[4]; { const int kbase = (int)(uintptr_t)(LAS char*)K_lds + r32 * 384;
#pragma unroll
    for (int j = 0; j < 4; ++j) ka[j] = kbase + ((j * 32 + hi * 16) ^ ((r32 & 7) << 4)); }
  const int qa = (int)(uintptr_t)(LAS char*)qrl;
  struct { bf16x8 vs0, vs1, ks0, ks1, ks2; } sr_[SDEPTH];
#define SLOAD(i, k0) do { const bf16_t* Kt = Kh + (size_t)(k0) * DQK; const bf16_t* Vt = Vh + (size_t)(k0) * DV; \
    sr_[i].vs0 = *(const bf16x8*)(Vt + voff0); sr_[i].vs1 = *(const bf16x8*)(Vt + voff0 + 32 * DV); \
    sr_[i].ks0 = *(const bf16x8*)(Kt + kg0); sr_[i].ks1 = *(const bf16x8*)(Kt + kg0 + 32 * DQK); sr_[i].ks2 = *(const bf16x8*)(Kt + kg2); } while (0)
#define SWRITE(b, i) do { *(bf16x8*)(V_lds + (b) * SHM_V + vst0) = sr_[i].vs0; *(bf16x8*)(V_lds + (b) * SHM_V + vst0 + 8192) = sr_[i].vs1; \
    *(bf16x8*)(K_lds + (b) * SHM_K + kl0) = sr_[i].ks0; *(bf16x8*)(K_lds + (b) * SHM_K + kl0 + 32 * 384) = sr_[i].ks1; *(bf16x8*)(K_lds + (b) * SHM_K + kl2) = sr_[i].ks2; } while (0)
#define SWAIT() do { if constexpr (SDEPTH == 2) asm volatile("s_waitcnt vmcnt(5)" ::: "memory"); else asm volatile("s_waitcnt vmcnt(0)" ::: "memory"); } while (0)
#define RESC(a) do { if (__any((a) < 1.f)) { if (hi == 0) al_l[r32] = (a); asm volatile("s_waitcnt lgkmcnt(0)" ::: "memory"); \
    _Pragma("unroll") for (int d = 0; d < 4; ++d) _Pragma("unroll") for (int r = 0; r < 16; ++r) o[d][r] *= al_l[crow(r, hi)]; } } while (0)
  f32x16 pA0, pA1, pB0, pB1; float mnA, mnB, alA, alB; bf16x8 pa0, pa1, pa2, pa3; const int NT = seq / KVBLK;
  constexpr int SE = 0, SO = SDEPTH - 1;
  SLOAD(SE, 0); asm volatile("s_waitcnt vmcnt(0)" ::: "memory"); SWRITE(0, SE); __syncthreads();
  qkt2<0>(pA0, pA1, qr, ka, qa); partialSM(pA0, pA1, m_reg, mnA, alA);
  SLOAD(SO, KVBLK); if constexpr (SDEPTH == 2) { if (2 < NT) SLOAD(SE, 2 * KVBLK); }
  SWAIT(); SWRITE(1, SO); __syncthreads();
  for (int j = 1; j + 1 < NT; j += 2) {
#if ATT_EARLY
    SBAR(); SLOAD(SO, (j + SDEPTH) * KVBLK); SBAR();
#endif
    SBAR(); qkt2<1>(pB0, pB1, qr, ka, qa);
    finishSM(pA0, pA1, alA, l_reg, pa0, pa1, pa2, pa3); SBAR();
#if !ATT_EARLY
    SLOAD(SO, (j + SDEPTH) * KVBLK); SBAR();
#endif
    pv2<0>(o, vb0, pa0, pa1, pa2, pa3); partialSM(pB0, pB1, m_reg, mnB, alB);
    __syncthreads(); SWAIT(); SWRITE(0, SE);
    RESC(alB); __syncthreads();
#if ATT_EARLY
    SBAR(); if (SDEPTH == 1 || j + 3 < NT) SLOAD(SE, (j + 1 + SDEPTH) * KVBLK); SBAR();
#endif
    SBAR(); qkt2<0>(pA0, pA1, qr, ka, qa);
    finishSM(pB0, pB1, alB, l_reg, pa0, pa1, pa2, pa3); SBAR();
#if !ATT_EARLY
    if (SDEPTH == 1 || j + 3 < NT) SLOAD(SE, (j + 1 + SDEPTH) * KVBLK); SBAR();
#endif
    pv2<1>(o, vb0, pa0, pa1, pa2, pa3); partialSM(pA0, pA1, m_reg, mnA, alA);
    __syncthreads(); SWAIT(); SWRITE(1, SO);
    RESC(alA); __syncthreads();
  }
  SBAR(); qkt2<1>(pB0, pB1, qr, ka, qa);
  finishSM(pA0, pA1, alA, l_reg, pa0, pa1, pa2, pa3); SBAR();
  pv2<0>(o, vb0, pa0, pa1, pa2, pa3); partialSM(pB0, pB1, m_reg, mnB, alB);
  __syncthreads(); RESC(alB);
  finishSM(pB0, pB1, alB, l_reg, pa0, pa1, pa2, pa3); SBAR();
  pv2<1>(o, vb0, pa0, pa1, pa2, pa3);
  if (hi == 0) li_l[r32] = l_reg; asm volatile("s_waitcnt lgkmcnt(0)" ::: "memory");
  float rli[16];
#pragma unroll
  for (int r = 0; r < 16; ++r) rli[r] = __builtin_amdgcn_rcpf(li_l[crow(r, hi)]);
  __syncthreads();
  int ln = lane; asm volatile("" : "+v"(ln));
  char* Tw = lds + wid * 8192; const int r32l = ln & 31, hil = ln >> 5;
#pragma unroll
  for (int r = 0; r < 16; ++r) { const int ro = (r & 3) + 8 * (r >> 2);
#pragma unroll
    for (int d0 = 0; d0 < 4; ++d0) { const float v = o[d0][r] * rli[r];
      *(bf16_t*)(Tw + (ro + 4 * hil) * 256 + (32 * d0 + r32l) * 2) = (bf16_t)(cvtpk(v, v) & 0xffff); } }
  asm volatile("" ::: "memory");
  bf16_t* Ow = Ob + (size_t)(wid * QBLK) * 1024; const bf16_t* Zw = MZb + (size_t)(wid * QBLK) * 512;
#pragma unroll
  for (int i = 0; i < 8; ++i) { const int pc = ln + 64 * i, row = pc >> 4, c8 = pc & 15;
    const u32x4 ov = *(const u32x4*)(Tw + row * 256 + c8 * 16), zv = *(const u32x4*)(Zw + (unsigned)(row * 512 + c8 * 8));
    float fo[8], fz[8]; unpack8(ov, fo); unpack8(zv, fz);
#pragma unroll
    for (int j = 0; j < 8; ++j) fo[j] *= silu_f(fz[j]);
    *(u32x4*)(Ow + (unsigned)(row * 1024 + c8 * 8)) = pack8(fo); }
#undef SLOAD
#undef SWRITE
#undef SWAIT
#undef RESC
}
}

__device__ __forceinline__ void attn_phase(const Params& p, unsigned char* lds_generic) {
    const bf16_t* Q = (const bf16_t*)(p.ws + WS_Q); const bf16_t* K = (const bf16_t*)(p.ws + WS_K); const bf16_t* V = (const bf16_t*)(p.ws + WS_V);
    const bf16_t* MZ = (const bf16_t*)(p.ws + WS_MZ); bf16_t* O = (bf16_t*)(p.ws + WS_H);
    for (int it = blockIdx.x; it < 512; it += gridDim.x) {
        const int xcd = it & 7, r = it >> 3, bh = xcd * 4 + (r >> 4), qb = r & 15, b = bh >> 2, h = bh & 3;
        __syncthreads();
        const size_t tok0 = (size_t)b * 4096 + qb * 256;
        att::attn_body(Q + ((size_t)bh * 4096 + qb * 256) * 192, K + (size_t)bh * 4096 * 192, V + (size_t)bh * 4096 * 128,
                       MZ + tok0 * 512 + h * 128, O + tok0 * 1024 + 512 + h * 128, 4096, (char*)lds_generic);
    }
    __syncthreads();
}

constexpr int MX_WL = 0, MX_VT = 34816, MX_ST = 104448, MX_ROW = 272;
__device__ __forceinline__ void mix_phase(const Params& p, int oi, LAS unsigned char* lds, bool dry = false) {
    const int tid = tid_fresh(), w = __builtin_amdgcn_readfirstlane(tid >> 6), lane = tid & 63, tq = lane & 15, quad = lane >> 4;
    const bf16_t* Wsb = (const bf16_t*)(p.ws + WS_WS); const bf16_t* V2 = (const bf16_t*)(p.ws + WS_V2); bf16_t* UZ = (bf16_t*)(p.ws + WS_UZ);
    const f32x2* PART = (const f32x2*)(p.ws + WS_PART);
    LAS f32x2* STAT = (LAS f32x2*)(lds + MX_ST);
    const int per = 2048 / gridDim.x; int last_g = -1;
    for (int i = 0; i < per; ++i) {
        const int it = blockIdx.x * per + i, g = it >> 8, bn = it & 255, b = bn >> 5, n = bn & 31; const size_t tok0 = (size_t)b * 4096 + n * 128;
        __syncthreads();
        if (g != last_g) { last_g = g;
#pragma unroll
            for (int q = 0; q < 4; ++q) { const int pc = tid + 512 * q, row = pc >> 4, cgp = pc & 15;
                *(LAS u32x4*)(lds + MX_WL + row * MX_ROW + cgp * 16) = *(const u32x4*)(Wsb + ((size_t)(oi * 8 + g) * 128 + row) * 128 + cgp * 8); } }
        {
            const int tl = tid >> 2, part = tid & 3; const f32x4* pp = (const f32x4*)(PART + (tok0 + tl) * 32 + part * 8);
            const f32x4 p0 = pp[0], p1 = pp[1], p2 = pp[2], p3 = pp[3];
            float s = (p0[0] + p0[2]) + (p1[0] + p1[2]) + (p2[0] + p2[2]) + (p3[0] + p3[2]), ss = (p0[1] + p0[3]) + (p1[1] + p1[3]) + (p2[1] + p2[3]) + (p3[1] + p3[3]);
            s += __shfl_xor(s, 1); ss += __shfl_xor(ss, 1); s += __shfl_xor(s, 2); ss += __shfl_xor(ss, 2);
            const float mu = s * (1.0f / 2048.0f), var = ss * (1.0f / 2048.0f) - mu * mu; if (part == 0) STAT[tl] = (f32x2){mu, rsqrtf(var + EPS)}; }
        u32x4 uzw[8];
#pragma unroll
        for (int nb = 0; nb < 8; ++nb) uzw[nb] = *(const u32x4*)(UZ + (tok0 + 16 * nb + tq) * 2048 + g * 256 + 32 * w + 8 * quad);
        __syncthreads();
        {
            const int c0 = 8 * ((lane >> 4) + 4 * w);
            const f32x4 gl0 = *(const f32x4*)(p.in[I_SGG] + oi * 2048 + g * 256 + c0), gl1 = *(const f32x4*)(p.in[I_SGG] + oi * 2048 + g * 256 + c0 + 4);
            const f32x4 bl0 = *(const f32x4*)(p.in[I_SGB] + oi * 2048 + g * 256 + c0), bl1 = *(const f32x4*)(p.in[I_SGB] + oi * 2048 + g * 256 + c0 + 4);
#pragma unroll
            for (int q = 0; q < 4; ++q) { const int rp = (lane & 15) + 16 * q; const size_t tokA = tok0 + 2 * rp; const f32x2 sa = STAT[2 * rp], sb = STAT[2 * rp + 1];
                const u32x4 ra = *(const u32x4*)(V2 + tokA * 2048 + g * 256 + c0), rb = *(const u32x4*)(V2 + (tokA + 1) * 2048 + g * 256 + c0);
                float fa[8], fb[8]; unpack8(ra, fa); unpack8(rb, fb);
#pragma unroll
                for (int e = 0; e < 8; ++e) { const float gg = e < 4 ? gl0[e & 3] : gl1[e & 3], bb = e < 4 ? bl0[e & 3] : bl1[e & 3];
                    const float va = (fa[e] - sa.x) * sa.y * gg + bb, vb = (fb[e] - sb.x) * sb.y * gg + bb;
                    *(LAS unsigned*)(lds + MX_VT + (c0 + e) * MX_ROW + 4 * rp) = cvtpk(va, vb); } }
        }
        __syncthreads();
        bf16x8 A[2][4];
#pragma unroll
        for (int mb = 0; mb < 2; ++mb)
#pragma unroll
            for (int ks = 0; ks < 4; ++ks) { const int c = 32 * w + 8 * (tq >> 2) + 4 * mb + (tq & 3);
                A[mb][ks] = *(const LAS bf16x8*)(lds + MX_VT + c * MX_ROW + (32 * ks + 8 * quad) * 2); }
#pragma unroll
        for (int nb = 0; nb < 8; ++nb) {
            f32x4 a0 = (f32x4){0.f, 0.f, 0.f, 0.f}, a1 = (f32x4){0.f, 0.f, 0.f, 0.f};
#pragma unroll
            for (int ks = 0; ks < 4; ++ks) { const bf16x8 bw = *(const LAS bf16x8*)(lds + MX_WL + (16 * nb + tq) * MX_ROW + (32 * ks + 8 * quad) * 2);
                a0 = MFMA16(A[0][ks], bw, a0); a1 = MFMA16(A[1][ks], bw, a1); }
            const int ti = 16 * nb + tq; const size_t tok = tok0 + ti; const float bias = p.in[I_SGBS][(oi * 8 + g) * 128 + ti];
            bf16_t* up = UZ + tok * 2048 + g * 256 + 32 * w + 8 * quad;
            float f[8]; unpack8(uzw[nb], f);
#pragma unroll
            for (int j = 0; j < 4; ++j) { f[j] *= (a0[j] + bias); f[4 + j] *= (a1[j] + bias); }
            if (!dry || f[0] == 1.2345e33f) *(u32x4*)up = pack8(f);
        }
    }
    __syncthreads();
}

constexpr size_t WS_BAR = (WS_TOTAL + 255) / 256 * 256;
constexpr size_t WS_NEED = WS_BAR + (size_t)XCD_BAR_WORDS * 4;
__device__ __forceinline__ int opq(int x) { asm volatile("" : "+s"(x)); return x; }
__global__ void __launch_bounds__(512, 2) mega(Params p) {
    extern __shared__ __attribute__((aligned(16))) unsigned char lds_[];
    LAS unsigned char* lds = (LAS unsigned char*)lds_;
    cg::grid_group grid = cg::this_grid();
    const int lo = p.ph_lo, hi = p.ph_hi;
    unsigned char* ws = p.ws;
#ifdef ONLY_PH
#define IN(k) ((((k) - 2) % 10 + 2 == ONLY_PH || (k) == ONLY_PH) && lo <= (k) && (k) < hi)
#else
#define IN(k) (lo <= (k) && (k) < hi)
#endif
    volatile LAS unsigned* xb_st = (volatile LAS unsigned*)(lds + LDS_BYTES - 16);
    if (threadIdx.x < 4) xb_st[threadIdx.x] = 0u;
    __syncthreads();
    XcdBarrier xbar = xcd_barrier_post((unsigned*)(ws + WS_BAR), xb_st);
    if (p.ph_lo < 0) grid.sync();
#ifdef DBL_BAR
#define SEAM(k) do { if (IN(k) && IN((k) + 1)) { xcd_barrier(xbar); xcd_barrier(xbar); } } while (0)
#else
#define SEAM(k) do { if (IN(k) && IN((k) + 1)) xcd_barrier(xbar); } while (0)
#endif
#if defined(DBG_MAXP) || defined(DBG_KEXPR)
    if (blockIdx.x == 0 && threadIdx.x == 0) ((int*)(ws + WS_PART))[41] = 0;
#endif
#ifndef REP
#define REP 0
#endif
#define REPN(bit) (((REP) >> (bit)) & 1 ? 2 : 1)
    if (IN(0)) for (int rep = 0; rep < REPN(8); ++rep) p0_phase(p, lds);
    SEAM(0);
    if (IN(1)) for (int rep = 0; rep < (((REP) >> 10) & 1 ? 5 : 1); ++rep) norm_phase(p, -1, 0, nullptr, p.in[I_X]);
    SEAM(1);
    if (((REP) >> 11) & 1) for (int rep = 0; rep < 20; ++rep) grid.sync();
    for (int lp = 0; lp < 2; ++lp) {
        const int base = 2 + 10 * lp, le = 2 * lp, lod = 2 * lp + 1;
        if (IN(base + 0)) for (int rep = 0; rep < REPN(0); ++rep) {
            pg8::Gemm g{(const bf16_t*)(ws + WS_H), (const bf16_t*)(ws + WS_WINE) + (size_t)lp * 2560 * 1024, T_, opq(2560), opq(1024)};
            pg8::StaticOrder S; S.init(T_, 2560, (int)gridDim.x, (int)blockIdx.x); EpiEvenIn E{ws};
            pg8::gemm_phase<EpiEvenIn, pg8::StaticOrder, false>(lds, g, S, E, nullptr);
        }
        SEAM(base + 0);
        if (IN(base + 1)) { for (int rep = 0; rep < REPN(9); ++rep) rs_rope_phase(p); for (int rep = 0; rep < REPN(1); ++rep) gla_a_phase(p, lp, lds); }
        SEAM(base + 1);
        if (IN(base + 2)) {
          for (int rep = 0; rep < REPN(2); ++rep) {
            { pg8::Gemm g{(const bf16_t*)(ws + WS_CQ), (const bf16_t*)(ws + WS_WUP) + (size_t)lp * WUP_E, T_, opq(768), opq(256)};
              pg8::StaticOrder S; S.init(T_, 768, (int)gridDim.x, (int)blockIdx.x); EpiUp<false> E{ws};
              pg8::gemm_phase<EpiUp<false>, pg8::StaticOrder, false>(lds, g, S, E, nullptr); }
            { pg8::Gemm g{(const bf16_t*)(ws + WS_CKV), (const bf16_t*)(ws + WS_WUP) + (size_t)lp * WUP_E + WUP_KV, T_, opq(1024), opq(128)};
              pg8::StaticOrder S; S.init(T_, 1024, (int)gridDim.x, (int)blockIdx.x); EpiUp<true> E{ws};
              pg8::gemm_phase<EpiUp<true>, pg8::StaticOrder, false>(lds, g, S, E, nullptr); } }
            if (((REP) >> 12) & 1) gla_b_phase(p, true);
            gla_b_phase(p);
        }
        SEAM(base + 2);
        if (IN(base + 3)) {
#ifdef ATT_VAR
            attn_phase<ATT_VAR>(p, lds_);
#endif
            for (int rep = 0; rep < REPN(3); ++rep) attn_phase(p, lds_); for (int rep = 0; rep < REPN(4); ++rep) gla_c_phase(p, lp, lds); }
        SEAM(base + 3);
        if (IN(base + 4)) for (int rep = 0; rep < REPN(5); ++rep) {
            pg8::Gemm g{(const bf16_t*)(ws + WS_H), (const bf16_t*)(ws + WS_WOUTE) + (size_t)lp * 1024 * 1024, T_, opq(1024), opq(1024)};
            pg8::StaticOrder S; S.init(T_, 1024, (int)gridDim.x, (int)blockIdx.x); EpiY E{(bf16_t*)(ws + WS_YE)};
            pg8::gemm_phase<EpiY, pg8::StaticOrder, false>(lds, g, S, E, nullptr);
        }
        SEAM(base + 4);
        if (IN(base + 5)) norm_phase(p, le, le + 1, (const bf16_t*)(ws + WS_YE), le == 0 ? p.in[I_X] : p.out);
        SEAM(base + 5);
        if (IN(base + 6)) for (int rep = 0; rep < REPN(6); ++rep) {
            pg8::Gemm g{(const bf16_t*)(ws + WS_H), (const bf16_t*)(ws + WS_WINO) + (size_t)lp * 6144 * 1024, T_, opq(6144), opq(1024)};
            pg8::StaticOrder S; S.init(T_, 6144, (int)gridDim.x, (int)blockIdx.x); EpiOddIn E{ws};
            pg8::gemm_phase<EpiOddIn, pg8::StaticOrder, false>(lds, g, S, E, nullptr);
        }
        SEAM(base + 6);
        if (IN(base + 7)) { if (((REP) >> 13) & 1) mix_phase(p, lp, lds, true); mix_phase(p, lp, lds); }
        SEAM(base + 7);
        if (IN(base + 8)) for (int rep = 0; rep < REPN(7); ++rep) {
            pg8::Gemm g{(const bf16_t*)(ws + WS_UZ), (const bf16_t*)(ws + WS_WOUTO) + (size_t)lp * 1024 * 2048, T_, opq(1024), opq(2048)};
            pg8::StaticOrder S; S.init(T_, 1024, (int)gridDim.x, (int)blockIdx.x); EpiY E{(bf16_t*)(ws + WS_YO)};
            pg8::gemm_phase<EpiY, pg8::StaticOrder, false>(lds, g, S, E, nullptr);
        }
        SEAM(base + 8);
        if (IN(base + 9)) norm_phase(p, lod, lod < 3 ? lod + 1 : -1, (const bf16_t*)(ws + WS_YO), p.out);
        SEAM(base + 9);
    }
#ifdef DEBUG_HI
    {
        int* DIAG = (int*)(ws + WS_PART);
        const int tid = tid_fresh(); const size_t gtid = (size_t)blockIdx.x * 512 + tid, gsz = (size_t)gridDim.x * 512;
        grid.sync();
        if (blockIdx.x == 0 && tid < 64 && tid != 41) DIAG[tid] = 0;
        for (size_t i = gtid; i < (size_t)T_ * 1024; i += gsz) p.out[i] = DBG_KEEP_OUT ? p.out[i] : 0.f;
        grid.sync();
#define DBG_CHECK(bi, off_, n_, isf32) { int bad = 0; \
            if (isf32) { const float* q = (const float*)(ws + (off_)); for (size_t i = gtid; i < (size_t)(n_); i += gsz) { const float v = q[i]; if (!(fabsf(v) < DBG_LIM)) bad = 1; } } \
            else { const bf16_t* q = (const bf16_t*)(ws + (off_)); for (size_t i = gtid; i < (size_t)(n_); i += gsz) { const float v = bf2f(q[i]); if (!(fabsf(v) < DBG_LIM)) bad = 1; } } \
            if (bad) atomicAdd(&DIAG[bi], 1); }
        DEBUG_BUFS
#ifdef DBG_FRAC
        { int cnt = 0; const bf16_t* q = (const bf16_t*)(ws + DBG_FRAC_OFF); for (size_t i = gtid; i < (size_t)(DBG_FRAC_N); i += gsz) { const float v = bf2f(q[i]); if (!(fabsf(v) < DBG_LIM)) ++cnt; } if (cnt) atomicAdd(&DIAG[40], cnt); }
#endif
        const int nb = DBG_NB;
        grid.sync();
        if (blockIdx.x == 0 && tid == 0) { int first = -1; for (int bi = 0; bi < nb; ++bi) if (first < 0 && __hip_atomic_load(&DIAG[bi], __ATOMIC_RELAXED, __HIP_MEMORY_SCOPE_AGENT) != 0) first = bi; p.out[0] = 1000.f * (float)(first + 1);
#if defined(DBG_MAXP) || defined(DBG_KEXPR)
            p.out[0] = 100.f * __int_as_float(__hip_atomic_load(&DIAG[41], __ATOMIC_RELAXED, __HIP_MEMORY_SCOPE_AGENT));
#endif
#ifdef DBG_FRAC
            p.out[0] = 100.f * (float)__hip_atomic_load(&DIAG[40], __ATOMIC_RELAXED, __HIP_MEMORY_SCOPE_AGENT);
#endif
        }
    }
#endif
}

extern "C" void kernel_launch(void* const* d_in, const int* in_sizes, int n_in, void* d_out, int out_size, void* d_ws, size_t ws_size, hipStream_t stream) {
    static int grid_blocks = 0;
    if (!grid_blocks) {
        if (n_in != 24 || out_size != T_ * 1024 || ws_size < WS_NEED) { fprintf(stderr, "kernel_launch: unexpected shapes (n_in %d out %d ws %zu need %zu)\n", n_in, out_size, ws_size, (size_t)WS_NEED); return; }
        if (hipFuncSetAttribute((const void*)mega, hipFuncAttributeMaxDynamicSharedMemorySize, (int)LDS_BYTES) != hipSuccess) { fprintf(stderr, "hipFuncSetAttribute failed\n"); return; }
        int dev = 0, cus = 0, per_cu = 0;
        (void)hipGetDevice(&dev);
        (void)hipDeviceGetAttribute(&cus, hipDeviceAttributeMultiprocessorCount, dev);
        (void)hipOccupancyMaxActiveBlocksPerMultiprocessor(&per_cu, mega, 512, LDS_BYTES);
        if (per_cu < 1 || cus != 256) { fprintf(stderr, "kernel_launch: occupancy %d cus %d\n", per_cu, cus); }
        grid_blocks = 256;
    }
    Params p{};
    for (int i = 0; i < 24; ++i) p.in[i] = (const float*)d_in[i];
    p.out = (float*)d_out; p.ws = (unsigned char*)d_ws;
#if N_LAUNCH_MODE == 0
    (void)hipMemsetAsync((unsigned char*)d_ws + WS_BAR, 0, (size_t)XCD_BAR_WORDS * 4, stream);
#ifdef DEBUG_HI
    p.ph_lo = 0; p.ph_hi = DEBUG_HI;
#else
    p.ph_lo = 0; p.ph_hi = NPHASE;
#endif
    void* args[] = {&p};
    hipError_t e = hipLaunchCooperativeKernel((void*)mega, dim3(grid_blocks), dim3(512), args, LDS_BYTES, stream);
    if (e != hipSuccess) fprintf(stderr, "cooperative launch failed: %s (grid %d)\n", hipGetErrorString(e), grid_blocks);
#else
    for (int k = 0; k < NPHASE; ++k) { p.ph_lo = k; p.ph_hi = k + 1; hipLaunchKernelGGL(mega, dim3(grid_blocks), dim3(512), LDS_BYTES, stream, p); }
#endif
}
```

```cpp
#ifndef ATT_SDEPTH
#define ATT_SDEPTH 1
#endif
#ifndef ATT_NQR
#define ATT_NQR 8
#endif
#include <hip/hip_runtime.h>
namespace pg8 {
#define PG8_LAS __attribute__((address_space(3)))
typedef unsigned short bf16_t;
typedef short bf16x8 __attribute__((ext_vector_type(8)));
typedef float f32x4 __attribute__((ext_vector_type(4)));
typedef unsigned u32x4 __attribute__((ext_vector_type(4)));
constexpr int BM = 256, BK = 64, HALF = 128, HTB = HALF * BK * 2  , STAGE_BYTES = 8 * HTB, NXCD = 8, WGM = 8;

__host__ __device__ __forceinline__ int lds_byte(int r, int c) { const int st = (r >> 4) * 2 + (c >> 5), rr = r & 15, cc = c & 31, ob = rr * 64 + cc * 2; return st * 1024 + (ob ^ (((ob >> 9) & 1) << 5)); }
__host__ __device__ __forceinline__ void stage_rc(int b, int& R, int& C) { const int st = b / 1024, sb = b % 1024, swz = sb ^ (((sb >> 9) & 1) << 5); R = (st >> 1) * 16 + swz / 64; C = (st & 1) * 32 + (swz % 64) / 2; }
__host__ __device__ __forceinline__ int perm32(int rho) { const int n = rho >> 4, i = rho & 15; return 8 * (i >> 2) + 4 * n + (i & 3); }

struct Unit { int pm, pn; };
struct Gemm { const bf16_t* A; const bf16_t* Bt; int M, N, K; };

struct StaticOrder {
    int nM, nN, nwg, G, c;
    __host__ __device__ void init(int M, int N, int G_, int c_) { nM = M / BM; nN = N / BM; nwg = nM * nN; G = G_; c = c_; }
    __host__ __device__ bool next(int i, Unit& u) const {
        const long L = (long)i * G + c; if (L >= nwg) return false;
        int wgid = (int)L; { const int q = nwg / NXCD, r = nwg % NXCD, xcd = wgid % NXCD, off = wgid / NXCD; wgid = (xcd < r ? xcd * (q + 1) : r * (q + 1) + (xcd - r) * q) + off; }
        const int nig = WGM * nN, gid = wgid / nig, fm = gid * WGM, gsz = (nM - fm) < WGM ? (nM - fm) : WGM;
        u.pm = fm + ((wgid % nig) % gsz); u.pn = (wgid % nig) / gsz; return true;
    }
    __device__ __forceinline__ void a_ready(const Unit&) const {}
    __device__ __forceinline__ void done(const Unit&) const {}
};
__device__ __forceinline__ unsigned cvt_pk_bf16(float lo, float hi) { unsigned r; asm volatile("v_cvt_pk_bf16_f32 %0, %1, %2" : "=v"(r) : "v"(lo), "v"(hi)); return r; }
typedef float f32x2 __attribute__((ext_vector_type(2)));
__device__ __forceinline__ f32x2 gelu_pk(f32x2 v) {
    const f32x2 av = __builtin_elementwise_abs(v), d = av * 0.2316418882f + 1.0f;
    f32x2 t; t.x = __builtin_amdgcn_rcpf(d.x); t.y = __builtin_amdgcn_rcpf(d.y);
    f32x2 q = t * 0.5307027145f + (-0.7265760135f); q = q * t + 0.7107068705f; q = q * t + (-0.142248368f); q = q * t + 0.127414796f; q = q * t;
    const f32x2 s = (v * v) * (-0.72134752044f);
    f32x2 e; e.x = __builtin_amdgcn_exp2f(s.x); e.y = __builtin_amdgcn_exp2f(s.y);
    const f32x2 m = v * (q * e), r = v - m;
    f32x2 o; o.x = v.x < 0.f ? m.x : r.x; o.y = v.y < 0.f ? m.y : r.y; return o;
}

struct EpiF32 {
    static constexpr bool PERM = false, AFTER_DRAIN = false;
    float* C; int ldc; const float* bias;
    __device__ __forceinline__ void operator()(const f32x4 (&acc)[2][2][4][2], const Unit& u, int wr, int wc, int fr, int fq) const {
        const int row0 = u.pm * BM + wr * 64 + fr, col0 = u.pn * BM + wc * 32 + 4 * fq;
        f32x4 bv[2][2];
#pragma unroll
        for (int bj = 0; bj < 2; ++bj)
#pragma unroll
            for (int n = 0; n < 2; ++n) bv[bj][n] = bias ? *(const f32x4*)(bias + col0 + bj * HALF + n * 16) : (f32x4){0.f, 0.f, 0.f, 0.f};
#pragma unroll
        for (int ai = 0; ai < 2; ++ai)
#pragma unroll
            for (int m = 0; m < 4; ++m) { float* rowp = C + (size_t)(row0 + ai * HALF + m * 16) * ldc + col0;
#pragma unroll
                for (int bj = 0; bj < 2; ++bj)
#pragma unroll
                    for (int n = 0; n < 2; ++n) *(f32x4*)(rowp + bj * HALF + n * 16) = acc[ai][bj][m][n] + bv[bj][n]; }
    }
};
template <class Epi, class Sched, bool STAMP = false>
__device__ __forceinline__ void gemm_phase(PG8_LAS unsigned char* lds, const Gemm g, const Sched& S, const Epi& E, unsigned long long* stamps) {
    int tid = threadIdx.x; asm volatile("" : "+v"(tid));
    const int wid = __builtin_amdgcn_readfirstlane(tid >> 6), lane = tid & 63, wr = wid >> 2, wc = wid & 3, fr = lane & 15, fq = lane >> 4;
    const int K = g.K, nt = K / BK;
    int ts_lo = 0, ts_hi = 0, nts = 0; const unsigned long long rt_entry = STAMP ? (unsigned long long)wall_clock64() : 0ull;
#define PG8_STAMP() do { if (STAMP && wid == 0 && nts < 64) { const unsigned long long _c = (unsigned long long)clock64(); \
        ts_lo = (lane == nts) ? (int)(unsigned)_c : ts_lo; ts_hi = (lane == nts) ? (int)(unsigned)(_c >> 32) : ts_hi; ++nts; } } while (0)
    PG8_STAMP();
    unsigned voffA[2], voffB[2];
#pragma unroll
    for (int i = 0; i < 2; ++i) { int R, C; stage_rc(tid * 16 + i * 8192, R, C); const int Rb = Epi::PERM ? ((R & ~31) + perm32(R & 31)) : R;
        voffA[i] = (unsigned)(R * K + C) * 2u; voffB[i] = (unsigned)(Rb * K + C) * 2u; }
    const size_t kstep = (size_t)(BK * 2);
    const size_t hstep = (size_t)HALF * K * 2;
    const size_t tstep = 2 * hstep;
    const unsigned ldsw = (unsigned)wid * 1024u;
    const int aoff = lds_byte(wr * 64 + fr, fq * 8), boff = lds_byte(wc * 32 + fr, fq * 8);
#define PG8_SA(b, h) (((b) * 2 + (h)) * HTB)
#define PG8_SB(b, h) ((4 + (b) * 2 + (h)) * HTB)
#define PG8_STAGE(bufoff, gbase, voff) do { _Pragma("unroll") for (int _i = 0; _i < 2; ++_i) \
        __builtin_amdgcn_global_load_lds((const unsigned*)((const char*)(gbase) + (voff)[_i]), (PG8_LAS unsigned*)(lds + (bufoff) + ldsw + _i * 8192), 16, 0, 0); } while (0)
#define PG8_LDA(dst, b, h) do { _Pragma("unroll") for (int m = 0; m < 4; ++m) _Pragma("unroll") for (int k = 0; k < 2; ++k) dst[m][k] = *(const PG8_LAS bf16x8*)(lds + PG8_SA(b, h) + aoff + m * 2048 + k * 1024); } while (0)
#define PG8_LDB(dst, b, h) do { _Pragma("unroll") for (int n = 0; n < 2; ++n) _Pragma("unroll") for (int k = 0; k < 2; ++k) dst[n][k] = *(const PG8_LAS bf16x8*)(lds + PG8_SB(b, h) + boff + n * 2048 + k * 1024); } while (0)
#define PG8_MMA(ai, bj, At, Bt) do { __builtin_amdgcn_s_setprio(1); _Pragma("unroll") for (int m = 0; m < 4; ++m) _Pragma("unroll") for (int n = 0; n < 2; ++n) _Pragma("unroll") for (int k = 0; k < 2; ++k) \
        acc[ai][bj][m][n] = __builtin_amdgcn_mfma_f32_16x16x32_bf16(Bt[n][k], At[m][k], acc[ai][bj][m][n], 0, 0, 0); __builtin_amdgcn_s_setprio(0); } while (0)
#define PG8_WAIT_V(n) asm volatile("s_waitcnt vmcnt(" #n ")" ::: "memory")
#define PG8_WAIT_L(n) asm volatile("s_waitcnt lgkmcnt(" #n ")" ::: "memory")
#define PG8_BAR __builtin_amdgcn_s_barrier()
#define PG8_SCHED __builtin_amdgcn_sched_barrier(0)
    Unit cur, nxt; int ui = 0;
    if (!S.next(0, cur)) return;
    f32x4 acc[2][2][4][2];
#pragma unroll
    for (int a = 0; a < 2; ++a)
#pragma unroll
        for (int b = 0; b < 2; ++b)
#pragma unroll
            for (int m = 0; m < 4; ++m)
#pragma unroll
                for (int n = 0; n < 2; ++n) acc[a][b][m][n] = (f32x4){0.f, 0.f, 0.f, 0.f};
    bf16x8 At[4][2], B0[2][2], B1[2][2];
    const char* cA = (const char*)g.A + (size_t)cur.pm * tstep; const char* cB = (const char*)g.Bt + (size_t)cur.pn * tstep;
    S.a_ready(cur);
    PG8_STAGE(PG8_SB(0, 0), cB, voffB); PG8_STAGE(PG8_SA(0, 0), cA, voffA); PG8_STAGE(PG8_SB(0, 1), cB + hstep, voffB); PG8_STAGE(PG8_SA(0, 1), cA + hstep, voffA);
    if (wr == 1) PG8_BAR;
    PG8_WAIT_V(4); PG8_BAR;
    PG8_STAGE(PG8_SB(1, 0), cB + kstep, voffB); PG8_STAGE(PG8_SA(1, 0), cA + kstep, voffA); PG8_STAGE(PG8_SB(1, 1), cB + hstep + kstep, voffB);
    PG8_WAIT_V(6); PG8_BAR;
    PG8_STAMP();
    for (;;) {
        const bool has_next = S.next(ui + 1, nxt);
        const char* nA = has_next ? (const char*)g.A + (size_t)nxt.pm * tstep : cA; const char* nB = has_next ? (const char*)g.Bt + (size_t)nxt.pn * tstep : cB;
        for (int t = 0; t < nt; t += 2) {
            const bool last = (t == nt - 2);
            const char* a1 = cA + (size_t)(t + 1) * kstep;
            const char* a2 = last ? nA : cA + (size_t)(t + 2) * kstep; const char* b2 = last ? nB : cB + (size_t)(t + 2) * kstep;
            const char* a3 = a2 + kstep; const char* b3 = b2 + kstep;
            if (last && has_next) S.a_ready(nxt);
            PG8_LDB(B0, 0, 0); PG8_SCHED; PG8_LDA(At, 0, 0); PG8_STAGE(PG8_SA(1, 1), a1 + hstep, voffA);
            PG8_WAIT_L(8); PG8_BAR; PG8_WAIT_L(0); PG8_MMA(0, 0, At, B0); PG8_BAR; PG8_SCHED;
            PG8_LDB(B1, 0, 1); PG8_STAGE(PG8_SB(0, 0), b2, voffB);
            PG8_BAR; PG8_WAIT_L(0); PG8_MMA(0, 1, At, B1); PG8_BAR;
            PG8_LDA(At, 0, 1); PG8_STAGE(PG8_SA(0, 0), a2, voffA);
            PG8_BAR; PG8_WAIT_L(0); PG8_MMA(1, 0, At, B0); PG8_BAR; PG8_SCHED;
            PG8_STAGE(PG8_SB(0, 1), b2 + hstep, voffB);
            PG8_WAIT_V(6); PG8_BAR; PG8_MMA(1, 1, At, B1); PG8_BAR;
            PG8_LDB(B0, 1, 0); PG8_SCHED; PG8_LDA(At, 1, 0); PG8_STAGE(PG8_SA(0, 1), a2 + hstep, voffA);
            PG8_WAIT_L(8); PG8_BAR; PG8_WAIT_L(0); PG8_MMA(0, 0, At, B0); PG8_BAR; PG8_SCHED;
            PG8_LDB(B1, 1, 1); PG8_STAGE(PG8_SB(1, 0), b3, voffB);
            PG8_BAR; PG8_WAIT_L(0); PG8_MMA(0, 1, At, B1); PG8_BAR;
            PG8_LDA(At, 1, 1); PG8_STAGE(PG8_SA(1, 0), a3, voffA);
            PG8_BAR; PG8_WAIT_L(0); PG8_MMA(1, 0, At, B0); PG8_BAR; PG8_SCHED;
            PG8_STAGE(PG8_SB(1, 1), b3 + hstep, voffB);
            PG8_WAIT_V(6); PG8_BAR; PG8_MMA(1, 1, At, B1); PG8_BAR;
        }
        PG8_STAMP();
        if constexpr (!Epi::AFTER_DRAIN) { E(acc, cur, wr, wc, fr, fq); S.done(cur); }
        PG8_STAMP();
        if (!has_next) break;
#pragma unroll
        for (int a = 0; a < 2; ++a)
#pragma unroll
            for (int b = 0; b < 2; ++b)
#pragma unroll
                for (int m = 0; m < 4; ++m)
#pragma unroll
                    for (int n = 0; n < 2; ++n) acc[a][b][m][n] = (f32x4){0.f, 0.f, 0.f, 0.f};
        cur = nxt; cA = nA; cB = nB; ++ui;
    }
    PG8_WAIT_V(0);
    if (wr == 0) PG8_BAR;
    PG8_BAR;
    if constexpr (Epi::AFTER_DRAIN) { E.fused(acc, cur, wr, wc, fr, fq, lds, wid, lane); S.done(cur); }
    PG8_STAMP();
    if (STAMP && wid == 0) { stamps[lane] = lane < nts ? (((unsigned long long)(unsigned)ts_hi << 32) | (unsigned)ts_lo) : 0ull;
        if (lane == 62) stamps[62] = rt_entry; if (lane == 63) stamps[63] = (unsigned long long)wall_clock64(); }
#undef PG8_STAMP
#undef PG8_SA
#undef PG8_SB
#undef PG8_STAGE
#undef PG8_LDA
#undef PG8_LDB
#undef PG8_MMA
#undef PG8_WAIT_V
#undef PG8_WAIT_L
#undef PG8_BAR
#undef PG8_SCHED
}
}


#include <hip/hip_cooperative_groups.h>
#include <cstdio>
namespace cg = cooperative_groups;
#define LAS __attribute__((address_space(3)))
typedef unsigned short bf16_t;
typedef short bf16x8 __attribute__((ext_vector_type(8)));
typedef short s16x4 __attribute__((ext_vector_type(4)));
typedef float f32x4 __attribute__((ext_vector_type(4)));
typedef float f32x2 __attribute__((ext_vector_type(2)));
typedef float f32x16 __attribute__((ext_vector_type(16)));
typedef unsigned u32x4 __attribute__((ext_vector_type(4)));
typedef unsigned u32x2 __attribute__((ext_vector_type(2)));

#ifndef N_LAUNCH_MODE
#define N_LAUNCH_MODE 0
#endif

constexpr int T_ = 32768, DM = 1024, NBAT = 8, SEQ = 4096;
constexpr float EPS = 1e-6f;
constexpr int NPHASE = 22;
constexpr size_t LDS_BYTES = 163840;

constexpr size_t al256(size_t x) { return (x + 255) / 256 * 256; }
constexpr size_t WS_WINE  = 0;
constexpr size_t WS_WUP   = WS_WINE  + al256((size_t)2 * 2560 * 1024 * 2);
constexpr size_t WS_WOUTE = WS_WUP   + al256((size_t)2 * 1792 * 384 * 2);
constexpr size_t WS_WINO  = WS_WOUTE + al256((size_t)2 * 1024 * 1024 * 2);
constexpr size_t WS_WOUTO = WS_WINO  + al256((size_t)2 * 6144 * 1024 * 2);
constexpr size_t WS_WS    = WS_WOUTO + al256((size_t)2 * 1024 * 2048 * 2);
constexpr size_t WS_MOD   = WS_WS    + al256((size_t)2 * 8 * 128 * 128 * 2);
constexpr size_t WS_ROPE  = WS_MOD   + al256((size_t)4 * 8 * 3072 * 4);
constexpr size_t WS_RS    = WS_ROPE  + al256((size_t)T_ * 32 * 8);
constexpr size_t WS_EV    = WS_RS    + al256((size_t)T_ * 2 * 4);
constexpr size_t WS_PART  = WS_EV    + al256((size_t)4096 * 64 * 4);
constexpr size_t WS_H     = WS_PART  + al256((size_t)T_ * 32 * 8);
constexpr size_t WS_R2    = WS_H     + al256((size_t)T_ * 1024 * 2);
constexpr size_t WS_GQ    = WS_R2;
constexpr size_t WS_GK    = WS_GQ   + (size_t)T_ * 256 * 2;
constexpr size_t WS_GV    = WS_GK   + (size_t)T_ * 256 * 2;
constexpr size_t WS_GZ    = WS_GV   + (size_t)T_ * 512 * 2;
constexpr size_t WS_MZ    = WS_GZ   + (size_t)T_ * 512 * 2;
constexpr size_t WS_CQKV  = WS_MZ   + (size_t)T_ * 512 * 2;
constexpr size_t WS_KR    = WS_CQKV + (size_t)T_ * 384 * 2;
constexpr size_t WS_GA    = WS_KR   + (size_t)T_ * 64 * 2;
constexpr size_t WS_Q     = WS_GA   + (size_t)T_ * 32 * 4;
constexpr size_t WS_K     = WS_Q    + (size_t)T_ * 4 * 192 * 2;
constexpr size_t WS_V     = WS_K    + (size_t)T_ * 4 * 192 * 2;
constexpr size_t WS_ST    = WS_V    + (size_t)T_ * 4 * 128 * 2;
constexpr size_t WS_EVEN_END = WS_ST + (size_t)4096 * 8192 * 2;
constexpr size_t WS_YE    = WS_Q;
constexpr size_t WS_UZ    = WS_R2;
constexpr size_t WS_V2    = WS_UZ   + (size_t)T_ * 2048 * 2;
constexpr size_t WS_YO    = WS_V2;
constexpr size_t WS_ODD_END = WS_V2 + (size_t)T_ * 2048 * 2;
constexpr size_t WS_TOTAL = WS_EVEN_END > WS_ODD_END ? WS_EVEN_END : WS_ODD_END;
static_assert(WS_Q + (size_t)T_ * 1024 * 4 == WS_ST, "Y_even must cover exactly Q|K|V");

constexpr size_t WUP_E = 768 * 256 + 1024 * 128, WUP_KV = 768 * 256;
constexpr size_t WS_CQ = WS_CQKV, WS_CKV = WS_CQKV + (size_t)T_ * 256 * 2;
struct Params { const float* in[24]; float* out; unsigned char* ws; int ph_lo, ph_hi; };
enum { I_X = 0, I_C, I_POS, I_WMOD, I_BMOD, I_GPRE, I_GPOST, I_WINE, I_W2F, I_B2F, I_W2B, I_B2B, I_GNORM, I_GQ, I_WUQ, I_GKV, I_WUKV, I_WOUTE,
       I_WINO, I_SGG, I_SGB, I_SGW, I_SGBS, I_WOUTO };

typedef __bf16 bf16v2 __attribute__((ext_vector_type(2)));
__device__ __forceinline__ unsigned cvtpk(float lo, float hi) { const f32x2 v = {lo, hi}; return __builtin_bit_cast(unsigned, __builtin_convertvector(v, bf16v2)); }
__device__ __forceinline__ float bflo(unsigned w) { return __uint_as_float(w << 16); }
__device__ __forceinline__ float bfhi(unsigned w) { return __uint_as_float(w & 0xffff0000u); }
__device__ __forceinline__ float bf2f(unsigned short b) { return __uint_as_float(((unsigned)b) << 16); }
__device__ __forceinline__ int tid_fresh() { int t = threadIdx.x; asm volatile("" : "+v"(t)); return t; }
__device__ __forceinline__ float wave_sum(float v) {
#pragma unroll
    for (int o = 32; o >= 1; o >>= 1) v += __shfl_xor(v, o);
    return v; }
__device__ __forceinline__ float silu_f(float z) { return z * __builtin_amdgcn_rcpf(1.0f + __expf(-z)); }
__device__ __forceinline__ float logsig_f(float x) { return fminf(x, 0.f) - __logf(1.0f + __expf(-fabsf(x))); }
__device__ __forceinline__ void unpack8(const u32x4 w, float (&f)[8]) {
    f[0] = bflo(w.x); f[1] = bfhi(w.x); f[2] = bflo(w.y); f[3] = bfhi(w.y); f[4] = bflo(w.z); f[5] = bfhi(w.z); f[6] = bflo(w.w); f[7] = bfhi(w.w); }
__device__ __forceinline__ u32x4 pack8(const float (&f)[8]) { u32x4 w; w.x = cvtpk(f[0], f[1]); w.y = cvtpk(f[2], f[3]); w.z = cvtpk(f[4], f[5]); w.w = cvtpk(f[6], f[7]); return w; }
#define MFMA16(a, b, c) __builtin_amdgcn_mfma_f32_16x16x32_bf16((a), (b), (c), 0, 0, 0)

__device__ __forceinline__ int map_even_col(int n) {
    if (n < 1024) return n;
    if (n < 1536) return n - 1024 + 1056;
    if (n < 2048) return n - 1536 + 2016;
    if (n < 2304) return n - 2048 + 1568;
    if (n < 2432) return n - 2304 + 1824;
    if (n < 2496) return n - 2432 + 1952;
    if (n < 2528) return n - 2496 + 1024;
    return -1; }
__device__ __forceinline__ int map_q_col(int n) {
    const int hh = n / 192, j = n - hh * 192;
    if (j < 128) return n;
    const int jj = j - 128, g8 = jj >> 3, w = jj & 7;
    return hh * 192 + 128 + ((w < 4) ? (4 * g8 + w) : (32 + 4 * g8 + (w - 4))); }
__device__ __forceinline__ int map_odd_col(int n) {
    const int pn = n >> 8;
    if (pn < 16) { const int half = (n >> 7) & 1, idx = n & 127; return (half ? 4096 : 0) + 128 * pn + idx; }
    return 2048 + (n - 4096); }

template <int MAT> __device__ __forceinline__ float prep_val(const Params& p, int e, int n, int k) {
    if (MAT == 0) { const int sc = map_even_col(n); return sc < 0 ? 0.f : p.in[I_WINE][((size_t)e * 1024 + k) * 2528 + sc]; }
    if (MAT == 1) return p.in[I_GQ][e * 256 + k] * p.in[I_WUQ][((size_t)e * 256 + k) * 768 + map_q_col(n)];
    if (MAT == 5) return p.in[I_GKV][e * 128 + k] * p.in[I_WUKV][((size_t)e * 128 + k) * 1024 + n];
    if (MAT == 2) return p.in[I_WOUTE][((size_t)e * 1024 + k) * 1024 + n];
    if (MAT == 3) return p.in[I_WINO][((size_t)e * 1024 + k) * 6144 + map_odd_col(n)];
    return p.in[I_WOUTO][((size_t)e * 2048 + k) * 1024 + n];
}
template <int MAT> __device__ __forceinline__ f32x4 prep_val4(const Params& p, int e, int n, int k) {
    const f32x4 z = {0.f, 0.f, 0.f, 0.f};
    if (MAT == 0) { const int sc = map_even_col(n); return sc < 0 ? z : *(const f32x4*)(p.in[I_WINE] + ((size_t)e * 1024 + k) * 2528 + sc); }
    if (MAT == 1) return *(const f32x4*)(p.in[I_WUQ] + ((size_t)e * 256 + k) * 768 + map_q_col(n)) * p.in[I_GQ][e * 256 + k];
    if (MAT == 5) return *(const f32x4*)(p.in[I_WUKV] + ((size_t)e * 128 + k) * 1024 + n) * p.in[I_GKV][e * 128 + k];
    if (MAT == 2) return *(const f32x4*)(p.in[I_WOUTE] + ((size_t)e * 1024 + k) * 1024 + n);
    if (MAT == 3) return *(const f32x4*)(p.in[I_WINO] + ((size_t)e * 1024 + k) * 6144 + map_odd_col(n));
    return *(const f32x4*)(p.in[I_WOUTO] + ((size_t)e * 2048 + k) * 1024 + n);
}
template <int MAT> __device__ __forceinline__ void prep_tile(const Params& p, LAS float* tl, bf16_t* dst, int K, int e, int n0, int k0) {
    const int tid = tid_fresh(), n4 = (tid & 15) * 4, kk = tid >> 4;
#pragma unroll
    for (int r = 0; r < 2; ++r) { const int k = kk + 32 * r; const f32x4 v = prep_val4<MAT>(p, e, n0 + n4, k0 + k);
        tl[k * 65 + n4] = v[0]; tl[k * 65 + n4 + 1] = v[1]; tl[k * 65 + n4 + 2] = v[2]; tl[k * 65 + n4 + 3] = v[3]; }
    __syncthreads();
    const int nl2 = tid >> 3, kg = tid & 7; float v[8];
#pragma unroll
    for (int q = 0; q < 8; ++q) v[q] = tl[(8 * kg + q) * 65 + nl2];
    *(u32x4*)(dst + (size_t)(n0 + nl2) * K + k0 + 8 * kg) = pack8(v);
    __syncthreads();
}

__device__ __forceinline__ void p0_phase(const Params& p, LAS unsigned char* lds) {
    const int tid = tid_fresh();
    unsigned char* ws = p.ws;
    constexpr int N_MOD = 192, N_ROPE = 256, N_WS = 64;
    constexpr int T0 = N_MOD + N_ROPE + N_WS;
    constexpr int T1 = T0 + 2 * 40 * 16;
    constexpr int T2 = T1 + 2 * 12 * 4 + 2 * 16 * 2;
    constexpr int T3 = T2 + 2 * 16 * 16;
    constexpr int T4 = T3 + 2 * 96 * 16;
    constexpr int T5 = T4 + 2 * 16 * 32;
    LAS float* tl = (LAS float*)lds;
    for (int it = blockIdx.x; it < T5; it += gridDim.x) {
        if (it < N_MOD) {
            const int l = it / 48, jc = it % 48;
            LAS float* sc = (LAS float*)lds;
            LAS float* red = (LAS float*)(lds + 32768);
            for (int i = tid; i < 8192; i += 512) { const float cv = p.in[I_C][i]; sc[i] = silu_f(cv); }
            __syncthreads();
            const int cgp = tid & 15, kg = tid >> 4;
            float acc[8][4];
#pragma unroll
            for (int b = 0; b < 8; ++b)
#pragma unroll
                for (int c = 0; c < 4; ++c) acc[b][c] = 0.f;
            const float* wp = p.in[I_WMOD] + ((size_t)l * 1024 + 32 * kg) * 3072 + 64 * jc + 4 * cgp;
#pragma unroll 4
            for (int kk = 0; kk < 32; ++kk) {
                const f32x4 w = *(const f32x4*)(wp + (size_t)kk * 3072);
#pragma unroll
                for (int b = 0; b < 8; ++b) { const float s = sc[b * 1024 + 32 * kg + kk];
#pragma unroll
                    for (int c = 0; c < 4; ++c) acc[b][c] += s * w[c]; } }
#pragma unroll
            for (int b = 0; b < 8; ++b)
#pragma unroll
                for (int c = 0; c < 4; ++c) red[(kg * 8 + b) * 64 + 4 * cgp + c] = acc[b][c];
            __syncthreads();
            { const int b = tid >> 6, col = tid & 63; float s = p.in[I_BMOD][l * 3072 + 64 * jc + col];
              for (int q = 0; q < 32; ++q) s += red[(q * 8 + b) * 64 + col];
              ((float*)(ws + WS_MOD))[((size_t)l * 8 + b) * 3072 + 64 * jc + col] = s; }
            __syncthreads();
        } else if (it < N_MOD + N_ROPE) {
            const int r0 = (it - N_MOD) * 4096;
            for (int i = tid; i < 4096; i += 512) { const int idx = r0 + i, row = idx >> 5, fi = idx & 31;
                const float pos = (float)((const int*)p.in[I_POS])[row];
                const float inv = 1.0f / powf(10000.0f, (float)(2 * fi) * (1.0f / 64.0f));
                const float ang = pos * inv; f32x2 cs; cs.x = cosf(ang); cs.y = sinf(ang);
                ((f32x2*)(ws + WS_ROPE))[idx] = cs; }
        } else if (it < T0) {
            const int r0 = (it - N_MOD - N_ROPE) * 4096;
            for (int i = tid; i < 2048; i += 512) { const int idx = r0 + 2 * i; const f32x2 v = *(const f32x2*)(p.in[I_SGW] + idx);
                ((unsigned*)(ws + WS_WS))[idx >> 1] = cvtpk(v.x, v.y); }
        } else if (it < T1) { const int q = it - T0, e = q / 640, r = q % 640, nt = r / 16, kt = r % 16;
            prep_tile<0>(p, tl, (bf16_t*)(ws + WS_WINE) + (size_t)e * 2560 * 1024, 1024, e, nt * 64, kt * 64);
        } else if (it < T2) { const int q = it - T1;
            if (q < 96) { const int e = q / 48, r = q % 48, nt = r / 4, kt = r % 4;
                prep_tile<1>(p, tl, (bf16_t*)(ws + WS_WUP) + (size_t)e * WUP_E, 256, e, nt * 64, kt * 64); }
            else { const int q2 = q - 96, e = q2 / 32, r = q2 % 32, nt = r / 2, kt = r % 2;
                prep_tile<5>(p, tl, (bf16_t*)(ws + WS_WUP) + (size_t)e * WUP_E + WUP_KV, 128, e, nt * 64, kt * 64); }
        } else if (it < T3) { const int q = it - T2, e = q / 256, r = q % 256, nt = r / 16, kt = r % 16;
            prep_tile<2>(p, tl, (bf16_t*)(ws + WS_WOUTE) + (size_t)e * 1024 * 1024, 1024, e, nt * 64, kt * 64);
        } else if (it < T4) { const int q = it - T3, e = q / 1536, r = q % 1536, nt = r / 16, kt = r % 16;
            prep_tile<3>(p, tl, (bf16_t*)(ws + WS_WINO) + (size_t)e * 6144 * 1024, 1024, e, nt * 64, kt * 64);
        } else { const int q = it - T4, e = q / 512, r = q % 512, nt = r / 32, kt = r % 32;
            prep_tile<4>(p, tl, (bf16_t*)(ws + WS_WOUTO) + (size_t)e * 1024 * 2048, 2048, e, nt * 64, kt * 64);
        }
    }
}

__device__ __forceinline__ void norm_phase(const Params& p, int l_post, int l_pre, const bf16_t* y, const float* xin) {
    const int tid = tid_fresh(), lane = tid & 63, wave = tid >> 6;
    const float* mod = (const float*)(p.ws + WS_MOD);
    bf16_t* H = (bf16_t*)(p.ws + WS_H);
    for (int row = blockIdx.x * 8 + wave; row < T_; row += gridDim.x * 8) {
        const int b = row >> 12;
        f32x4 xv[4];
#pragma unroll
        for (int i = 0; i < 4; ++i) xv[i] = *(const f32x4*)(xin + (size_t)row * 1024 + 256 * i + 4 * lane);
        if (l_post >= 0) {
            f32x4 yv[4]; float ss = 0.f;
#pragma unroll
            for (int i = 0; i < 4; ++i) { const u32x2 yw = *(const u32x2*)(y + (size_t)row * 1024 + 256 * i + 4 * lane); yv[i] = (f32x4){bflo(yw.x), bfhi(yw.x), bflo(yw.y), bfhi(yw.y)}; ss += yv[i][0] * yv[i][0] + yv[i][1] * yv[i][1] + yv[i][2] * yv[i][2] + yv[i][3] * yv[i][3]; }
            ss = wave_sum(ss); const float rs = rsqrtf(ss * (1.0f / 1024.0f) + EPS);
            const float* gate = mod + ((size_t)l_post * 8 + b) * 3072 + 2048; const float* gp = p.in[I_GPOST] + l_post * 1024;
#pragma unroll
            for (int i = 0; i < 4; ++i) { const f32x4 g = *(const f32x4*)(gate + 256 * i + 4 * lane), w = *(const f32x4*)(gp + 256 * i + 4 * lane);
                xv[i] = xv[i] + g * (yv[i] * rs * w);
#ifdef DEBUG_SANITIZE
                if (l_post == 3) { for (int q = 0; q < 4; ++q) if (!(fabsf(xv[i][q]) < 1e30f)) xv[i][q] = 12345.f; }
#endif
                *(f32x4*)(p.out + (size_t)row * 1024 + 256 * i + 4 * lane) = xv[i]; }
        }
        if (l_pre >= 0) {
            float ss = 0.f;
#pragma unroll
            for (int i = 0; i < 4; ++i) ss += xv[i][0] * xv[i][0] + xv[i][1] * xv[i][1] + xv[i][2] * xv[i][2] + xv[i][3] * xv[i][3];
            ss = wave_sum(ss); const float rs = rsqrtf(ss * (1.0f / 1024.0f) + EPS);
            const float* sh = mod + ((size_t)l_pre * 8 + b) * 3072; const float* sc = sh + 1024; const float* gp = p.in[I_GPRE] + l_pre * 1024;
#pragma unroll
            for (int i = 0; i < 4; ++i) { const f32x4 s0 = *(const f32x4*)(sh + 256 * i + 4 * lane), s1 = *(const f32x4*)(sc + 256 * i + 4 * lane), w = *(const f32x4*)(gp + 256 * i + 4 * lane);
                const f32x4 hv = (xv[i] * rs * w) * (s1 + 1.0f) + s0; u32x2 o; o.x = cvtpk(hv[0], hv[1]); o.y = cvtpk(hv[2], hv[3]);
                *(u32x2*)(H + (size_t)row * 1024 + 256 * i + 4 * lane) = o; }
        }
    }
}

#define XB_TMO      128
#define XB_XCNT(j)  (256  + 64 * (j))
#define XB_XSUB(j)  (1280 + 64 * (j))
#define XB_XGEN(j)  (2304 + 64 * (j))
#define XB_TOP      3328
#define XB_TOPGEN   3392
#define XCD_BAR_WORDS 3456
#define XB_SPIN_CAP (1u << 18)

__device__ __forceinline__ unsigned xb_ld(unsigned* p)              { return __hip_atomic_load(p, __ATOMIC_RELAXED, __HIP_MEMORY_SCOPE_AGENT); }
__device__ __forceinline__ unsigned xb_add(unsigned* p, unsigned v) { return __hip_atomic_fetch_add(p, v, __ATOMIC_RELAXED, __HIP_MEMORY_SCOPE_AGENT); }
__device__ __forceinline__ unsigned xb_xcc_id() { return (unsigned)__builtin_amdgcn_s_getreg((3 << 11) | 20) & 0xFu; }
#define XB_SPIN(cond, bar) do { unsigned _sp = 0; while (cond) { __builtin_amdgcn_s_sleep(1); \
    if ((++_sp & 255u) == 0u) { if (xb_ld(&(bar)[XB_TMO])) break; if (_sp > XB_SPIN_CAP) { atomicAdd(&(bar)[XB_TMO], 1u); break; } } } } while (0)

struct XcdBarrier {
    unsigned* bar; unsigned x;
    volatile LAS unsigned* st;
};

__device__ __forceinline__ XcdBarrier xcd_barrier_post(unsigned* bar, volatile LAS unsigned* st) {
    XcdBarrier b; b.bar = bar; b.x = xb_xcc_id(); b.st = st;
    if (threadIdx.x == 0) (void)xb_add(&bar[XB_XCNT(b.x)], 1u);
    return b;
}
__device__ __forceinline__ void xcd_barrier_complete(unsigned* bar, unsigned x, unsigned& nloc, unsigned& nx) {
    const unsigned G = gridDim.x * gridDim.y * gridDim.z;
    unsigned sum, cnt, mine, sp = 0u;
    for (;;) {
        sum = 0u; cnt = 0u; mine = 0u;
#pragma unroll
        for (unsigned j = 0; j < 16; ++j) { const unsigned c = xb_ld(&bar[XB_XCNT(j)]); sum += c; cnt += (c > 0u) ? 1u : 0u; mine = (j == x) ? c : mine; }
        if (sum == G) break;
        __builtin_amdgcn_s_sleep(1);
        if ((++sp & 255u) == 0u) { if (xb_ld(&bar[XB_TMO])) break; if (sp > XB_SPIN_CAP) { atomicAdd(&bar[XB_TMO], 1u); break; } }
    }
    nloc = mine > 0u ? mine : 1u; nx = cnt > 0u ? cnt : 1u;
}

__device__ __forceinline__ void xcd_barrier(const XcdBarrier& b) {
    asm volatile("s_waitcnt vmcnt(0)" ::: "memory");
    __syncthreads();
    if (threadIdx.x == 0) {
        unsigned* bar = b.bar;
        __builtin_amdgcn_s_waitcnt(0);
        unsigned nloc = b.st[0], nx = b.st[1];
        if (nloc == 0u) { xcd_barrier_complete(bar, b.x, nloc, nx); b.st[0] = nloc; b.st[1] = nx; }
        const unsigned old = xb_add(&bar[XB_XSUB(b.x)], 1u);
        const unsigned gen = old / nloc;
        if (old + 1u == (gen + 1u) * nloc) {
            __builtin_amdgcn_fence(__ATOMIC_RELEASE, "agent");
            asm volatile("s_waitcnt vmcnt(0)" ::: "memory");
            const unsigned og = xb_add(&bar[XB_TOP], 1u);
            const unsigned tg = og / nx;
            if (og + 1u == (tg + 1u) * nx) xb_add(&bar[XB_TOPGEN], 1u);
            else XB_SPIN(xb_ld(&bar[XB_TOPGEN]) == tg, bar);
            __builtin_amdgcn_fence(__ATOMIC_ACQUIRE, "agent");
            xb_add(&bar[XB_XGEN(b.x)], 1u);
            asm volatile("s_waitcnt vmcnt(0)" ::: "memory");
        } else {
            XB_SPIN(xb_ld(&bar[XB_XGEN(b.x)]) == gen, bar);
            __builtin_amdgcn_fence(__ATOMIC_ACQUIRE, "agent");
            asm volatile("s_waitcnt vmcnt(0)" ::: "memory");
        }
    }
    __syncthreads();
}


struct EpiEvenIn {
    static constexpr bool PERM = true, AFTER_DRAIN = false;
    unsigned char* ws;
    __device__ __forceinline__ void operator()(const f32x4 (&acc)[2][2][4][2], const pg8::Unit& u, int wr, int wc, int fr_, int fq_) const {
        int fr = fr_, fq = fq_; asm volatile("" : "+v"(fr), "+v"(fq));
        const int row0 = u.pm * 256 + wr * 64 + fr, pn = u.pn, cu = 32 * wc + 8 * fq;
        if (pn < 9) {
            bf16_t* base; int ld;
            if (pn == 0) { base = (bf16_t*)(ws + WS_GQ); ld = 256; }
            else if (pn == 1) { base = (bf16_t*)(ws + WS_GK); ld = 256; }
            else if (pn < 4) { base = (bf16_t*)(ws + WS_GV) + (pn - 2) * 256; ld = 512; }
            else if (pn < 6) { base = (bf16_t*)(ws + WS_GZ) + (pn - 4) * 256; ld = 512; }
            else if (pn < 8) { base = (bf16_t*)(ws + WS_MZ) + (pn - 6) * 256; ld = 512; }
            else { base = (bf16_t*)(ws + WS_CQ); ld = 256; }
#pragma unroll
            for (int ai = 0; ai < 2; ++ai)
#pragma unroll
                for (int m = 0; m < 4; ++m) { bf16_t* rowp = base + (size_t)(row0 + ai * 128 + m * 16) * ld + cu;
#pragma unroll
                    for (int bj = 0; bj < 2; ++bj) { const f32x4 v0 = acc[ai][bj][m][0], v1 = acc[ai][bj][m][1];
                        u32x4 w; w.x = cvtpk(v0[0], v0[1]); w.y = cvtpk(v0[2], v0[3]); w.z = cvtpk(v1[0], v1[1]); w.w = cvtpk(v1[2], v1[3]);
                        *(u32x4*)(rowp + bj * 128) = w; } }
        } else {
            bf16_t* ckv = (bf16_t*)(ws + WS_CKV); bf16_t* kr = (bf16_t*)(ws + WS_KR); float* ga = (float*)(ws + WS_GA);
#pragma unroll
            for (int ai = 0; ai < 2; ++ai)
#pragma unroll
                for (int m = 0; m < 4; ++m) { const size_t row = (size_t)(row0 + ai * 128 + m * 16);
                    { const f32x4 v0 = acc[ai][0][m][0], v1 = acc[ai][0][m][1];
                      u32x4 w; w.x = cvtpk(v0[0], v0[1]); w.y = cvtpk(v0[2], v0[3]); w.z = cvtpk(v1[0], v1[1]); w.w = cvtpk(v1[2], v1[3]);
                      *(u32x4*)(ckv + row * 128 + cu) = w; }
                    { const f32x4 v0 = acc[ai][1][m][0], v1 = acc[ai][1][m][1];
                      if (wc < 2) { u32x4 w; w.x = cvtpk(v0[0], v0[1]); w.y = cvtpk(v0[2], v0[3]); w.z = cvtpk(v1[0], v1[1]); w.w = cvtpk(v1[2], v1[3]);
                          *(u32x4*)(kr + row * 64 + cu) = w; }
                      else if (wc == 2) { *(f32x4*)(ga + row * 32 + 8 * fq) = v0; *(f32x4*)(ga + row * 32 + 8 * fq + 4) = v1; } } }
        }
    }
};
struct EpiY {
    static constexpr bool PERM = true, AFTER_DRAIN = false;
    bf16_t* Y;
    __device__ __forceinline__ void operator()(const f32x4 (&acc)[2][2][4][2], const pg8::Unit& u, int wr, int wc, int fr_, int fq_) const {
        int fr = fr_, fq = fq_; asm volatile("" : "+v"(fr), "+v"(fq));
        const int row0 = u.pm * 256 + wr * 64 + fr, col0 = u.pn * 256 + 32 * wc + 8 * fq;
#pragma unroll
        for (int ai = 0; ai < 2; ++ai)
#pragma unroll
            for (int m = 0; m < 4; ++m) { bf16_t* rowp = Y + (size_t)(row0 + ai * 128 + m * 16) * 1024 + col0;
#pragma unroll
                for (int bj = 0; bj < 2; ++bj) { const f32x4 v0 = acc[ai][bj][m][0], v1 = acc[ai][bj][m][1];
                    u32x4 w; w.x = cvtpk(v0[0], v0[1]); w.y = cvtpk(v0[2], v0[3]); w.z = cvtpk(v1[0], v1[1]); w.w = cvtpk(v1[2], v1[3]);
                    *(u32x4*)(rowp + bj * 128) = w; } }
    }
};
template <bool KV> struct EpiUp {
    static constexpr bool PERM = true, AFTER_DRAIN = false;
    unsigned char* ws;
    __device__ __forceinline__ void operator()(const f32x4 (&acc)[2][2][4][2], const pg8::Unit& u, int wr, int wc, int fr_, int fq_) const {
        int fr = fr_, fq = fq_; asm volatile("" : "+v"(fr), "+v"(fq));
        const int row0 = u.pm * 256 + wr * 64 + fr, pn = u.pn;
        bf16_t* Q = (bf16_t*)(ws + WS_Q); bf16_t* K = (bf16_t*)(ws + WS_K); bf16_t* V = (bf16_t*)(ws + WS_V);
        const float* RS = (const float*)(ws + WS_RS); const f32x2* ROPE = (const f32x2*)(ws + WS_ROPE);
#pragma unroll
        for (int ai = 0; ai < 2; ++ai)
#pragma unroll
            for (int m = 0; m < 4; ++m) { const int row = row0 + ai * 128 + m * 16, b = row >> 12, s = row & 4095;
                const f32x2 rs = *(const f32x2*)(RS + 2 * (size_t)row);
#pragma unroll
                for (int bj = 0; bj < 2; ++bj) { f32x4 v0 = acc[ai][bj][m][0], v1 = acc[ai][bj][m][1];
                    if (!KV) {
                        v0 = v0 * rs.x; v1 = v1 * rs.x;
                        const int n = 256 * pn + 128 * bj + 32 * wc + 8 * fq, hh = n / 192, j = n - hh * 192;
                        bf16_t* qrow = Q + ((size_t)(b * 4 + hh) * 4096 + s) * 192;
                        if (j < 128) { u32x4 w; w.x = cvtpk(v0[0], v0[1]); w.y = cvtpk(v0[2], v0[3]); w.z = cvtpk(v1[0], v1[1]); w.w = cvtpk(v1[2], v1[3]);
                            *(u32x4*)(qrow + j) = w; }
                        else { const int i0 = (j - 128) >> 1;
                            const f32x4 c01 = *(const f32x4*)(ROPE + (size_t)row * 32 + i0), c23 = *(const f32x4*)(ROPE + (size_t)row * 32 + i0 + 2);
                            const float cs[4] = {c01[0], c01[2], c23[0], c23[2]}, sn[4] = {c01[1], c01[3], c23[1], c23[3]};
                            float o1[4], o2[4];
#pragma unroll
                            for (int q = 0; q < 4; ++q) { o1[q] = v0[q] * cs[q] - v1[q] * sn[q]; o2[q] = v1[q] * cs[q] + v0[q] * sn[q]; }
                            u32x2 w1, w2; w1.x = cvtpk(o1[0], o1[1]); w1.y = cvtpk(o1[2], o1[3]); w2.x = cvtpk(o2[0], o2[1]); w2.y = cvtpk(o2[2], o2[3]);
                            *(u32x2*)(qrow + 128 + i0) = w1; *(u32x2*)(qrow + 160 + i0) = w2; }
                    } else {
                        v0 = v0 * rs.y; v1 = v1 * rs.y; const int hh = pn, jj = 32 * wc + 8 * fq;
                        u32x4 w; w.x = cvtpk(v0[0], v0[1]); w.y = cvtpk(v0[2], v0[3]); w.z = cvtpk(v1[0], v1[1]); w.w = cvtpk(v1[2], v1[3]);
                        if (bj == 0) *(u32x4*)(K + ((size_t)(b * 4 + hh) * 4096 + s) * 192 + jj) = w;
                        else         *(u32x4*)(V + ((size_t)(b * 4 + hh) * 4096 + s) * 128 + jj) = w;
                    } }
                asm volatile("" ::: "memory"); }
    }
};
struct EpiOddIn {
    static constexpr bool PERM = true, AFTER_DRAIN = false;
    unsigned char* ws;
    __device__ __forceinline__ void operator()(const f32x4 (&acc)[2][2][4][2], const pg8::Unit& u, int wr, int wc, int fr_, int fq_) const {
        int fr = fr_, fq = fq_; asm volatile("" : "+v"(fr), "+v"(fq));
        const int row0 = u.pm * 256 + wr * 64 + fr, pn = u.pn, cu = 32 * wc + 8 * fq;
        typedef float f2 __attribute__((ext_vector_type(2)));
        if (pn < 16) {
            bf16_t* UZ = (bf16_t*)(ws + WS_UZ);
#pragma unroll
            for (int ai = 0; ai < 2; ++ai)
#pragma unroll
                for (int m = 0; m < 4; ++m) { const size_t row = (size_t)(row0 + ai * 128 + m * 16); float o[8];
#pragma unroll
                    for (int n = 0; n < 2; ++n) { const f32x4 uu = acc[ai][0][m][n], zz = acc[ai][1][m][n];
                        const f2 ga = pg8::gelu_pk((f2){uu[0], uu[1]}), gb = pg8::gelu_pk((f2){uu[2], uu[3]});
                        o[4 * n + 0] = ga.x * silu_f(zz[0]); o[4 * n + 1] = ga.y * silu_f(zz[1]); o[4 * n + 2] = gb.x * silu_f(zz[2]); o[4 * n + 3] = gb.y * silu_f(zz[3]); }
                    *(u32x4*)(UZ + row * 2048 + 128 * pn + cu) = pack8(o); }
        } else {
            bf16_t* V2 = (bf16_t*)(ws + WS_V2); f32x2* PART = (f32x2*)(ws + WS_PART);
#pragma unroll
            for (int ai = 0; ai < 2; ++ai)
#pragma unroll
                for (int m = 0; m < 4; ++m) { const size_t row = (size_t)(row0 + ai * 128 + m * 16); float s = 0.f, ss = 0.f;
#pragma unroll
                    for (int bj = 0; bj < 2; ++bj) { float o[8];
#pragma unroll
                        for (int n = 0; n < 2; ++n) { const f32x4 vv = acc[ai][bj][m][n];
                            const f2 ga = pg8::gelu_pk((f2){vv[0], vv[1]}), gb = pg8::gelu_pk((f2){vv[2], vv[3]});
                            o[4 * n + 0] = ga.x; o[4 * n + 1] = ga.y; o[4 * n + 2] = gb.x; o[4 * n + 3] = gb.y; }
#pragma unroll
                        for (int q = 0; q < 8; ++q) { s += o[q]; ss += o[q] * o[q]; }
                        *(u32x4*)(V2 + row * 2048 + 256 * (pn - 16) + 128 * bj + cu) = pack8(o); }
                    s += __shfl_xor(s, 16); ss += __shfl_xor(ss, 16); s += __shfl_xor(s, 32); ss += __shfl_xor(ss, 32);
                    if (fq == 0) PART[row * 32 + (pn - 16) * 4 + wc] = (f32x2){s, ss}; }
        }
    }
};

__device__ __forceinline__ void rs_rope_phase(const Params& p) {
    const int tid = tid_fresh(), lane = tid & 63, wave = tid >> 6, sub = lane & 7, rg = lane >> 3;
    unsigned char* ws = p.ws;
    const bf16_t* CQ = (const bf16_t*)(ws + WS_CQ); const bf16_t* CKV = (const bf16_t*)(ws + WS_CKV); const bf16_t* KR = (const bf16_t*)(ws + WS_KR);
    float* RS = (float*)(ws + WS_RS); const f32x2* ROPE = (const f32x2*)(ws + WS_ROPE); bf16_t* K = (bf16_t*)(ws + WS_K);
    for (int row0 = (blockIdx.x * 8 + wave) * 8; row0 < T_; row0 += gridDim.x * 64) {
        const int row = row0 + rg, b = row >> 12, s = row & 4095;
        float sq = 0.f, sk = 0.f;
#pragma unroll
        for (int q = 0; q < 4; ++q) { const u32x4 a = *(const u32x4*)(CQ + (size_t)row * 256 + sub * 32 + 8 * q); float f[8]; unpack8(a, f);
#pragma unroll
            for (int j = 0; j < 8; ++j) sq += f[j] * f[j]; }
#pragma unroll
        for (int q = 0; q < 2; ++q) { const u32x4 a = *(const u32x4*)(CKV + (size_t)row * 128 + sub * 16 + 8 * q); float f[8]; unpack8(a, f);
#pragma unroll
            for (int j = 0; j < 8; ++j) sk += f[j] * f[j]; }
        sq += __shfl_xor(sq, 1); sk += __shfl_xor(sk, 1); sq += __shfl_xor(sq, 2); sk += __shfl_xor(sk, 2); sq += __shfl_xor(sq, 4); sk += __shfl_xor(sk, 4);
        if (sub == 0) { f32x2 o; o.x = rsqrtf(sq * (1.0f / 256.0f) + EPS); o.y = rsqrtf(sk * (1.0f / 128.0f) + EPS); *(f32x2*)(RS + 2 * (size_t)row) = o; }
        const int i0 = 4 * sub;
        const u32x2 x1w = *(const u32x2*)(KR + (size_t)row * 64 + i0), x2w = *(const u32x2*)(KR + (size_t)row * 64 + 32 + i0);
        const f32x4 c01 = *(const f32x4*)(ROPE + (size_t)row * 32 + i0), c23 = *(const f32x4*)(ROPE + (size_t)row * 32 + i0 + 2);
        const float x1[4] = {bflo(x1w.x), bfhi(x1w.x), bflo(x1w.y), bfhi(x1w.y)}, x2[4] = {bflo(x2w.x), bfhi(x2w.x), bflo(x2w.y), bfhi(x2w.y)};
        const float cs[4] = {c01[0], c01[2], c23[0], c23[2]}, sn[4] = {c01[1], c01[3], c23[1], c23[3]};
        float o1[4], o2[4];
#pragma unroll
        for (int j = 0; j < 4; ++j) { o1[j] = x1[j] * cs[j] - x2[j] * sn[j]; o2[j] = x2[j] * cs[j] + x1[j] * sn[j]; }
        u32x2 w1, w2; w1.x = cvtpk(o1[0], o1[1]); w1.y = cvtpk(o1[2], o1[3]); w2.x = cvtpk(o2[0], o2[1]); w2.y = cvtpk(o2[2], o2[3]);
#pragma unroll
        for (int h = 0; h < 4; ++h) { bf16_t* kp = K + ((size_t)(b * 4 + h) * 4096 + s) * 192 + 128; *(u32x2*)(kp + i0) = w1; *(u32x2*)(kp + 32 + i0) = w2; }
    }
}

constexpr int GL_QF = 0, GL_KF = 9216, GL_QB = 18432, GL_KB = 27648, GL_VT = 36864, GL_ATT = 55296, GL_GRP = 64512, GL_W2 = 129024, GL_B2 = 137216, GL_ROW = 144;
static_assert(GL_B2 + 512 <= LDS_BYTES, "gla lds");

__device__ __forceinline__ void gla_stage_w2(const Params& p, int e, int h, LAS unsigned char* lds) {
    LAS float* W2L = (LAS float*)(lds + GL_W2); LAS float* B2L = (LAS float*)(lds + GL_B2);
    const int tid = tid_fresh();
    for (int idx = tid; idx < 2048; idx += 512) { const int dir = idx >> 10, d = (idx >> 4) & 63, r = idx & 15;
        W2L[idx] = p.in[dir ? I_W2B : I_W2F][((size_t)e * 16 + r) * 256 + h * 64 + d]; }
    if (tid < 128) { const int dir = tid >> 6, d = tid & 63; B2L[tid] = p.in[dir ? I_B2B : I_B2F][e * 256 + h * 64 + d]; }
}
__device__ __forceinline__ void gla_stage_vt(const Params& p, int b, int h, int chunk, LAS unsigned char* G, int gt) {
    const bf16_t* GV = (const bf16_t*)(p.ws + WS_GV);
    const int wv = gt >> 6, ln = gt & 63, c0 = 8 * ((ln >> 4) + 4 * wv);
#pragma unroll
    for (int i = 0; i < 2; ++i) { const int tp = (ln & 15) + 16 * i; const size_t tokA = (size_t)b * 4096 + chunk * 64 + 2 * tp;
        const u32x4 ra = *(const u32x4*)(GV + tokA * 512 + h * 128 + c0), rb = *(const u32x4*)(GV + (tokA + 1) * 512 + h * 128 + c0);
        const unsigned wa[4] = {ra.x, ra.y, ra.z, ra.w}, wb[4] = {rb.x, rb.y, rb.z, rb.w};
#pragma unroll
        for (int q = 0; q < 4; ++q) { const unsigned lo = (wa[q] & 0xffffu) | (wb[q] << 16), hi = (wa[q] >> 16) | (wb[q] & 0xffff0000u);
            *(LAS unsigned*)(G + GL_VT + (c0 + 2 * q) * GL_ROW + 4 * tp) = lo; *(LAS unsigned*)(G + GL_VT + (c0 + 2 * q + 1) * GL_ROW + 4 * tp) = hi; } }
}
__device__ __forceinline__ void gla_stage_ga(const Params& p, int b, int chunk, LAS unsigned char* G, int gt) {
    const float* ga = (const float*)(p.ws + WS_GA) + ((size_t)b * 4096 + chunk * 64) * 32;
#pragma unroll
    for (int i = 0; i < 2; ++i) { const int pc = gt + 256 * i; *(LAS f32x4*)(G + GL_ATT + (pc >> 3) * GL_ROW + (pc & 7) * 16) = *(const f32x4*)(ga + pc * 4); }
}
template <int CTRL, int ROWMASK> __device__ __forceinline__ float dpp_f(float src) {
    return __int_as_float(__builtin_amdgcn_update_dpp(0, __float_as_int(src), CTRL, ROWMASK, 0xf, false)); }
__device__ __forceinline__ float wave_incl_scan(float v) {
    v += dpp_f<0x111, 0xf>(v); v += dpp_f<0x112, 0xf>(v); v += dpp_f<0x114, 0xf>(v); v += dpp_f<0x118, 0xf>(v);
    v += dpp_f<0x142, 0xa>(v);
    v += dpp_f<0x143, 0xc>(v);
    return v; }
template <bool FOR_A>
__device__ __forceinline__ void gla_prep(const Params& p, int e, int b, int h, int chunk, LAS unsigned char* lds, LAS unsigned char* G, int wv, int lane) {
    const LAS float* W2L = (const LAS float*)(lds + GL_W2); const LAS float* B2L = (const LAS float*)(lds + GL_B2);
    const size_t tok = (size_t)b * 4096 + chunk * 64 + lane;
    float af[16], ab[16];
#pragma unroll
    for (int q = 0; q < 4; ++q) { const f32x4 x = *(const LAS f32x4*)(G + GL_ATT + lane * GL_ROW + 16 * q), y = *(const LAS f32x4*)(G + GL_ATT + lane * GL_ROW + 64 + 16 * q);
        af[4 * q] = x[0]; af[4 * q + 1] = x[1]; af[4 * q + 2] = x[2]; af[4 * q + 3] = x[3]; ab[4 * q] = y[0]; ab[4 * q + 1] = y[1]; ab[4 * q + 2] = y[2]; ab[4 * q + 3] = y[3]; }
    float pf[16], pb[16], gbv[16];
#pragma unroll
    for (int dd = 0; dd < 16; ++dd) { const int d = 16 * wv + dd; float xf = B2L[d], xb = B2L[64 + d];
#pragma unroll
        for (int q = 0; q < 4; ++q) { const f32x4 wf = *(const LAS f32x4*)(W2L + d * 16 + 4 * q), wb = *(const LAS f32x4*)(W2L + 1024 + d * 16 + 4 * q);
            xf += af[4 * q] * wf[0] + af[4 * q + 1] * wf[1] + af[4 * q + 2] * wf[2] + af[4 * q + 3] * wf[3];
            xb += ab[4 * q] * wb[0] + ab[4 * q + 1] * wb[1] + ab[4 * q + 2] * wb[2] + ab[4 * q + 3] * wb[3]; }
        pf[dd] = logsig_f(xf) * 0.0625f; gbv[dd] = logsig_f(xb) * 0.0625f; pb[dd] = gbv[dd]; }
#pragma unroll
    for (int dd = 0; dd < 16; ++dd) { pf[dd] = wave_incl_scan(pf[dd]); pb[dd] = wave_incl_scan(pb[dd]); }
#pragma unroll
    for (int dd = 0; dd < 16; ++dd) { const float tot = __int_as_float(__builtin_amdgcn_readlane(__float_as_int(pb[dd]), 63)); pb[dd] = tot - pb[dd] + gbv[dd]; }
    if (FOR_A) {
        float* EV = (float*)(p.ws + WS_EV);
#pragma unroll
        for (int dd = 0; dd < 16; ++dd) { const float tf = __int_as_float(__builtin_amdgcn_readlane(__float_as_int(pf[dd]), 63)), tb = __int_as_float(__builtin_amdgcn_readlane(__float_as_int(pb[dd]), 0));
            if (lane == 0) { EV[((size_t)((b * 4 + h) * 2 + 0) * 64 + chunk) * 64 + 16 * wv + dd] = __expf(tf); EV[((size_t)((b * 4 + h) * 2 + 1) * 64 + chunk) * 64 + 16 * wv + dd] = __expf(tb); } }
    }
#ifdef DBG_MAXP
    if (FOR_A) { float mx = 0.f;
        for (int dd = 0; dd < 16; ++dd) { mx = fmaxf(mx, DBG_MAXP); }
        atomicMax((int*)(p.ws + WS_PART) + 41, __float_as_int(mx)); }
#endif
    float kv[16], qv[16];
    { const bf16_t* kp = (const bf16_t*)(p.ws + WS_GK) + tok * 256 + h * 64 + 16 * wv; const u32x4 k0 = *(const u32x4*)kp, k1 = *(const u32x4*)(kp + 8);
      float t0[8], t1[8]; unpack8(k0, t0); unpack8(k1, t1);
#pragma unroll
      for (int q = 0; q < 8; ++q) { kv[q] = t0[q]; kv[8 + q] = t1[q]; } }
    if (!FOR_A) { const bf16_t* qp = (const bf16_t*)(p.ws + WS_GQ) + tok * 256 + h * 64 + 16 * wv; const u32x4 q0 = *(const u32x4*)qp, q1 = *(const u32x4*)(qp + 8);
      float t0[8], t1[8]; unpack8(q0, t0); unpack8(q1, t1);
#pragma unroll
      for (int q = 0; q < 8; ++q) { qv[q] = t0[q] * 0.125f; qv[8 + q] = t1[q] * 0.125f; } }
    if (FOR_A) {
#pragma unroll
        for (int dd = 0; dd < 16; ++dd) { const int d = 16 * wv + dd;
#ifdef DBG_NOEXP
            const float kf = kv[dd], kb = kv[dd];
#else
            const float kf = kv[dd] * __expf(-pf[dd]), kb = kv[dd] * __expf(-pb[dd]);
#endif
#ifdef DBG_KEXPR
            { const float vv = DBG_KEXPR; const float mv = (vv != vv) ? 7.7e7f : fabsf(vv); atomicMax((int*)(p.ws + WS_PART) + 41, __float_as_int(mv)); }
#endif

            *(LAS bf16_t*)(G + GL_QF + d * GL_ROW + 2 * lane) = (bf16_t)(cvtpk(kf, kf) & 0xffff);
            *(LAS bf16_t*)(G + GL_KF + d * GL_ROW + 2 * lane) = (bf16_t)(cvtpk(kb, kb) & 0xffff); }
    } else {
        float o[8];
#define GLA_PUT(OFF, EXPR0) do { _Pragma("unroll") for (int hf = 0; hf < 2; ++hf) { _Pragma("unroll") for (int q = 0; q < 8; ++q) { const int dd = 8 * hf + q; o[q] = (EXPR0); } \
            *(LAS u32x4*)(G + (OFF) + lane * GL_ROW + (16 * wv + 8 * hf) * 2) = pack8(o); } } while (0)
        GLA_PUT(GL_QF, qv[dd] * __expf(pf[dd]));
        GLA_PUT(GL_KF, kv[dd] * __expf(-pf[dd]));
        GLA_PUT(GL_QB, qv[dd] * __expf(pb[dd]));
        GLA_PUT(GL_KB, kv[dd] * __expf(-pb[dd]));
#undef GLA_PUT
    }
}

__device__ __forceinline__ void gla_a_phase(const Params& p, int e, LAS unsigned char* lds) {
    const int tid = tid_fresh(), grp = __builtin_amdgcn_readfirstlane(tid >> 8), wv = __builtin_amdgcn_readfirstlane((tid & 255) >> 6);
    LAS unsigned char* G = lds + grp * GL_GRP;
    bf16_t* ST = (bf16_t*)(p.ws + WS_ST);
    int h_staged = -1;
    for (int it = blockIdx.x; it < 1024; it += gridDim.x) {
        int lane = tid & 63; asm volatile("" : "+v"(lane));
        const int gt = 64 * wv + lane, tq = lane & 15, quad = lane >> 4;
        const int b = it >> 7, h = (it >> 5) & 3, chunk = 2 * (it & 31) + grp;
        __syncthreads();
        if (h != h_staged) { gla_stage_w2(p, e, h, lds); h_staged = h; }
        gla_stage_ga(p, b, chunk, G, gt);
        __syncthreads();
        gla_prep<true>(p, e, b, h, chunk, lds, G, wv, lane);
        gla_stage_vt(p, b, h, chunk, G, gt);
        __syncthreads();
        const int dir = wv >> 1, ch = wv & 1;
        LAS unsigned char* KT = G + (dir ? GL_KF : GL_QF);
        f32x4 acc[4][4];
#pragma unroll
        for (int mb = 0; mb < 4; ++mb)
#pragma unroll
            for (int nb = 0; nb < 4; ++nb) acc[mb][nb] = (f32x4){0.f, 0.f, 0.f, 0.f};
#pragma unroll
        for (int ks = 0; ks < 2; ++ks) { bf16x8 a[4], bb[4];
#pragma unroll
            for (int mb = 0; mb < 4; ++mb) a[mb] = *(const LAS bf16x8*)(KT + (16 * mb + tq) * GL_ROW + (32 * ks + 8 * quad) * 2);
#pragma unroll
            for (int nb = 0; nb < 4; ++nb) bb[nb] = *(const LAS bf16x8*)(G + GL_VT + (64 * ch + 16 * nb + tq) * GL_ROW + (32 * ks + 8 * quad) * 2);
#pragma unroll
            for (int mb = 0; mb < 4; ++mb)
#pragma unroll
                for (int nb = 0; nb < 4; ++nb) acc[mb][nb] = MFMA16(a[mb], bb[nb], acc[mb][nb]); }
        bf16_t* slot = ST + ((size_t)((b * 4 + h) * 2 + dir) * 64 + chunk) * 8192;
#pragma unroll
        for (int mb = 0; mb < 4; ++mb)
#pragma unroll
            for (int nb = 0; nb < 4; ++nb) { const int c = 64 * ch + 16 * nb + tq, d = 16 * mb + 4 * quad; const f32x4 v = acc[mb][nb];
                u32x2 w; w.x = cvtpk(v[0], v[1]); w.y = cvtpk(v[2], v[3]); *(u32x2*)(slot + c * 64 + d) = w; }
    }
}
__device__ __forceinline__ void gla_b_phase(const Params& p, bool dry = false) {
    bf16_t* ST = (bf16_t*)(p.ws + WS_ST); const float* EV = (const float*)(p.ws + WS_EV);
    const int tid = tid_fresh();
    for (int e = blockIdx.x * 512 + tid; e < 131072; e += gridDim.x * 512) {
        const int seq = e >> 11, within = e & 2047, dq = within & 15, dir = seq & 1;
        bf16_t* sp = ST + (size_t)seq * 64 * 8192 + within * 4; const float* ep = EV + (size_t)seq * 64 * 64 + dq * 4;
        float S0 = 0.f, S1 = 0.f, S2 = 0.f, S3 = 0.f;
        for (int k0 = 0; k0 < 64; k0 += 8) { u32x2 uu[8]; f32x4 ee[8];
#pragma unroll
            for (int q = 0; q < 8; ++q) { const int ck = dir ? 63 - (k0 + q) : (k0 + q); uu[q] = *(const u32x2*)(sp + (size_t)ck * 8192); ee[q] = *(const f32x4*)(ep + ck * 64); }
#pragma unroll
            for (int q = 0; q < 8; ++q) { const int ck = dir ? 63 - (k0 + q) : (k0 + q);
                u32x2 w; w.x = cvtpk(S0, S1); w.y = cvtpk(S2, S3); if (!dry || S0 == 1.2345e33f) *(u32x2*)(sp + (size_t)ck * 8192) = w;
                S0 = ee[q][0] * (S0 + bflo(uu[q].x)); S1 = ee[q][1] * (S1 + bfhi(uu[q].x)); S2 = ee[q][2] * (S2 + bflo(uu[q].y)); S3 = ee[q][3] * (S3 + bfhi(uu[q].y)); } }
    }
}
__device__ __forceinline__ void gla_c_phase(const Params& p, int e, LAS unsigned char* lds) {
    const int tid = tid_fresh(), grp = __builtin_amdgcn_readfirstlane(tid >> 8), wv = __builtin_amdgcn_readfirstlane((tid & 255) >> 6);
    LAS unsigned char* G = lds + grp * GL_GRP;
    const bf16_t* ST = (const bf16_t*)(p.ws + WS_ST); const bf16_t* GZ = (const bf16_t*)(p.ws + WS_GZ); bf16_t* O = (bf16_t*)(p.ws + WS_H);
    int h_staged = -1;
    for (int it = blockIdx.x; it < 1024; it += gridDim.x) {
        int lane = tid & 63; asm volatile("" : "+v"(lane));
        const int gt = 64 * wv + lane, tq = lane & 15, quad = lane >> 4;
        const int b = it >> 7, h = (it >> 5) & 3, chunk = 2 * (it & 31) + grp;
        __syncthreads();
        if (h != h_staged) { gla_stage_w2(p, e, h, lds); h_staged = h; }
        gla_stage_ga(p, b, chunk, G, gt);
        __syncthreads();
        gla_prep<false>(p, e, b, h, chunk, lds, G, wv, lane);
        gla_stage_vt(p, b, h, chunk, G, gt);
        __syncthreads();
        const int t = 16 * wv + tq;
        u32x4 stf[4], stb[4];
        { const bf16_t* slf = ST + ((size_t)((b * 4 + h) * 2 + 0) * 64 + chunk) * 8192; const bf16_t* slb = ST + ((size_t)((b * 4 + h) * 2 + 1) * 64 + chunk) * 8192;
#pragma unroll
          for (int i = 0; i < 4; ++i) { const int pc = gt + 256 * i; stf[i] = *(const u32x4*)(slf + pc * 8); stb[i] = *(const u32x4*)(slb + pc * 8); } }
        bf16x8 bqf[2], bqb[2];
        {
            f32x4 sf[4], sb[4];
#pragma unroll
            for (int mb = 0; mb < 4; ++mb) { sf[mb] = (f32x4){0.f, 0.f, 0.f, 0.f}; sb[mb] = (f32x4){0.f, 0.f, 0.f, 0.f}; }
#pragma unroll
            for (int ks = 0; ks < 2; ++ks) { const int ko = (32 * ks + 8 * quad) * 2;
                bqf[ks] = *(const LAS bf16x8*)(G + GL_QF + t * GL_ROW + ko); bqb[ks] = *(const LAS bf16x8*)(G + GL_QB + t * GL_ROW + ko);
#pragma unroll
                for (int mb = 0; mb < 4; ++mb) { const bf16x8 akf = *(const LAS bf16x8*)(G + GL_KF + (16 * mb + tq) * GL_ROW + ko), akb = *(const LAS bf16x8*)(G + GL_KB + (16 * mb + tq) * GL_ROW + ko);
                    sf[mb] = MFMA16(akf, bqf[ks], sf[mb]); sb[mb] = MFMA16(akb, bqb[ks], sb[mb]); } }
#pragma unroll
            for (int mb = 0; mb < 4; ++mb) { const int s0 = 16 * mb + 4 * quad; float v[4];
#pragma unroll
                for (int j = 0; j < 4; ++j) v[j] = (s0 + j <= t) ? sf[mb][j] : sb[mb][j];
                u32x2 w; w.x = cvtpk(v[0], v[1]); w.y = cvtpk(v[2], v[3]); *(LAS u32x2*)(G + GL_ATT + t * GL_ROW + s0 * 2) = w; }
        }
        __syncthreads();
#pragma unroll
        for (int i = 0; i < 4; ++i) { const int pc = gt + 256 * i, c = pc >> 3, c8 = pc & 7;
            *(LAS u32x4*)(G + c * GL_ROW + c8 * 16) = stf[i]; *(LAS u32x4*)(G + 18432 + c * GL_ROW + c8 * 16) = stb[i]; }
        f32x4 o[8];
#pragma unroll
        for (int mb = 0; mb < 8; ++mb) o[mb] = (f32x4){0.f, 0.f, 0.f, 0.f};
        const int crow0 = 8 * (tq >> 2) + (tq & 3);
#pragma unroll
        for (int ks = 0; ks < 2; ++ks) { const int ko = (32 * ks + 8 * quad) * 2; const bf16x8 batt = *(const LAS bf16x8*)(G + GL_ATT + t * GL_ROW + ko);
#pragma unroll
            for (int mb = 0; mb < 8; ++mb) { const int c = 32 * (mb >> 1) + crow0 + 4 * (mb & 1);
                const bf16x8 av = *(const LAS bf16x8*)(G + GL_VT + c * GL_ROW + ko); o[mb] = MFMA16(av, batt, o[mb]); } }
        __syncthreads();
#pragma unroll
        for (int dir = 0; dir < 2; ++dir) {
#pragma unroll
            for (int ks = 0; ks < 2; ++ks) { const int ko = (32 * ks + 8 * quad) * 2; const bf16x8 bq = dir ? bqb[ks] : bqf[ks];
#pragma unroll
                for (int mb = 0; mb < 8; ++mb) { const int c = 32 * (mb >> 1) + crow0 + 4 * (mb & 1);
                    const bf16x8 as = *(const LAS bf16x8*)(G + dir * 18432 + c * GL_ROW + ko); o[mb] = MFMA16(as, bq, o[mb]); } } }
        float ss = 0.f;
#pragma unroll
        for (int mb = 0; mb < 8; ++mb) ss += o[mb][0] * o[mb][0] + o[mb][1] * o[mb][1] + o[mb][2] * o[mb][2] + o[mb][3] * o[mb][3];
        ss += __shfl_xor(ss, 16); ss += __shfl_xor(ss, 32);
        const float rs = rsqrtf(ss * (1.0f / 128.0f) + EPS);
        const size_t tok = (size_t)b * 4096 + chunk * 64 + t;
#pragma unroll
        for (int pp = 0; pp < 4; ++pp) { const int c0 = 32 * pp + 8 * quad;
            const u32x4 gzw = *(const u32x4*)(GZ + tok * 512 + h * 128 + c0); float z[8]; unpack8(gzw, z);
            const f32x4 g0 = *(const f32x4*)(p.in[I_GNORM] + e * 128 + c0), g1 = *(const f32x4*)(p.in[I_GNORM] + e * 128 + c0 + 4);
            float r[8];
#pragma unroll
            for (int j = 0; j < 4; ++j) { r[j] = o[2 * pp][j] * rs * g0[j] * silu_f(z[j]); r[4 + j] = o[2 * pp + 1][j] * rs * g1[j] * silu_f(z[4 + j]); }
            *(u32x4*)(O + tok * 1024 + h * 128 + c0) = pack8(r); }
    }
}

#ifndef ATT_EARLY
#define ATT_EARLY 1
#endif
namespace att {
constexpr int DQK = 192, DV = 128, NW = 8, QBLK = 32, KVBLK = 64;
constexpr float SCALE = 0.07216878364870323f;
constexpr float THR = 8.f;
constexpr int SDEPTH = ATT_SDEPTH;
constexpr int SHM_V = KVBLK * DV * 2, SHM_K = KVBLK * DQK * 2;
constexpr int SHM_QR = 2 * SHM_V + 2 * SHM_K + NW * 64 * 4;
constexpr int NQR = ATT_NQR;
constexpr int SHM_ATTN = SHM_QR + NW * (12 - NQR) * 1024;
#define KSWZ(row, colB) ((row) * 384 + ((colB) ^ (((row) & 7) << 4)))
#define SBAR() __builtin_amdgcn_sched_barrier(0)
__device__ __forceinline__ int crow(int r, int hi) { return (r & 3) + 8 * (r >> 2) + 4 * hi; }
__device__ __forceinline__ unsigned cvtpkv(float lo, float hi) { unsigned r; asm volatile("v_cvt_pk_bf16_f32 %0, %1, %2" : "=v"(r) : "v"(lo), "v"(hi)); return r; }

__device__ __forceinline__ void partialSM(f32x16& p0, f32x16& p1, float& m_reg, float& mn, float& alpha) {
  constexpr float C = SCALE * 1.4426950408889634f;
  float pmax = p0[0];
#pragma unroll
  for (int r = 1; r < 16; ++r) pmax = fmaxf(pmax, p0[r]);
#pragma unroll
  for (int r = 0; r < 16; ++r) pmax = fmaxf(pmax, p1[r]);
  { auto rr = __builtin_amdgcn_permlane32_swap(__float_as_uint(pmax), __float_as_uint(pmax), false, false);
    pmax = fmaxf(__uint_as_float(rr[0]), __uint_as_float(rr[1])); }
  if (__builtin_expect(__all(pmax - m_reg <= THR / SCALE), 1)) { mn = m_reg; alpha = 1.f; }
  else { mn = fmaxf(m_reg, pmax); alpha = __builtin_amdgcn_exp2f((m_reg - mn) * C); m_reg = mn; }
  float mnC = -mn * C;
#pragma unroll
  for (int r = 0; r < 16; ++r) p0[r] = fmaf(p0[r], C, mnC);
#pragma unroll
  for (int r = 0; r < 16; ++r) p1[r] = fmaf(p1[r], C, mnC);
#pragma unroll
  for (int r = 0; r < 16; ++r) p0[r] = __builtin_amdgcn_exp2f(p0[r]);
}
__device__ __forceinline__ void finishSM(f32x16& p0, f32x16& p1, float alpha, float& l_reg, bf16x8& pa0, bf16x8& pa1, bf16x8& pa2, bf16x8& pa3) {
#pragma unroll
  for (int r = 0; r < 16; ++r) p1[r] = __builtin_amdgcn_exp2f(p1[r]);
  float ps = 0;
#pragma unroll
  for (int r = 0; r < 16; ++r) ps += p0[r];
#pragma unroll
  for (int r = 0; r < 16; ++r) ps += p1[r];
  { auto rr = __builtin_amdgcn_permlane32_swap(__float_as_uint(ps), __float_as_uint(ps), false, false);
    ps = __uint_as_float(rr[0]) + __uint_as_float(rr[1]); }
  l_reg = l_reg * alpha + ps;
#define PK4(P, BASE, OUT) do { unsigned a0 = cvtpkv(P[BASE + 0], P[BASE + 1]), a1 = cvtpkv(P[BASE + 2], P[BASE + 3]);   \
    unsigned b0 = cvtpkv(P[BASE + 4], P[BASE + 5]), b1 = cvtpkv(P[BASE + 6], P[BASE + 7]);                              \
    auto r0 = __builtin_amdgcn_permlane32_swap(a0, b0, false, false); auto r1 = __builtin_amdgcn_permlane32_swap(a1, b1, false, false); \
    u32x4 w = {r0[0], r1[0], r0[1], r1[1]}; OUT = *reinterpret_cast<bf16x8*>(&w); } while (0)
  PK4(p0, 0, pa0); PK4(p0, 8, pa1); PK4(p1, 0, pa2); PK4(p1, 8, pa3);
#undef PK4
}
__device__ __forceinline__ void qkt(f32x16& p0, f32x16& p1, const char* Ks, const bf16x8* qr, const char* qrl, int r32, int hi) {
  p0 = f32x16{}; p1 = f32x16{};
#pragma unroll
  for (int d0 = 0; d0 < 12; ++d0) { int cb = (d0 * 16 + hi * 8) * 2;
    bf16x8 b0 = *reinterpret_cast<const bf16x8*>(Ks + KSWZ(r32, cb));
    bf16x8 b1 = *reinterpret_cast<const bf16x8*>(Ks + KSWZ(32 + r32, cb));
    const bf16x8 q = d0 < NQR ? qr[d0 < NQR ? d0 : 0] : *reinterpret_cast<const bf16x8*>(qrl + (d0 - NQR) * 1024);
    p0 = __builtin_amdgcn_mfma_f32_32x32x16_bf16(b0, q, p0, 0, 0, 0);
    p1 = __builtin_amdgcn_mfma_f32_32x32x16_bf16(b1, q, p1, 0, 0, 0); }
}
__device__ __forceinline__ int v_st(int k, int c) { const int kk = (k & ~0xC) | ((k & 4) << 1) | ((k & 8) >> 1); return ((kk >> 3) * 4 + (c >> 5)) * 512 + ((kk & 7) * 32 + (c & 31)) * 2; }
__device__ __forceinline__ int v_rd_base(int lane) { return ((lane & 3) << 3) | (((lane >> 2) & 3) << 6) | (((lane >> 4) & 1) << 5) | (((lane >> 5) & 1) << 8); }
constexpr int v_rd_off(int d0, int ks, int half) { return d0 * 512 + ks * 4096 + half * 2048; }
template <int OFF> __device__ __forceinline__ s16x4 tr_read(int vb) {
  s16x4 r; asm volatile("ds_read_b64_tr_b16 %0, %1 offset:%2" : "=&v"(r) : "v"(vb), "i"(OFF) : "memory"); return r;
}
template <int D0> __device__ __forceinline__ void pv_one(f32x16& od, int vb, bf16x8 pa0, bf16x8 pa1, bf16x8 pa2, bf16x8 pa3) {
  const s16x4 l0 = tr_read<v_rd_off(D0, 0, 0)>(vb), h0 = tr_read<v_rd_off(D0, 0, 1)>(vb), l1 = tr_read<v_rd_off(D0, 1, 0)>(vb), h1 = tr_read<v_rd_off(D0, 1, 1)>(vb);
  const s16x4 l2 = tr_read<v_rd_off(D0, 2, 0)>(vb), h2 = tr_read<v_rd_off(D0, 2, 1)>(vb), l3 = tr_read<v_rd_off(D0, 3, 0)>(vb), h3 = tr_read<v_rd_off(D0, 3, 1)>(vb);
  asm volatile("s_waitcnt lgkmcnt(0)" ::: "memory"); SBAR();
#define PK(L, H) (bf16x8){L[0], L[1], L[2], L[3], H[0], H[1], H[2], H[3]}
  od = __builtin_amdgcn_mfma_f32_32x32x16_bf16(pa0, PK(l0, h0), od, 0, 0, 0);
  od = __builtin_amdgcn_mfma_f32_32x32x16_bf16(pa1, PK(l1, h1), od, 0, 0, 0);
  od = __builtin_amdgcn_mfma_f32_32x32x16_bf16(pa2, PK(l2, h2), od, 0, 0, 0);
  od = __builtin_amdgcn_mfma_f32_32x32x16_bf16(pa3, PK(l3, h3), od, 0, 0, 0);
#undef PK
}
__device__ __forceinline__ void pv_d0(f32x16* o, int vb, bf16x8 pa0, bf16x8 pa1, bf16x8 pa2, bf16x8 pa3) {
  pv_one<0>(o[0], vb, pa0, pa1, pa2, pa3); pv_one<1>(o[1], vb, pa0, pa1, pa2, pa3); pv_one<2>(o[2], vb, pa0, pa1, pa2, pa3); pv_one<3>(o[3], vb, pa0, pa1, pa2, pa3);
}

template <int OFF> __device__ __forceinline__ bf16x8 lds_rd128(int a) { bf16x8 r; asm volatile("ds_read_b128 %0, %1 offset:%2" : "=&v"(r) : "v"(a), "i"(OFF) : "memory"); return r; }
template <int N> __device__ __forceinline__ void lgkm_wait2(bf16x8& a, bf16x8& b) { asm volatile("s_waitcnt lgkmcnt(%2)" : "+v"(a), "+v"(b) : "n"(N) : "memory"); }
template <int N> __device__ __forceinline__ void lgkm_wait3(bf16x8& a, bf16x8& b, bf16x8& c) { asm volatile("s_waitcnt lgkmcnt(%3)" : "+v"(a), "+v"(b), "+v"(c) : "n"(N) : "memory"); }
template <int N> __device__ __forceinline__ void lgkm_wait2s(s16x4& a, s16x4& b) { asm volatile("s_waitcnt lgkmcnt(%2)" : "+v"(a), "+v"(b) : "n"(N) : "memory"); }
constexpr int k_off(int buf, int d0, int half) { return buf * SHM_K + (d0 >> 2) * 128 + half * 12288; }
constexpr int q_off(int d0) { return (d0 >= NQR ? d0 - NQR : 0) * 1024; }
template <int BUF, int D0> __device__ __forceinline__ void k_fetch(bf16x8& b0, bf16x8& b1, bf16x8& qx, const int (&ka)[4], int qa) {
  b0 = lds_rd128<k_off(BUF, D0, 0)>(ka[D0 & 3]); b1 = lds_rd128<k_off(BUF, D0, 1)>(ka[D0 & 3]);
  if constexpr (D0 >= NQR) qx = lds_rd128<q_off(D0)>(qa);
}
template <int BUF, int D0> __device__ __forceinline__ void qk_step(f32x16& p0, f32x16& p1, bf16x8 (&b0)[2], bf16x8 (&b1)[2], bf16x8 (&qx)[2], const bf16x8* qr, const int (&ka)[4], int qa) {
  if constexpr (D0 < 11) k_fetch<BUF, D0 + 1>(b0[(D0 + 1) & 1], b1[(D0 + 1) & 1], qx[(D0 + 1) & 1], ka, qa);
  constexpr int PEND = D0 < 11 ? (2 + ((D0 + 1) >= NQR ? 1 : 0)) : 0;
  if constexpr (D0 >= NQR) lgkm_wait3<PEND>(b0[D0 & 1], b1[D0 & 1], qx[D0 & 1]); else lgkm_wait2<PEND>(b0[D0 & 1], b1[D0 & 1]);
  const bf16x8 q = D0 < NQR ? qr[D0 < NQR ? D0 : 0] : qx[D0 & 1];
  p0 = __builtin_amdgcn_mfma_f32_32x32x16_bf16(b0[D0 & 1], q, p0, 0, 0, 0);
  p1 = __builtin_amdgcn_mfma_f32_32x32x16_bf16(b1[D0 & 1], q, p1, 0, 0, 0);
}
template <int BUF> __device__ __forceinline__ void qkt2(f32x16& p0, f32x16& p1, const bf16x8* qr, const int (&ka)[4], int qa) {
  p0 = f32x16{}; p1 = f32x16{};
  bf16x8 b0[2], b1[2], qx[2];
  k_fetch<BUF, 0>(b0[0], b1[0], qx[0], ka, qa);
  qk_step<BUF, 0>(p0, p1, b0, b1, qx, qr, ka, qa); qk_step<BUF, 1>(p0, p1, b0, b1, qx, qr, ka, qa); qk_step<BUF, 2>(p0, p1, b0, b1, qx, qr, ka, qa); qk_step<BUF, 3>(p0, p1, b0, b1, qx, qr, ka, qa);
  qk_step<BUF, 4>(p0, p1, b0, b1, qx, qr, ka, qa); qk_step<BUF, 5>(p0, p1, b0, b1, qx, qr, ka, qa); qk_step<BUF, 6>(p0, p1, b0, b1, qx, qr, ka, qa); qk_step<BUF, 7>(p0, p1, b0, b1, qx, qr, ka, qa);
  qk_step<BUF, 8>(p0, p1, b0, b1, qx, qr, ka, qa); qk_step<BUF, 9>(p0, p1, b0, b1, qx, qr, ka, qa); qk_step<BUF, 10>(p0, p1, b0, b1, qx, qr, ka, qa); qk_step<BUF, 11>(p0, p1, b0, b1, qx, qr, ka, qa);
}
template <int BUF, int S> __device__ __forceinline__ void v_fetch(s16x4& l, s16x4& h, int vb) {
  l = tr_read<BUF * SHM_V + v_rd_off(S & 3, S >> 2, 0)>(vb); h = tr_read<BUF * SHM_V + v_rd_off(S & 3, S >> 2, 1)>(vb);
}
template <int BUF, int S> __device__ __forceinline__ void pv_step(f32x16* o, s16x4 (&l)[3], s16x4 (&h)[3], int vb, const bf16x8 (&pa)[4]) {
  if constexpr (S + 2 < 16) v_fetch<BUF, S + 2>(l[(S + 2) % 3], h[(S + 2) % 3], vb);
  constexpr int PEND = S + 2 < 16 ? 4 : (S + 1 < 16 ? 2 : 0);
  lgkm_wait2s<PEND>(l[S % 3], h[S % 3]);
  const s16x4 L = l[S % 3], H = h[S % 3];
  o[S & 3] = __builtin_amdgcn_mfma_f32_32x32x16_bf16(pa[S >> 2], (bf16x8){L[0], L[1], L[2], L[3], H[0], H[1], H[2], H[3]}, o[S & 3], 0, 0, 0);
}
template <int BUF> __device__ __forceinline__ void pv2(f32x16* o, int vb, bf16x8 pa0, bf16x8 pa1, bf16x8 pa2, bf16x8 pa3) {
  s16x4 l[3], h[3]; const bf16x8 pa[4] = {pa0, pa1, pa2, pa3};
  v_fetch<BUF, 0>(l[0], h[0], vb); v_fetch<BUF, 1>(l[1], h[1], vb);
  pv_step<BUF, 0>(o, l, h, vb, pa); pv_step<BUF, 1>(o, l, h, vb, pa); pv_step<BUF, 2>(o, l, h, vb, pa); pv_step<BUF, 3>(o, l, h, vb, pa);
  pv_step<BUF, 4>(o, l, h, vb, pa); pv_step<BUF, 5>(o, l, h, vb, pa); pv_step<BUF, 6>(o, l, h, vb, pa); pv_step<BUF, 7>(o, l, h, vb, pa);
  pv_step<BUF, 8>(o, l, h, vb, pa); pv_step<BUF, 9>(o, l, h, vb, pa); pv_step<BUF, 10>(o, l, h, vb, pa); pv_step<BUF, 11>(o, l, h, vb, pa);
  pv_step<BUF, 12>(o, l, h, vb, pa); pv_step<BUF, 13>(o, l, h, vb, pa); pv_step<BUF, 14>(o, l, h, vb, pa); pv_step<BUF, 15>(o, l, h, vb, pa);
}

__device__ __forceinline__ void attn_body(const bf16_t* __restrict__ Qb, const bf16_t* __restrict__ Kh, const bf16_t* __restrict__ Vh,
                                          const bf16_t* __restrict__ MZb, bf16_t* __restrict__ Ob, int seq, char* lds) {
  const int tid = tid_fresh(), wid = __builtin_amdgcn_readfirstlane(tid >> 6), lane = tid & 63, r32 = lane & 31, hi = lane >> 5;
  char* V_lds = lds; char* K_lds = lds + 2 * SHM_V;
  float* wsl = (float*)(lds + 2 * SHM_V + 2 * SHM_K) + wid * 64; float* li_l = wsl; float* al_l = wsl + 32;
  float m_reg = -1e30f, l_reg = 0; f32x16 o[4] = {}; bf16x8 qr[NQR];
  char* qrl = lds + SHM_QR + wid * ((12 - NQR) * 1024) + lane * 16;
  const bf16_t* Qw = Qb + (long)(wid * QBLK + r32) * DQK + hi * 8;
#pragma unroll
  for (int d0 = 0; d0 < NQR; ++d0) qr[d0] = *reinterpret_cast<const bf16x8*>(Qw + d0 * 16);
#pragma unroll
  for (int d0 = NQR; d0 < 12; ++d0) *reinterpret_cast<bf16x8*>(qrl + (d0 - NQR) * 1024) = *reinterpret_cast<const bf16x8*>(Qw + d0 * 16);
  const int sr = tid >> 4, sc = (tid & 15) * 8, vst0 = v_st(sr, sc);
  const int sr2 = tid >> 3, sl2 = 16 + (tid & 7);
  const unsigned kg0 = sr * DQK + sc, kg2 = sr2 * DQK + sl2 * 8, voff0 = sr * DV + sc;
  const int kl0 = KSWZ(sr, sc * 2), kl2 = KSWZ(sr2, sl2 * 16);
  const int vb0 = (int)(uintptr_t)(LAS char*)V_lds + v_rd_base(lane);
  int ka[4]; { const int kbase = (int)(uintptr_t)(LAS char*)K_lds + r32 * 384;
#pragma unroll
    for (int j = 0; j < 4; ++j) ka[j] = kbase + ((j * 32 + hi * 16) ^ ((r32 & 7) << 4)); }
  const int qa = (int)(uintptr_t)(LAS char*)qrl;
  struct { bf16x8 vs0, vs1, ks0, ks1, ks2; } sr_[SDEPTH];
#define SLOAD(i, k0) do { const bf16_t* Kt = Kh + (size_t)(k0) * DQK; const bf16_t* Vt = Vh + (size_t)(k0) * DV; \
    sr_[i].vs0 = *(const bf16x8*)(Vt + voff0); sr_[i].vs1 = *(const bf16x8*)(Vt + voff0 + 32 * DV); \
    sr_[i].ks0 = *(const bf16x8*)(Kt + kg0); sr_[i].ks1 = *(const bf16x8*)(Kt + kg0 + 32 * DQK); sr_[i].ks2 = *(const bf16x8*)(Kt + kg2); } while (0)
#define SWRITE(b, i) do { *(bf16x8*)(V_lds + (b) * SHM_V + vst0) = sr_[i].vs0; *(bf16x8*)(V_lds + (b) * SHM_V + vst0 + 8192) = sr_[i].vs1; \
    *(bf16x8*)(K_lds + (b) * SHM_K + kl0) = sr_[i].ks0; *(bf16x8*)(K_lds + (b) * SHM_K + kl0 + 32 * 384) = sr_[i].ks1; *(bf16x8*)(K_lds + (b) * SHM_K + kl2) = sr_[i].ks2; } while (0)
#define SWAIT() do { if constexpr (SDEPTH == 2) asm volatile("s_waitcnt vmcnt(5)" ::: "memory"); else asm volatile("s_waitcnt vmcnt(0)" ::: "memory"); } while (0)
#define RESC(a) do { if (__any((a) < 1.f)) { if (hi == 0) al_l[r32] = (a); asm volatile("s_waitcnt lgkmcnt(0)" ::: "memory"); \
    _Pragma("unroll") for (int d = 0; d < 4; ++d) _Pragma("unroll") for (int r = 0; r < 16; ++r) o[d][r] *= al_l[crow(r, hi)]; } } while (0)
  f32x16 pA0, pA1, pB0, pB1; float mnA, mnB, alA, alB; bf16x8 pa0, pa1, pa2, pa3; const int NT = seq / KVBLK;
  constexpr int SE = 0, SO = SDEPTH - 1;
  SLOAD(SE, 0); asm volatile("s_waitcnt vmcnt(0)" ::: "memory"); SWRITE(0, SE); __syncthreads();
  qkt2<0>(pA0, pA1, qr, ka, qa); partialSM(pA0, pA1, m_reg, mnA, alA);
  SLOAD(SO, KVBLK); if constexpr (SDEPTH == 2) { if (2 < NT) SLOAD(SE, 2 * KVBLK); }
  SWAIT(); SWRITE(1, SO); __syncthreads();
  for (int j = 1; j + 1 < NT; j += 2) {
#if ATT_EARLY
    SBAR(); SLOAD(SO, (j + SDEPTH) * KVBLK); SBAR();
#endif
    SBAR(); qkt2<1>(pB0, pB1, qr, ka, qa);
    finishSM(pA0, pA1, alA, l_reg, pa0, pa1, pa2, pa3); SBAR();
#if !ATT_EARLY
    SLOAD(SO, (j + SDEPTH) * KVBLK); SBAR();
#endif
    pv2<0>(o, vb0, pa0, pa1, pa2, pa3); partialSM(pB0, pB1, m_reg, mnB, alB);
    __syncthreads(); SWAIT(); SWRITE(0, SE);
    RESC(alB); __syncthreads();
#if ATT_EARLY
    SBAR(); if (SDEPTH == 1 || j + 3 < NT) SLOAD(SE, (j + 1 + SDEPTH) * KVBLK); SBAR();
#endif
    SBAR(); qkt2<0>(pA0, pA1, qr, ka, qa);
    finishSM(pB0, pB1, alB, l_reg, pa0, pa1, pa2, pa3); SBAR();
#if !ATT_EARLY
    if (SDEPTH == 1 || j + 3 < NT) SLOAD(SE, (j + 1 + SDEPTH) * KVBLK); SBAR();
#endif
    pv2<1>(o, vb0, pa0, pa1, pa2, pa3); partialSM(pA0, pA1, m_reg, mnA, alA);
    __syncthreads(); SWAIT(); SWRITE(1, SO);
    RESC(alA); __syncthreads();
  }
  SBAR(); qkt2<1>(pB0, pB1, qr, ka, qa);
  finishSM(pA0, pA1, alA, l_reg, pa0, pa1, pa2, pa3); SBAR();
  pv2<0>(o, vb0, pa0, pa1, pa2, pa3); partialSM(pB0, pB1, m_reg, mnB, alB);
  __syncthreads(); RESC(alB);
  finishSM(pB0, pB1, alB, l_reg, pa0, pa1, pa2, pa3); SBAR();
  pv2<1>(o, vb0, pa0, pa1, pa2, pa3);
  if (hi == 0) li_l[r32] = l_reg; asm volatile("s_waitcnt lgkmcnt(0)" ::: "memory");
  float rli[16];
#pragma unroll
  for (int r = 0; r < 16; ++r) rli[r] = __builtin_amdgcn_rcpf(li_l[crow(r, hi)]);
  __syncthreads();
  int ln = lane; asm volatile("" : "+v"(ln));
  char* Tw = lds + wid * 8192; const int r32l = ln & 31, hil = ln >> 5;
#pragma unroll
  for (int r = 0; r < 16; ++r) { const int ro = (r & 3) + 8 * (r >> 2);
#pragma unroll
    for (int d0 = 0; d0 < 4; ++d0) { const float v = o[d0][r] * rli[r];
      *(bf16_t*)(Tw + (ro + 4 * hil) * 256 + (32 * d0 + r32l) * 2) = (bf16_t)(cvtpk(v, v) & 0xffff); } }
  asm volatile("" ::: "memory");
  bf16_t* Ow = Ob + (size_t)(wid * QBLK) * 1024; const bf16_t* Zw = MZb + (size_t)(wid * QBLK) * 512;
#pragma unroll
  for (int i = 0; i < 8; ++i) { const int pc = ln + 64 * i, row = pc >> 4, c8 = pc & 15;
    const u32x4 ov = *(const u32x4*)(Tw + row * 256 + c8 * 16), zv = *(const u32x4*)(Zw + (unsigned)(row * 512 + c8 * 8));
    float fo[8], fz[8]; unpack8(ov, fo); unpack8(zv, fz);
#pragma unroll
    for (int j = 0; j < 8; ++j) fo[j] *= silu_f(fz[j]);
    *(u32x4*)(Ow + (unsigned)(row * 1024 + c8 * 8)) = pack8(fo); }
#undef SLOAD
#undef SWRITE
#undef SWAIT
#undef RESC
}
}

__device__ __forceinline__ void attn_phase(const Params& p, unsigned char* lds_generic) {
    const bf16_t* Q = (const bf16_t*)(p.ws + WS_Q); const bf16_t* K = (const bf16_t*)(p.ws + WS_K); const bf16_t* V = (const bf16_t*)(p.ws + WS_V);
    const bf16_t* MZ = (const bf16_t*)(p.ws + WS_MZ); bf16_t* O = (bf16_t*)(p.ws + WS_H);
    for (int it = blockIdx.x; it < 512; it += gridDim.x) {
        const int xcd = it & 7, r = it >> 3, bh = xcd * 4 + (r >> 4), qb = r & 15, b = bh >> 2, h = bh & 3;
        __syncthreads();
        const size_t tok0 = (size_t)b * 4096 + qb * 256;
        att::attn_body(Q + ((size_t)bh * 4096 + qb * 256) * 192, K + (size_t)bh * 4096 * 192, V + (size_t)bh * 4096 * 128,
                       MZ + tok0 * 512 + h * 128, O + tok0 * 1024 + 512 + h * 128, 4096, (char*)lds_generic);
    }
    __syncthreads();
}

constexpr int MX_WL = 0, MX_VT = 34816, MX_ST = 104448, MX_ROW = 272;
__device__ __forceinline__ void mix_phase(const Params& p, int oi, LAS unsigned char* lds, bool dry = false) {
    const int tid = tid_fresh(), w = __builtin_amdgcn_readfirstlane(tid >> 6), lane = tid & 63, tq = lane & 15, quad = lane >> 4;
    const bf16_t* Wsb = (const bf16_t*)(p.ws + WS_WS); const bf16_t* V2 = (const bf16_t*)(p.ws + WS_V2); bf16_t* UZ = (bf16_t*)(p.ws + WS_UZ);
    const f32x2* PART = (const f32x2*)(p.ws + WS_PART);
    LAS f32x2* STAT = (LAS f32x2*)(lds + MX_ST);
    const int per = 2048 / gridDim.x; int last_g = -1;
    for (int i = 0; i < per; ++i) {
        const int it = blockIdx.x * per + i, g = it >> 8, bn = it & 255, b = bn >> 5, n = bn & 31; const size_t tok0 = (size_t)b * 4096 + n * 128;
        __syncthreads();
        if (g != last_g) { last_g = g;
#pragma unroll
            for (int q = 0; q < 4; ++q) { const int pc = tid + 512 * q, row = pc >> 4, cgp = pc & 15;
                *(LAS u32x4*)(lds + MX_WL + row * MX_ROW + cgp * 16) = *(const u32x4*)(Wsb + ((size_t)(oi * 8 + g) * 128 + row) * 128 + cgp * 8); } }
        {
            const int tl = tid >> 2, part = tid & 3; const f32x4* pp = (const f32x4*)(PART + (tok0 + tl) * 32 + part * 8);
            const f32x4 p0 = pp[0], p1 = pp[1], p2 = pp[2], p3 = pp[3];
            float s = (p0[0] + p0[2]) + (p1[0] + p1[2]) + (p2[0] + p2[2]) + (p3[0] + p3[2]), ss = (p0[1] + p0[3]) + (p1[1] + p1[3]) + (p2[1] + p2[3]) + (p3[1] + p3[3]);
            s += __shfl_xor(s, 1); ss += __shfl_xor(ss, 1); s += __shfl_xor(s, 2); ss += __shfl_xor(ss, 2);
            const float mu = s * (1.0f / 2048.0f), var = ss * (1.0f / 2048.0f) - mu * mu; if (part == 0) STAT[tl] = (f32x2){mu, rsqrtf(var + EPS)}; }
        u32x4 uzw[8];
#pragma unroll
        for (int nb = 0; nb < 8; ++nb) uzw[nb] = *(const u32x4*)(UZ + (tok0 + 16 * nb + tq) * 2048 + g * 256 + 32 * w + 8 * quad);
        __syncthreads();
        {
            const int c0 = 8 * ((lane >> 4) + 4 * w);
            const f32x4 gl0 = *(const f32x4*)(p.in[I_SGG] + oi * 2048 + g * 256 + c0), gl1 = *(const f32x4*)(p.in[I_SGG] + oi * 2048 + g * 256 + c0 + 4);
            const f32x4 bl0 = *(const f32x4*)(p.in[I_SGB] + oi * 2048 + g * 256 + c0), bl1 = *(const f32x4*)(p.in[I_SGB] + oi * 2048 + g * 256 + c0 + 4);
#pragma unroll
            for (int q = 0; q < 4; ++q) { const int rp = (lane & 15) + 16 * q; const size_t tokA = tok0 + 2 * rp; const f32x2 sa = STAT[2 * rp], sb = STAT[2 * rp + 1];
                const u32x4 ra = *(const u32x4*)(V2 + tokA * 2048 + g * 256 + c0), rb = *(const u32x4*)(V2 + (tokA + 1) * 2048 + g * 256 + c0);
                float fa[8], fb[8]; unpack8(ra, fa); unpack8(rb, fb);
#pragma unroll
                for (int e = 0; e < 8; ++e) { const float gg = e < 4 ? gl0[e & 3] : gl1[e & 3], bb = e < 4 ? bl0[e & 3] : bl1[e & 3];
                    const float va = (fa[e] - sa.x) * sa.y * gg + bb, vb = (fb[e] - sb.x) * sb.y * gg + bb;
                    *(LAS unsigned*)(lds + MX_VT + (c0 + e) * MX_ROW + 4 * rp) = cvtpk(va, vb); } }
        }
        __syncthreads();
        bf16x8 A[2][4];
#pragma unroll
        for (int mb = 0; mb < 2; ++mb)
#pragma unroll
            for (int ks = 0; ks < 4; ++ks) { const int c = 32 * w + 8 * (tq >> 2) + 4 * mb + (tq & 3);
                A[mb][ks] = *(const LAS bf16x8*)(lds + MX_VT + c * MX_ROW + (32 * ks + 8 * quad) * 2); }
#pragma unroll
        for (int nb = 0; nb < 8; ++nb) {
            f32x4 a0 = (f32x4){0.f, 0.f, 0.f, 0.f}, a1 = (f32x4){0.f, 0.f, 0.f, 0.f};
#pragma unroll
            for (int ks = 0; ks < 4; ++ks) { const bf16x8 bw = *(const LAS bf16x8*)(lds + MX_WL + (16 * nb + tq) * MX_ROW + (32 * ks + 8 * quad) * 2);
                a0 = MFMA16(A[0][ks], bw, a0); a1 = MFMA16(A[1][ks], bw, a1); }
            const int ti = 16 * nb + tq; const size_t tok = tok0 + ti; const float bias = p.in[I_SGBS][(oi * 8 + g) * 128 + ti];
            bf16_t* up = UZ + tok * 2048 + g * 256 + 32 * w + 8 * quad;
            float f[8]; unpack8(uzw[nb], f);
#pragma unroll
            for (int j = 0; j < 4; ++j) { f[j] *= (a0[j] + bias); f[4 + j] *= (a1[j] + bias); }
            if (!dry || f[0] == 1.2345e33f) *(u32x4*)up = pack8(f);
        }
    }
    __syncthreads();
}

constexpr size_t WS_BAR = (WS_TOTAL + 255) / 256 * 256;
constexpr size_t WS_NEED = WS_BAR + (size_t)XCD_BAR_WORDS * 4;
__device__ __forceinline__ int opq(int x) { asm volatile("" : "+s"(x)); return x; }
__global__ void __launch_bounds__(512, 2) mega(Params p) {
    extern __shared__ __attribute__((aligned(16))) unsigned char lds_[];
    LAS unsigned char* lds = (LAS unsigned char*)lds_;
    cg::grid_group grid = cg::this_grid();
    const int lo = p.ph_lo, hi = p.ph_hi;
    unsigned char* ws = p.ws;
#ifdef ONLY_PH
#define IN(k) ((((k) - 2) % 10 + 2 == ONLY_PH || (k) == ONLY_PH) && lo <= (k) && (k) < hi)
#else
#define IN(k) (lo <= (k) && (k) < hi)
#endif
    volatile LAS unsigned* xb_st = (volatile LAS unsigned*)(lds + LDS_BYTES - 16);
    if (threadIdx.x < 4) xb_st[threadIdx.x] = 0u;
    __syncthreads();
    XcdBarrier xbar = xcd_barrier_post((unsigned*)(ws + WS_BAR), xb_st);
    if (p.ph_lo < 0) grid.sync();
#ifdef DBL_BAR
#define SEAM(k) do { if (IN(k) && IN((k) + 1)) { xcd_barrier(xbar); xcd_barrier(xbar); } } while (0)
#else
#define SEAM(k) do { if (IN(k) && IN((k) + 1)) xcd_barrier(xbar); } while (0)
#endif
#if defined(DBG_MAXP) || defined(DBG_KEXPR)
    if (blockIdx.x == 0 && threadIdx.x == 0) ((int*)(ws + WS_PART))[41] = 0;
#endif
#ifndef REP
#define REP 0
#endif
#define REPN(bit) (((REP) >> (bit)) & 1 ? 2 : 1)
    if (IN(0)) for (int rep = 0; rep < REPN(8); ++rep) p0_phase(p, lds);
    SEAM(0);
    if (IN(1)) for (int rep = 0; rep < (((REP) >> 10) & 1 ? 5 : 1); ++rep) norm_phase(p, -1, 0, nullptr, p.in[I_X]);
    SEAM(1);
    if (((REP) >> 11) & 1) for (int rep = 0; rep < 20; ++rep) grid.sync();
    for (int lp = 0; lp < 2; ++lp) {
        const int base = 2 + 10 * lp, le = 2 * lp, lod = 2 * lp + 1;
        if (IN(base + 0)) for (int rep = 0; rep < REPN(0); ++rep) {
            pg8::Gemm g{(const bf16_t*)(ws + WS_H), (const bf16_t*)(ws + WS_WINE) + (size_t)lp * 2560 * 1024, T_, opq(2560), opq(1024)};
            pg8::StaticOrder S; S.init(T_, 2560, (int)gridDim.x, (int)blockIdx.x); EpiEvenIn E{ws};
            pg8::gemm_phase<EpiEvenIn, pg8::StaticOrder, false>(lds, g, S, E, nullptr);
        }
        SEAM(base + 0);
        if (IN(base + 1)) { for (int rep = 0; rep < REPN(9); ++rep) rs_rope_phase(p); for (int rep = 0; rep < REPN(1); ++rep) gla_a_phase(p, lp, lds); }
        SEAM(base + 1);
        if (IN(base + 2)) {
          for (int rep = 0; rep < REPN(2); ++rep) {
            { pg8::Gemm g{(const bf16_t*)(ws + WS_CQ), (const bf16_t*)(ws + WS_WUP) + (size_t)lp * WUP_E, T_, opq(768), opq(256)};
              pg8::StaticOrder S; S.init(T_, 768, (int)gridDim.x, (int)blockIdx.x); EpiUp<false> E{ws};
              pg8::gemm_phase<EpiUp<false>, pg8::StaticOrder, false>(lds, g, S, E, nullptr); }
            { pg8::Gemm g{(const bf16_t*)(ws + WS_CKV), (const bf16_t*)(ws + WS_WUP) + (size_t)lp * WUP_E + WUP_KV, T_, opq(1024), opq(128)};
              pg8::StaticOrder S; S.init(T_, 1024, (int)gridDim.x, (int)blockIdx.x); EpiUp<true> E{ws};
              pg8::gemm_phase<EpiUp<true>, pg8::StaticOrder, false>(lds, g, S, E, nullptr); } }
            if (((REP) >> 12) & 1) gla_b_phase(p, true);
            gla_b_phase(p);
        }
        SEAM(base + 2);
        if (IN(base + 3)) {
#ifdef ATT_VAR
            attn_phase<ATT_VAR>(p, lds_);
#endif
            for (int rep = 0; rep < REPN(3); ++rep) attn_phase(p, lds_); for (int rep = 0; rep < REPN(4); ++rep) gla_c_phase(p, lp, lds); }
        SEAM(base + 3);
        if (IN(base + 4)) for (int rep = 0; rep < REPN(5); ++rep) {
            pg8::Gemm g{(const bf16_t*)(ws + WS_H), (const bf16_t*)(ws + WS_WOUTE) + (size_t)lp * 1024 * 1024, T_, opq(1024), opq(1024)};
            pg8::StaticOrder S; S.init(T_, 1024, (int)gridDim.x, (int)blockIdx.x); EpiY E{(bf16_t*)(ws + WS_YE)};
            pg8::gemm_phase<EpiY, pg8::StaticOrder, false>(lds, g, S, E, nullptr);
        }
        SEAM(base + 4);
        if (IN(base + 5)) norm_phase(p, le, le + 1, (const bf16_t*)(ws + WS_YE), le == 0 ? p.in[I_X] : p.out);
        SEAM(base + 5);
        if (IN(base + 6)) for (int rep = 0; rep < REPN(6); ++rep) {
            pg8::Gemm g{(const bf16_t*)(ws + WS_H), (const bf16_t*)(ws + WS_WINO) + (size_t)lp * 6144 * 1024, T_, opq(6144), opq(1024)};
            pg8::StaticOrder S; S.init(T_, 6144, (int)gridDim.x, (int)blockIdx.x); EpiOddIn E{ws};
            pg8::gemm_phase<EpiOddIn, pg8::StaticOrder, false>(lds, g, S, E, nullptr);
        }
        SEAM(base + 6);
        if (IN(base + 7)) { if (((REP) >> 13) & 1) mix_phase(p, lp, lds, true); mix_phase(p, lp, lds); }
        SEAM(base + 7);
        if (IN(base + 8)) for (int rep = 0; rep < REPN(7); ++rep) {
            pg8::Gemm g{(const bf16_t*)(ws + WS_UZ), (const bf16_t*)(ws + WS_WOUTO) + (size_t)lp * 1024 * 2048, T_, opq(1024), opq(2048)};
            pg8::StaticOrder S; S.init(T_, 1024, (int)gridDim.x, (int)blockIdx.x); EpiY E{(bf16_t*)(ws + WS_YO)};
            pg8::gemm_phase<EpiY, pg8::StaticOrder, false>(lds, g, S, E, nullptr);
        }
        SEAM(base + 8);
        if (IN(base + 9)) norm_phase(p, lod, lod < 3 ? lod + 1 : -1, (const bf16_t*)(ws + WS_YO), p.out);
        SEAM(base + 9);
    }
#ifdef DEBUG_HI
    {
        int* DIAG = (int*)(ws + WS_PART);
        const int tid = tid_fresh(); const size_t gtid = (size_t)blockIdx.x * 512 + tid, gsz = (size_t)gridDim.x * 512;
        grid.sync();
        if (blockIdx.x == 0 && tid < 64 && tid != 41) DIAG[tid] = 0;
        for (size_t i = gtid; i < (size_t)T_ * 1024; i += gsz) p.out[i] = DBG_KEEP_OUT ? p.out[i] : 0.f;
        grid.sync();
#define DBG_CHECK(bi, off_, n_, isf32) { int bad = 0; \
            if (isf32) { const float* q = (const float*)(ws + (off_)); for (size_t i = gtid; i < (size_t)(n_); i += gsz) { const float v = q[i]; if (!(fabsf(v) < DBG_LIM)) bad = 1; } } \
            else { const bf16_t* q = (const bf16_t*)(ws + (off_)); for (size_t i = gtid; i < (size_t)(n_); i += gsz) { const float v = bf2f(q[i]); if (!(fabsf(v) < DBG_LIM)) bad = 1; } } \
            if (bad) atomicAdd(&DIAG[bi], 1); }
        DEBUG_BUFS
#ifdef DBG_FRAC
        { int cnt = 0; const bf16_t* q = (const bf16_t*)(ws + DBG_FRAC_OFF); for (size_t i = gtid; i < (size_t)(DBG_FRAC_N); i += gsz) { const float v = bf2f(q[i]); if (!(fabsf(v) < DBG_LIM)) ++cnt; } if (cnt) atomicAdd(&DIAG[40], cnt); }
#endif
        const int nb = DBG_NB;
        grid.sync();
        if (blockIdx.x == 0 && tid == 0) { int first = -1; for (int bi = 0; bi < nb; ++bi) if (first < 0 && __hip_atomic_load(&DIAG[bi], __ATOMIC_RELAXED, __HIP_MEMORY_SCOPE_AGENT) != 0) first = bi; p.out[0] = 1000.f * (float)(first + 1);
#if defined(DBG_MAXP) || defined(DBG_KEXPR)
            p.out[0] = 100.f * __int_as_float(__hip_atomic_load(&DIAG[41], __ATOMIC_RELAXED, __HIP_MEMORY_SCOPE_AGENT));
#endif
#ifdef DBG_FRAC
            p.out[0] = 100.f * (float)__hip_atomic_load(&DIAG[40], __ATOMIC_RELAXED, __HIP_MEMORY_SCOPE_AGENT);
#endif
        }
    }
#endif
}

extern "C" void kernel_launch(void* const* d_in, const int* in_sizes, int n_in, void* d_out, int out_size, void* d_ws, size_t ws_size, hipStream_t stream) {
    static int grid_blocks = 0;
    if (!grid_blocks) {
        if (n_in != 24 || out_size != T_ * 1024 || ws_size < WS_NEED) { fprintf(stderr, "kernel_launch: unexpected shapes (n_in %d out %d ws %zu need %zu)\n", n_in, out_size, ws_size, (size_t)WS_NEED); return; }
        if (hipFuncSetAttribute((const void*)mega, hipFuncAttributeMaxDynamicSharedMemorySize, (int)LDS_BYTES) != hipSuccess) { fprintf(stderr, "hipFuncSetAttribute failed\n"); return; }
        int dev = 0, cus = 0, per_cu = 0;
        (void)hipGetDevice(&dev);
        (void)hipDeviceGetAttribute(&cus, hipDeviceAttributeMultiprocessorCount, dev);
        (void)hipOccupancyMaxActiveBlocksPerMultiprocessor(&per_cu, mega, 512, LDS_BYTES);
        if (per_cu < 1 || cus != 256) { fprintf(stderr, "kernel_launch: occupancy %d cus %d\n", per_cu, cus); }
        grid_blocks = 256;
    }
    Params p{};
    for (int i = 0; i < 24; ++i) p.in[i] = (const float*)d_in[i];
    p.out = (float*)d_out; p.ws = (unsigned char*)d_ws;
#if N_LAUNCH_MODE == 0
    (void)hipMemsetAsync((unsigned char*)d_ws + WS_BAR, 0, (size_t)XCD_BAR_WORDS * 4, stream);
#ifdef DEBUG_HI
    p.ph_lo = 0; p.ph_hi = DEBUG_HI;
#else
    p.ph_lo = 0; p.ph_hi = NPHASE;
#endif
    void* args[] = {&p};
    hipError_t e = hipLaunchCooperativeKernel((void*)mega, dim3(grid_blocks), dim3(512), args, LDS_BYTES, stream);
    if (e != hipSuccess) fprintf(stderr, "cooperative launch failed: %s (grid %d)\n", hipGetErrorString(e), grid_blocks);
#else
    for (int k = 0; k < NPHASE; ++k) { p.ph_lo = k; p.ph_hi = k + 1; hipLaunchKernelGGL(mega, dim3(grid_blocks), dim3(512), LDS_BYTES, stream, p); }
#endif
}
```

```cpp
#ifndef ATT_SDEPTH
#define ATT_SDEPTH 1
#endif
#ifndef ATT_NQR
#define ATT_NQR 8
#endif
#include <hip/hip_runtime.h>
namespace pg8 {
#define PG8_LAS __attribute__((address_space(3)))
typedef unsigned short bf16_t;
typedef short bf16x8 __attribute__((ext_vector_type(8)));
typedef float f32x4 __attribute__((ext_vector_type(4)));
typedef unsigned u32x4 __attribute__((ext_vector_type(4)));
constexpr int BM = 256, BK = 64, HALF = 128, HTB = HALF * BK * 2  , STAGE_BYTES = 8 * HTB, NXCD = 8, WGM = 8;

__host__ __device__ __forceinline__ int lds_byte(int r, int c) { const int st = (r >> 4) * 2 + (c >> 5), rr = r & 15, cc = c & 31, ob = rr * 64 + cc * 2; return st * 1024 + (ob ^ (((ob >> 9) & 1) << 5)); }
__host__ __device__ __forceinline__ void stage_rc(int b, int& R, int& C) { const int st = b / 1024, sb = b % 1024, swz = sb ^ (((sb >> 9) & 1) << 5); R = (st >> 1) * 16 + swz / 64; C = (st & 1) * 32 + (swz % 64) / 2; }
__host__ __device__ __forceinline__ int perm32(int rho) { const int n = rho >> 4, i = rho & 15; return 8 * (i >> 2) + 4 * n + (i & 3); }

struct Unit { int pm, pn; };
struct Gemm { const bf16_t* A; const bf16_t* Bt; int M, N, K; };

struct StaticOrder {
    int nM, nN, nwg, G, c;
    __host__ __device__ void init(int M, int N, int G_, int c_) { nM = M / BM; nN = N / BM; nwg = nM * nN; G = G_; c = c_; }
    __host__ __device__ bool next(int i, Unit& u) const {
        const long L = (long)i * G + c; if (L >= nwg) return false;
        int wgid = (int)L; { const int q = nwg / NXCD, r = nwg % NXCD, xcd = wgid % NXCD, off = wgid / NXCD; wgid = (xcd < r ? xcd * (q + 1) : r * (q + 1) + (xcd - r) * q) + off; }
        const int nig = WGM * nN, gid = wgid / nig, fm = gid * WGM, gsz = (nM - fm) < WGM ? (nM - fm) : WGM;
        u.pm = fm + ((wgid % nig) % gsz); u.pn = (wgid % nig) / gsz; return true;
    }
    __device__ __forceinline__ void a_ready(const Unit&) const {}
    __device__ __forceinline__ void done(const Unit&) const {}
};
__device__ __forceinline__ unsigned cvt_pk_bf16(float lo, float hi) { unsigned r; asm volatile("v_cvt_pk_bf16_f32 %0, %1, %2" : "=v"(r) : "v"(lo), "v"(hi)); return r; }
typedef float f32x2 __attribute__((ext_vector_type(2)));
__device__ __forceinline__ f32x2 gelu_pk(f32x2 v) {
    const f32x2 av = __builtin_elementwise_abs(v), d = av * 0.2316418882f + 1.0f;
    f32x2 t; t.x = __builtin_amdgcn_rcpf(d.x); t.y = __builtin_amdgcn_rcpf(d.y);
    f32x2 q = t * 0.5307027145f + (-0.7265760135f); q = q * t + 0.7107068705f; q = q * t + (-0.142248368f); q = q * t + 0.127414796f; q = q * t;
    const f32x2 s = (v * v) * (-0.72134752044f);
    f32x2 e; e.x = __builtin_amdgcn_exp2f(s.x); e.y = __builtin_amdgcn_exp2f(s.y);
    const f32x2 m = v * (q * e), r = v - m;
    f32x2 o; o.x = v.x < 0.f ? m.x : r.x; o.y = v.y < 0.f ? m.y : r.y; return o;
}

struct EpiF32 {
    static constexpr bool PERM = false, AFTER_DRAIN = false;
    float* C; int ldc; const float* bias;
    __device__ __forceinline__ void operator()(const f32x4 (&acc)[2][2][4][2], const Unit& u, int wr, int wc, int fr, int fq) const {
        const int row0 = u.pm * BM + wr * 64 + fr, col0 = u.pn * BM + wc * 32 + 4 * fq;
        f32x4 bv[2][2];
#pragma unroll
        for (int bj = 0; bj < 2; ++bj)
#pragma unroll
            for (int n = 0; n < 2; ++n) bv[bj][n] = bias ? *(const f32x4*)(bias + col0 + bj * HALF + n * 16) : (f32x4){0.f, 0.f, 0.f, 0.f};
#pragma unroll
        for (int ai = 0; ai < 2; ++ai)
#pragma unroll
            for (int m = 0; m < 4; ++m) { float* rowp = C + (size_t)(row0 + ai * HALF + m * 16) * ldc + col0;
#pragma unroll
                for (int bj = 0; bj < 2; ++bj)
#pragma unroll
                    for (int n = 0; n < 2; ++n) *(f32x4*)(rowp + bj * HALF + n * 16) = acc[ai][bj][m][n] + bv[bj][n]; }
    }
};
template <class Epi, class Sched, bool STAMP = false>
__device__ __forceinline__ void gemm_phase(PG8_LAS unsigned char* lds, const Gemm g, const Sched& S, const Epi& E, unsigned long long* stamps) {
    int tid = threadIdx.x; asm volatile("" : "+v"(tid));
    const int wid = __builtin_amdgcn_readfirstlane(tid >> 6), lane = tid & 63, wr = wid >> 2, wc = wid & 3, fr = lane & 15, fq = lane >> 4;
    const int K = g.K, nt = K / BK;
    int ts_lo = 0, ts_hi = 0, nts = 0; const unsigned long long rt_entry = STAMP ? (unsigned long long)wall_clock64() : 0ull;
#define PG8_STAMP() do { if (STAMP && wid == 0 && nts < 64) { const unsigned long long _c = (unsigned long long)clock64(); \
        ts_lo = (lane == nts) ? (int)(unsigned)_c : ts_lo; ts_hi = (lane == nts) ? (int)(unsigned)(_c >> 32) : ts_hi; ++nts; } } while (0)
    PG8_STAMP();
    unsigned voffA[2], voffB[2];
#pragma unroll
    for (int i = 0; i < 2; ++i) { int R, C; stage_rc(tid * 16 + i * 8192, R, C); const int Rb = Epi::PERM ? ((R & ~31) + perm32(R & 31)) : R;
        voffA[i] = (unsigned)(R * K + C) * 2u; voffB[i] = (unsigned)(Rb * K + C) * 2u; }
    const size_t kstep = (size_t)(BK * 2);
    const size_t hstep = (size_t)HALF * K * 2;
    const size_t tstep = 2 * hstep;
    const unsigned ldsw = (unsigned)wid * 1024u;
    const int aoff = lds_byte(wr * 64 + fr, fq * 8), boff = lds_byte(wc * 32 + fr, fq * 8);
#define PG8_SA(b, h) (((b) * 2 + (h)) * HTB)
#define PG8_SB(b, h) ((4 + (b) * 2 + (h)) * HTB)
#define PG8_STAGE(bufoff, gbase, voff) do { _Pragma("unroll") for (int _i = 0; _i < 2; ++_i) \
        __builtin_amdgcn_global_load_lds((const unsigned*)((const char*)(gbase) + (voff)[_i]), (PG8_LAS unsigned*)(lds + (bufoff) + ldsw + _i * 8192), 16, 0, 0); } while (0)
#define PG8_LDA(dst, b, h) do { _Pragma("unroll") for (int m = 0; m < 4; ++m) _Pragma("unroll") for (int k = 0; k < 2; ++k) dst[m][k] = *(const PG8_LAS bf16x8*)(lds + PG8_SA(b, h) + aoff + m * 2048 + k * 1024); } while (0)
#define PG8_LDB(dst, b, h) do { _Pragma("unroll") for (int n = 0; n < 2; ++n) _Pragma("unroll") for (int k = 0; k < 2; ++k) dst[n][k] = *(const PG8_LAS bf16x8*)(lds + PG8_SB(b, h) + boff + n * 2048 + k * 1024); } while (0)
#define PG8_MMA(ai, bj, At, Bt) do { __builtin_amdgcn_s_setprio(1); _Pragma("unroll") for (int m = 0; m < 4; ++m) _Pragma("unroll") for (int n = 0; n < 2; ++n) _Pragma("unroll") for (int k = 0; k < 2; ++k) \
        acc[ai][bj][m][n] = __builtin_amdgcn_mfma_f32_16x16x32_bf16(Bt[n][k], At[m][k], acc[ai][bj][m][n], 0, 0, 0); __builtin_amdgcn_s_setprio(0); } while (0)
#define PG8_WAIT_V(n) asm volatile("s_waitcnt vmcnt(" #n ")" ::: "memory")
#define PG8_WAIT_L(n) asm volatile("s_waitcnt lgkmcnt(" #n ")" ::: "memory")
#define PG8_BAR __builtin_amdgcn_s_barrier()
#define PG8_SCHED __builtin_amdgcn_sched_barrier(0)
    Unit cur, nxt; int ui = 0;
    if (!S.next(0, cur)) return;
    f32x4 acc[2][2][4][2];
#pragma unroll
    for (int a = 0; a < 2; ++a)
#pragma unroll
        for (int b = 0; b < 2; ++b)
#pragma unroll
            for (int m = 0; m < 4; ++m)
#pragma unroll
                for (int n = 0; n < 2; ++n) acc[a][b][m][n] = (f32x4){0.f, 0.f, 0.f, 0.f};
    bf16x8 At[4][2], B0[2][2], B1[2][2];
    const char* cA = (const char*)g.A + (size_t)cur.pm * tstep; const char* cB = (const char*)g.Bt + (size_t)cur.pn * tstep;
    S.a_ready(cur);
    PG8_STAGE(PG8_SB(0, 0), cB, voffB); PG8_STAGE(PG8_SA(0, 0), cA, voffA); PG8_STAGE(PG8_SB(0, 1), cB + hstep, voffB); PG8_STAGE(PG8_SA(0, 1), cA + hstep, voffA);
    if (wr == 1) PG8_BAR;
    PG8_WAIT_V(4); PG8_BAR;
    PG8_STAGE(PG8_SB(1, 0), cB + kstep, voffB); PG8_STAGE(PG8_SA(1, 0), cA + kstep, voffA); PG8_STAGE(PG8_SB(1, 1), cB + hstep + kstep, voffB);
    PG8_WAIT_V(6); PG8_BAR;
    PG8_STAMP();
    for (;;) {
        const bool has_next = S.next(ui + 1, nxt);
        const char* nA = has_next ? (const char*)g.A + (size_t)nxt.pm * tstep : cA; const char* nB = has_next ? (const char*)g.Bt + (size_t)nxt.pn * tstep : cB;
        for (int t = 0; t < nt; t += 2) {
            const bool last = (t == nt - 2);
            const char* a1 = cA + (size_t)(t + 1) * kstep;
            const char* a2 = last ? nA : cA + (size_t)(t + 2) * kstep; const char* b2 = last ? nB : cB + (size_t)(t + 2) * kstep;
            const char* a3 = a2 + kstep; const char* b3 = b2 + kstep;
            if (last && has_next) S.a_ready(nxt);
            PG8_LDB(B0, 0, 0); PG8_SCHED; PG8_LDA(At, 0, 0); PG8_STAGE(PG8_SA(1, 1), a1 + hstep, voffA);
            PG8_WAIT_L(8); PG8_BAR; PG8_WAIT_L(0); PG8_MMA(0, 0, At, B0); PG8_BAR; PG8_SCHED;
            PG8_LDB(B1, 0, 1); PG8_STAGE(PG8_SB(0, 0), b2, voffB);
            PG8_BAR; PG8_WAIT_L(0); PG8_MMA(0, 1, At, B1); PG8_BAR;
            PG8_LDA(At, 0, 1); PG8_STAGE(PG8_SA(0, 0), a2, voffA);
            PG8_BAR; PG8_WAIT_L(0); PG8_MMA(1, 0, At, B0); PG8_BAR; PG8_SCHED;
            PG8_STAGE(PG8_SB(0, 1), b2 + hstep, voffB);
            PG8_WAIT_V(6); PG8_BAR; PG8_MMA(1, 1, At, B1); PG8_BAR;
            PG8_LDB(B0, 1, 0); PG8_SCHED; PG8_LDA(At, 1, 0); PG8_STAGE(PG8_SA(0, 1), a2 + hstep, voffA);
            PG8_WAIT_L(8); PG8_BAR; PG8_WAIT_L(0); PG8_MMA(0, 0, At, B0); PG8_BAR; PG8_SCHED;
            PG8_LDB(B1, 1, 1); PG8_STAGE(PG8_SB(1, 0), b3, voffB);
            PG8_BAR; PG8_WAIT_L(0); PG8_MMA(0, 1, At, B1); PG8_BAR;
            PG8_LDA(At, 1, 1); PG8_STAGE(PG8_SA(1, 0), a3, voffA);
            PG8_BAR; PG8_WAIT_L(0); PG8_MMA(1, 0, At, B0); PG8_BAR; PG8_SCHED;
            PG8_STAGE(PG8_SB(1, 1), b3 + hstep, voffB);
            PG8_WAIT_V(6); PG8_BAR; PG8_MMA(1, 1, At, B1); PG8_BAR;
        }
        PG8_STAMP();
        if constexpr (!Epi::AFTER_DRAIN) { E(acc, cur, wr, wc, fr, fq); S.done(cur); }
        PG8_STAMP();
        if (!has_next) break;
#pragma unroll
        for (int a = 0; a < 2; ++a)
#pragma unroll
            for (int b = 0; b < 2; ++b)
#pragma unroll
                for (int m = 0; m < 4; ++m)
#pragma unroll
                    for (int n = 0; n < 2; ++n) acc[a][b][m][n] = (f32x4){0.f, 0.f, 0.f, 0.f};
        cur = nxt; cA = nA; cB = nB; ++ui;
    }
    PG8_WAIT_V(0);
    if (wr == 0) PG8_BAR;
    PG8_BAR;
    if constexpr (Epi::AFTER_DRAIN) { E.fused(acc, cur, wr, wc, fr, fq, lds, wid, lane); S.done(cur); }
    PG8_STAMP();
    if (STAMP && wid == 0) { stamps[lane] = lane < nts ? (((unsigned long long)(unsigned)ts_hi << 32) | (unsigned)ts_lo) : 0ull;
        if (lane == 62) stamps[62] = rt_entry; if (lane == 63) stamps[63] = (unsigned long long)wall_clock64(); }
#undef PG8_STAMP
#undef PG8_SA
#undef PG8_SB
#undef PG8_STAGE
#undef PG8_LDA
#undef PG8_LDB
#undef PG8_MMA
#undef PG8_WAIT_V
#undef PG8_WAIT_L
#undef PG8_BAR
#undef PG8_SCHED
}
}


#include <hip/hip_cooperative_groups.h>
#include <cstdio>
namespace cg = cooperative_groups;
#define LAS __attribute__((address_space(3)))
typedef unsigned short bf16_t;
typedef short bf16x8 __attribute__((ext_vector_type(8)));
typedef short s16x4 __attribute__((ext_vector_type(4)));
typedef float f32x4 __attribute__((ext_vector_type(4)));
typedef float f32x2 __attribute__((ext_vector_type(2)));
typedef float f32x16 __attribute__((ext_vector_type(16)));
typedef unsigned u32x4 __attribute__((ext_vector_type(4)));
typedef unsigned u32x2 __attribute__((ext_vector_type(2)));

#ifndef N_LAUNCH_MODE
#define N_LAUNCH_MODE 0
#endif

constexpr int T_ = 32768, DM = 1024, NBAT = 8, SEQ = 4096;
constexpr float EPS = 1e-6f;
constexpr int NPHASE = 22;
constexpr size_t LDS_BYTES = 163840;

constexpr size_t al256(size_t x) { return (x + 255) / 256 * 256; }
constexpr size_t WS_WINE  = 0;
constexpr size_t WS_WUP   = WS_WINE  + al256((size_t)2 * 2560 * 1024 * 2);
constexpr size_t WS_WOUTE = WS_WUP   + al256((size_t)2 * 1792 * 384 * 2);
constexpr size_t WS_WINO  = WS_WOUTE + al256((size_t)2 * 1024 * 1024 * 2);
constexpr size_t WS_WOUTO = WS_WINO  + al256((size_t)2 * 6144 * 1024 * 2);
constexpr size_t WS_WS    = WS_WOUTO + al256((size_t)2 * 1024 * 2048 * 2);
constexpr size_t WS_MOD   = WS_WS    + al256((size_t)2 * 8 * 128 * 128 * 2);
constexpr size_t WS_ROPE  = WS_MOD   + al256((size_t)4 * 8 * 3072 * 4);
constexpr size_t WS_RS    = WS_ROPE  + al256((size_t)T_ * 32 * 8);
constexpr size_t WS_EV    = WS_RS    + al256((size_t)T_ * 2 * 4);
constexpr size_t WS_PART  = WS_EV    + al256((size_t)4096 * 64 * 4);
constexpr size_t WS_H     = WS_PART  + al256((size_t)T_ * 32 * 8);
constexpr size_t WS_R2    = WS_H     + al256((size_t)T_ * 1024 * 2);
constexpr size_t WS_GQ    = WS_R2;
constexpr size_t WS_GK    = WS_GQ   + (size_t)T_ * 256 * 2;
constexpr size_t WS_GV    = WS_GK   + (size_t)T_ * 256 * 2;
constexpr size_t WS_GZ    = WS_GV   + (size_t)T_ * 512 * 2;
constexpr size_t WS_MZ    = WS_GZ   + (size_t)T_ * 512 * 2;
constexpr size_t WS_CQKV  = WS_MZ   + (size_t)T_ * 512 * 2;
constexpr size_t WS_KR    = WS_CQKV + (size_t)T_ * 384 * 2;
constexpr size_t WS_GA    = WS_KR   + (size_t)T_ * 64 * 2;
constexpr size_t WS_Q     = WS_GA   + (size_t)T_ * 32 * 4;
constexpr size_t WS_K     = WS_Q    + (size_t)T_ * 4 * 192 * 2;
constexpr size_t WS_V     = WS_K    + (size_t)T_ * 4 * 192 * 2;
constexpr size_t WS_ST    = WS_V    + (size_t)T_ * 4 * 128 * 2;
constexpr size_t WS_EVEN_END = WS_ST + (size_t)4096 * 8192 * 2;
constexpr size_t WS_YE    = WS_Q;
constexpr size_t WS_UZ    = WS_R2;
constexpr size_t WS_V2    = WS_UZ   + (size_t)T_ * 2048 * 2;
constexpr size_t WS_YO    = WS_V2;
constexpr size_t WS_ODD_END = WS_V2 + (size_t)T_ * 2048 * 2;
constexpr size_t WS_TOTAL = WS_EVEN_END > WS_ODD_END ? WS_EVEN_END : WS_ODD_END;
static_assert(WS_Q + (size_t)T_ * 1024 * 4 == WS_ST, "Y_even must cover exactly Q|K|V");

constexpr size_t WUP_E = 768 * 256 + 1024 * 128, WUP_KV = 768 * 256;
constexpr size_t WS_CQ = WS_CQKV, WS_CKV = WS_CQKV + (size_t)T_ * 256 * 2;
struct Params { const float* in[24]; float* out; unsigned char* ws; int ph_lo, ph_hi; };
enum { I_X = 0, I_C, I_POS, I_WMOD, I_BMOD, I_GPRE, I_GPOST, I_WINE, I_W2F, I_B2F, I_W2B, I_B2B, I_GNORM, I_GQ, I_WUQ, I_GKV, I_WUKV, I_WOUTE,
       I_WINO, I_SGG, I_SGB, I_SGW, I_SGBS, I_WOUTO };

typedef __bf16 bf16v2 __attribute__((ext_vector_type(2)));
__device__ __forceinline__ unsigned cvtpk(float lo, float hi) { const f32x2 v = {lo, hi}; return __builtin_bit_cast(unsigned, __builtin_convertvector(v, bf16v2)); }
__device__ __forceinline__ float bflo(unsigned w) { return __uint_as_float(w << 16); }
__device__ __forceinline__ float bfhi(unsigned w) { return __uint_as_float(w & 0xffff0000u); }
__device__ __forceinline__ float bf2f(unsigned short b) { return __uint_as_float(((unsigned)b) << 16); }
__device__ __forceinline__ int tid_fresh() { int t = threadIdx.x; asm volatile("" : "+v"(t)); return t; }
__device__ __forceinline__ float wave_sum(float v) {
#pragma unroll
    for (int o = 32; o >= 1; o >>= 1) v += __shfl_xor(v, o);
    return v; }
__device__ __forceinline__ float silu_f(float z) { return z * __builtin_amdgcn_rcpf(1.0f + __expf(-z)); }
__device__ __forceinline__ float logsig_f(float x) { return fminf(x, 0.f) - __logf(1.0f + __expf(-fabsf(x))); }
__device__ __forceinline__ void unpack8(const u32x4 w, float (&f)[8]) {
    f[0] = bflo(w.x); f[1] = bfhi(w.x); f[2] = bflo(w.y); f[3] = bfhi(w.y); f[4] = bflo(w.z); f[5] = bfhi(w.z); f[6] = bflo(w.w); f[7] = bfhi(w.w); }
__device__ __forceinline__ u32x4 pack8(const float (&f)[8]) { u32x4 w; w.x = cvtpk(f[0], f[1]); w.y = cvtpk(f[2], f[3]); w.z = cvtpk(f[4], f[5]); w.w = cvtpk(f[6], f[7]); return w; }
#define MFMA16(a, b, c) __builtin_amdgcn_mfma_f32_16x16x32_bf16((a), (b), (c), 0, 0, 0)

__device__ __forceinline__ int map_even_col(int n) {
    if (n < 1024) return n;
    if (n < 1536) return n - 1024 + 1056;
    if (n < 2048) return n - 1536 + 2016;
    if (n < 2304) return n - 2048 + 1568;
    if (n < 2432) return n - 2304 + 1824;
    if (n < 2496) return n - 2432 + 1952;
    if (n < 2528) return n - 2496 + 1024;
    return -1; }
__device__ __forceinline__ int map_q_col(int n) {
    const int hh = n / 192, j = n - hh * 192;
    if (j < 128) return n;
    const int jj = j - 128, g8 = jj >> 3, w = jj & 7;
    return hh * 192 + 128 + ((w < 4) ? (4 * g8 + w) : (32 + 4 * g8 + (w - 4))); }
__device__ __forceinline__ int map_odd_col(int n) {
    const int pn = n >> 8;
    if (pn < 16) { const int half = (n >> 7) & 1, idx = n & 127; return (half ? 4096 : 0) + 128 * pn + idx; }
    return 2048 + (n - 4096); }

template <int MAT> __device__ __forceinline__ float prep_val(const Params& p, int e, int n, int k) {
    if (MAT == 0) { const int sc = map_even_col(n); return sc < 0 ? 0.f : p.in[I_WINE][((size_t)e * 1024 + k) * 2528 + sc]; }
    if (MAT == 1) return p.in[I_GQ][e * 256 + k] * p.in[I_WUQ][((size_t)e * 256 + k) * 768 + map_q_col(n)];
    if (MAT == 5) return p.in[I_GKV][e * 128 + k] * p.in[I_WUKV][((size_t)e * 128 + k) * 1024 + n];
    if (MAT == 2) return p.in[I_WOUTE][((size_t)e * 1024 + k) * 1024 + n];
    if (MAT == 3) return p.in[I_WINO][((size_t)e * 1024 + k) * 6144 + map_odd_col(n)];
    return p.in[I_WOUTO][((size_t)e * 2048 + k) * 1024 + n];
}
template <int MAT> __device__ __forceinline__ f32x4 prep_val4(const Params& p, int e, int n, int k) {
    const f32x4 z = {0.f, 0.f, 0.f, 0.f};
    if (MAT == 0) { const int sc = map_even_col(n); return sc < 0 ? z : *(const f32x4*)(p.in[I_WINE] + ((size_t)e * 1024 + k) * 2528 + sc); }
    if (MAT == 1) return *(const f32x4*)(p.in[I_WUQ] + ((size_t)e * 256 + k) * 768 + map_q_col(n)) * p.in[I_GQ][e * 256 + k];
    if (MAT == 5) return *(const f32x4*)(p.in[I_WUKV] + ((size_t)e * 128 + k) * 1024 + n) * p.in[I_GKV][e * 128 + k];
    if (MAT == 2) return *(const f32x4*)(p.in[I_WOUTE] + ((size_t)e * 1024 + k) * 1024 + n);
    if (MAT == 3) return *(const f32x4*)(p.in[I_WINO] + ((size_t)e * 1024 + k) * 6144 + map_odd_col(n));
    return *(const f32x4*)(p.in[I_WOUTO] + ((size_t)e * 2048 + k) * 1024 + n);
}
template <int MAT> __device__ __forceinline__ void prep_tile(const Params& p, LAS float* tl, bf16_t* dst, int K, int e, int n0, int k0) {
    const int tid = tid_fresh(), n4 = (tid & 15) * 4, kk = tid >> 4;
#pragma unroll
    for (int r = 0; r < 2; ++r) { const int k = kk + 32 * r; const f32x4 v = prep_val4<MAT>(p, e, n0 + n4, k0 + k);
        tl[k * 65 + n4] = v[0]; tl[k * 65 + n4 + 1] = v[1]; tl[k * 65 + n4 + 2] = v[2]; tl[k * 65 + n4 + 3] = v[3]; }
    __syncthreads();
    const int nl2 = tid >> 3, kg = tid & 7; float v[8];
#pragma unroll
    for (int q = 0; q < 8; ++q) v[q] = tl[(8 * kg + q) * 65 + nl2];
    *(u32x4*)(dst + (size_t)(n0 + nl2) * K + k0 + 8 * kg) = pack8(v);
    __syncthreads();
}

__device__ __forceinline__ void p0_phase(const Params& p, LAS unsigned char* lds) {
    const int tid = tid_fresh();
    unsigned char* ws = p.ws;
    constexpr int N_MOD = 192, N_ROPE = 256, N_WS = 64;
    constexpr int T0 = N_MOD + N_ROPE + N_WS;
    constexpr int T1 = T0 + 2 * 40 * 16;
    constexpr int T2 = T1 + 2 * 12 * 4 + 2 * 16 * 2;
    constexpr int T3 = T2 + 2 * 16 * 16;
    constexpr int T4 = T3 + 2 * 96 * 16;
    constexpr int T5 = T4 + 2 * 16 * 32;
    LAS float* tl = (LAS float*)lds;
    for (int it = blockIdx.x; it < T5; it += gridDim.x) {
        if (it < N_MOD) {
            const int l = it / 48, jc = it % 48;
            LAS float* sc = (LAS float*)lds;
            LAS float* red = (LAS float*)(lds + 32768);
            for (int i = tid; i < 8192; i += 512) { const float cv = p.in[I_C][i]; sc[i] = silu_f(cv); }
            __syncthreads();
            const int cgp = tid & 15, kg = tid >> 4;
            float acc[8][4];
#pragma unroll
            for (int b = 0; b < 8; ++b)
#pragma unroll
                for (int c = 0; c < 4; ++c) acc[b][c] = 0.f;
            const float* wp = p.in[I_WMOD] + ((size_t)l * 1024 + 32 * kg) * 3072 + 64 * jc + 4 * cgp;
#pragma unroll 4
            for (int kk = 0; kk < 32; ++kk) {
                const f32x4 w = *(const f32x4*)(wp + (size_t)kk * 3072);
#pragma unroll
                for (int b = 0; b < 8; ++b) { const float s = sc[b * 1024 + 32 * kg + kk];
#pragma unroll
                    for (int c = 0; c < 4; ++c) acc[b][c] += s * w[c]; } }
#pragma unroll
            for (int b = 0; b < 8; ++b)
#pragma unroll
                for (int c = 0; c < 4; ++c) red[(kg * 8 + b) * 64 + 4 * cgp + c] = acc[b][c];
            __syncthreads();
            { const int b = tid >> 6, col = tid & 63; float s = p.in[I_BMOD][l * 3072 + 64 * jc + col];
              for (int q = 0; q < 32; ++q) s += red[(q * 8 + b) * 64 + col];
              ((float*)(ws + WS_MOD))[((size_t)l * 8 + b) * 3072 + 64 * jc + col] = s; }
            __syncthreads();
        } else if (it < N_MOD + N_ROPE) {
            const int r0 = (it - N_MOD) * 4096;
            for (int i = tid; i < 4096; i += 512) { const int idx = r0 + i, row = idx >> 5, fi = idx & 31;
                const float pos = (float)((const int*)p.in[I_POS])[row];
                const float inv = 1.0f / powf(10000.0f, (float)(2 * fi) * (1.0f / 64.0f));
                const float ang = pos * inv; f32x2 cs; cs.x = cosf(ang); cs.y = sinf(ang);
                ((f32x2*)(ws + WS_ROPE))[idx] = cs; }
        } else if (it < T0) {
            const int r0 = (it - N_MOD - N_ROPE) * 4096;
            for (int i = tid; i < 2048; i += 512) { const int idx = r0 + 2 * i; const f32x2 v = *(const f32x2*)(p.in[I_SGW] + idx);
                ((unsigned*)(ws + WS_WS))[idx >> 1] = cvtpk(v.x, v.y); }
        } else if (it < T1) { const int q = it - T0, e = q / 640, r = q % 640, nt = r / 16, kt = r % 16;
            prep_tile<0>(p, tl, (bf16_t*)(ws + WS_WINE) + (size_t)e * 2560 * 1024, 1024, e, nt * 64, kt * 64);
        } else if (it < T2) { const int q = it - T1;
            if (q < 96) { const int e = q / 48, r = q % 48, nt = r / 4, kt = r % 4;
                prep_tile<1>(p, tl, (bf16_t*)(ws + WS_WUP) + (size_t)e * WUP_E, 256, e, nt * 64, kt * 64); }
            else { const int q2 = q - 96, e = q2 / 32, r = q2 % 32, nt = r / 2, kt = r % 2;
                prep_tile<5>(p, tl, (bf16_t*)(ws + WS_WUP) + (size_t)e * WUP_E + WUP_KV, 128, e, nt * 64, kt * 64); }
        } else if (it < T3) { const int q = it - T2, e = q / 256, r = q % 256, nt = r / 16, kt = r % 16;
            prep_tile<2>(p, tl, (bf16_t*)(ws + WS_WOUTE) + (size_t)e * 1024 * 1024, 1024, e, nt * 64, kt * 64);
        } else if (it < T4) { const int q = it - T3, e = q / 1536, r = q % 1536, nt = r / 16, kt = r % 16;
            prep_tile<3>(p, tl, (bf16_t*)(ws + WS_WINO) + (size_t)e * 6144 * 1024, 1024, e, nt * 64, kt * 64);
        } else { const int q = it - T4, e = q / 512, r = q % 512, nt = r / 32, kt = r % 32;
            prep_tile<4>(p, tl, (bf16_t*)(ws + WS_WOUTO) + (size_t)e * 1024 * 2048, 2048, e, nt * 64, kt * 64);
        }
    }
}

__device__ __forceinline__ void norm_phase(const Params& p, int l_post, int l_pre, const bf16_t* y, const float* xin) {
    const int tid = tid_fresh(), lane = tid & 63, wave = tid >> 6;
    const float* mod = (const float*)(p.ws + WS_MOD);
    bf16_t* H = (bf16_t*)(p.ws + WS_H);
    for (int row = blockIdx.x * 8 + wave; row < T_; row += gridDim.x * 8) {
        const int b = row >> 12;
        f32x4 xv[4];
#pragma unroll
        for (int i = 0; i < 4; ++i) xv[i] = *(const f32x4*)(xin + (size_t)row * 1024 + 256 * i + 4 * lane);
        if (l_post >= 0) {
            f32x4 yv[4]; float ss = 0.f;
#pragma unroll
            for (int i = 0; i < 4; ++i) { const u32x2 yw = *(const u32x2*)(y + (size_t)row * 1024 + 256 * i + 4 * lane); yv[i] = (f32x4){bflo(yw.x), bfhi(yw.x), bflo(yw.y), bfhi(yw.y)}; ss += yv[i][0] * yv[i][0] + yv[i][1] * yv[i][1] + yv[i][2] * yv[i][2] + yv[i][3] * yv[i][3]; }
            ss = wave_sum(ss); const float rs = rsqrtf(ss * (1.0f / 1024.0f) + EPS);
            const float* gate = mod + ((size_t)l_post * 8 + b) * 3072 + 2048; const float* gp = p.in[I_GPOST] + l_post * 1024;
#pragma unroll
            for (int i = 0; i < 4; ++i) { const f32x4 g = *(const f32x4*)(gate + 256 * i + 4 * lane), w = *(const f32x4*)(gp + 256 * i + 4 * lane);
                xv[i] = xv[i] + g * (yv[i] * rs * w);
#ifdef DEBUG_SANITIZE
                if (l_post == 3) { for (int q = 0; q < 4; ++q) if (!(fabsf(xv[i][q]) < 1e30f)) xv[i][q] = 12345.f; }
#endif
                *(f32x4*)(p.out + (size_t)row * 1024 + 256 * i + 4 * lane) = xv[i]; }
        }
        if (l_pre >= 0) {
            float ss = 0.f;
#pragma unroll
            for (int i = 0; i < 4; ++i) ss += xv[i][0] * xv[i][0] + xv[i][1] * xv[i][1] + xv[i][2] * xv[i][2] + xv[i][3] * xv[i][3];
            ss = wave_sum(ss); const float rs = rsqrtf(ss * (1.0f / 1024.0f) + EPS);
            const float* sh = mod + ((size_t)l_pre * 8 + b) * 3072; const float* sc = sh + 1024; const float* gp = p.in[I_GPRE] + l_pre * 1024;
#pragma unroll
            for (int i = 0; i < 4; ++i) { const f32x4 s0 = *(const f32x4*)(sh + 256 * i + 4 * lane), s1 = *(const f32x4*)(sc + 256 * i + 4 * lane), w = *(const f32x4*)(gp + 256 * i + 4 * lane);
                const f32x4 hv = (xv[i] * rs * w) * (s1 + 1.0f) + s0; u32x2 o; o.x = cvtpk(hv[0], hv[1]); o.y = cvtpk(hv[2], hv[3]);
                *(u32x2*)(H + (size_t)row * 1024 + 256 * i + 4 * lane) = o; }
        }
    }
}

#define XB_TMO      128
#define XB_XCNT(j)  (256  + 64 * (j))
#define XB_XSUB(j)  (1280 + 64 * (j))
#define XB_XGEN(j)  (2304 + 64 * (j))
#define XB_TOP      3328
#define XB_TOPGEN   3392
#define XCD_BAR_WORDS 3456
#define XB_SPIN_CAP (1u << 18)

__device__ __forceinline__ unsigned xb_ld(unsigned* p)              { return __hip_atomic_load(p, __ATOMIC_RELAXED, __HIP_MEMORY_SCOPE_AGENT); }
__device__ __forceinline__ unsigned xb_add(unsigned* p, unsigned v) { return __hip_atomic_fetch_add(p, v, __ATOMIC_RELAXED, __HIP_MEMORY_SCOPE_AGENT); }
__device__ __forceinline__ unsigned xb_xcc_id() { return (unsigned)__builtin_amdgcn_s_getreg((3 << 11) | 20) & 0xFu; }
#define XB_SPIN(cond, bar) do { unsigned _sp = 0; while (cond) { __builtin_amdgcn_s_sleep(1); \
    if ((++_sp & 255u) == 0u) { if (xb_ld(&(bar)[XB_TMO])) break; if (_sp > XB_SPIN_CAP) { atomicAdd(&(bar)[XB_TMO], 1u); break; } } } } while (0)

struct XcdBarrier {
    unsigned* bar; unsigned x;
    volatile LAS unsigned* st;
};

__device__ __forceinline__ XcdBarrier xcd_barrier_post(unsigned* bar, volatile LAS unsigned* st) {
    XcdBarrier b; b.bar = bar; b.x = xb_xcc_id(); b.st = st;
    if (threadIdx.x == 0) (void)xb_add(&bar[XB_XCNT(b.x)], 1u);
    return b;
}
__device__ __forceinline__ void xcd_barrier_complete(unsigned* bar, unsigned x, unsigned& nloc, unsigned& nx) {
    const unsigned G = gridDim.x * gridDim.y * gridDim.z;
    unsigned sum, cnt, mine, sp = 0u;
    for (;;) {
        sum = 0u; cnt = 0u; mine = 0u;
#pragma unroll
        for (unsigned j = 0; j < 16; ++j) { const unsigned c = xb_ld(&bar[XB_XCNT(j)]); sum += c; cnt += (c > 0u) ? 1u : 0u; mine = (j == x) ? c : mine; }
        if (sum == G) break;
        __builtin_amdgcn_s_sleep(1);
        if ((++sp & 255u) == 0u) { if (xb_ld(&bar[XB_TMO])) break; if (sp > XB_SPIN_CAP) { atomicAdd(&bar[XB_TMO], 1u); break; } }
    }
    nloc = mine > 0u ? mine : 1u; nx = cnt > 0u ? cnt : 1u;
}

__device__ __forceinline__ void xcd_barrier(const XcdBarrier& b) {
    asm volatile("s_waitcnt vmcnt(0)" ::: "memory");
    __syncthreads();
    if (threadIdx.x == 0) {
        unsigned* bar = b.bar;
        __builtin_amdgcn_s_waitcnt(0);
        unsigned nloc = b.st[0], nx = b.st[1];
        if (nloc == 0u) { xcd_barrier_complete(bar, b.x, nloc, nx); b.st[0] = nloc; b.st[1] = nx; }
        const unsigned old = xb_add(&bar[XB_XSUB(b.x)], 1u);
        const unsigned gen = old / nloc;
        if (old + 1u == (gen + 1u) * nloc) {
            __builtin_amdgcn_fence(__ATOMIC_RELEASE, "agent");
            asm volatile("s_waitcnt vmcnt(0)" ::: "memory");
            const unsigned og = xb_add(&bar[XB_TOP], 1u);
            const unsigned tg = og / nx;
            if (og + 1u == (tg + 1u) * nx) xb_add(&bar[XB_TOPGEN], 1u);
            else XB_SPIN(xb_ld(&bar[XB_TOPGEN]) == tg, bar);
            __builtin_amdgcn_fence(__ATOMIC_ACQUIRE, "agent");
            xb_add(&bar[XB_XGEN(b.x)], 1u);
            asm volatile("s_waitcnt vmcnt(0)" ::: "memory");
        } else {
            XB_SPIN(xb_ld(&bar[XB_XGEN(b.x)]) == gen, bar);
            __builtin_amdgcn_fence(__ATOMIC_ACQUIRE, "agent");
            asm volatile("s_waitcnt vmcnt(0)" ::: "memory");
        }
    }
    __syncthreads();
}


struct EpiEvenIn {
    static constexpr bool PERM = true, AFTER_DRAIN = false;
    unsigned char* ws;
    __device__ __forceinline__ void operator()(const f32x4 (&acc)[2][2][4][2], const pg8::Unit& u, int wr, int wc, int fr_, int fq_) const {
        int fr = fr_, fq = fq_; asm volatile("" : "+v"(fr), "+v"(fq));
        const int row0 = u.pm * 256 + wr * 64 + fr, pn = u.pn, cu = 32 * wc + 8 * fq;
        if (pn < 9) {
            bf16_t* base; int ld;
            if (pn == 0) { base = (bf16_t*)(ws + WS_GQ); ld = 256; }
            else if (pn == 1) { base = (bf16_t*)(ws + WS_GK); ld = 256; }
            else if (pn < 4) { base = (bf16_t*)(ws + WS_GV) + (pn - 2) * 256; ld = 512; }
            else if (pn < 6) { base = (bf16_t*)(ws + WS_GZ) + (pn - 4) * 256; ld = 512; }
            else if (pn < 8) { base = (bf16_t*)(ws + WS_MZ) + (pn - 6) * 256; ld = 512; }
            else { base = (bf16_t*)(ws + WS_CQ); ld = 256; }
#pragma unroll
            for (int ai = 0; ai < 2; ++ai)
#pragma unroll
                for (int m = 0; m < 4; ++m) { bf16_t* rowp = base + (size_t)(row0 + ai * 128 + m * 16) * ld + cu;
#pragma unroll
                    for (int bj = 0; bj < 2; ++bj) { const f32x4 v0 = acc[ai][bj][m][0], v1 = acc[ai][bj][m][1];
                        u32x4 w; w.x = cvtpk(v0[0], v0[1]); w.y = cvtpk(v0[2], v0[3]); w.z = cvtpk(v1[0], v1[1]); w.w = cvtpk(v1[2], v1[3]);
                        *(u32x4*)(rowp + bj * 128) = w; } }
        } else {
            bf16_t* ckv = (bf16_t*)(ws + WS_CKV); bf16_t* kr = (bf16_t*)(ws + WS_KR); float* ga = (float*)(ws + WS_GA);
#pragma unroll
            for (int ai = 0; ai < 2; ++ai)
#pragma unroll
                for (int m = 0; m < 4; ++m) { const size_t row = (size_t)(row0 + ai * 128 + m * 16);
                    { const f32x4 v0 = acc[ai][0][m][0], v1 = acc[ai][0][m][1];
                      u32x4 w; w.x = cvtpk(v0[0], v0[1]); w.y = cvtpk(v0[2], v0[3]); w.z = cvtpk(v1[0], v1[1]); w.w = cvtpk(v1[2], v1[3]);
                      *(u32x4*)(ckv + row * 128 + cu) = w; }
                    { const f32x4 v0 = acc[ai][1][m][0], v1 = acc[ai][1][m][1];
                      if (wc < 2) { u32x4 w; w.x = cvtpk(v0[0], v0[1]); w.y = cvtpk(v0[2], v0[3]); w.z = cvtpk(v1[0], v1[1]); w.w = cvtpk(v1[2], v1[3]);
                          *(u32x4*)(kr + row * 64 + cu) = w; }
                      else if (wc == 2) { *(f32x4*)(ga + row * 32 + 8 * fq) = v0; *(f32x4*)(ga + row * 32 + 8 * fq + 4) = v1; } } }
        }
    }
};
struct EpiY {
    static constexpr bool PERM = true, AFTER_DRAIN = false;
    bf16_t* Y;
    __device__ __forceinline__ void operator()(const f32x4 (&acc)[2][2][4][2], const pg8::Unit& u, int wr, int wc, int fr_, int fq_) const {
        int fr = fr_, fq = fq_; asm volatile("" : "+v"(fr), "+v"(fq));
        const int row0 = u.pm * 256 + wr * 64 + fr, col0 = u.pn * 256 + 32 * wc + 8 * fq;
#pragma unroll
        for (int ai = 0; ai < 2; ++ai)
#pragma unroll
            for (int m = 0; m < 4; ++m) { bf16_t* rowp = Y + (size_t)(row0 + ai * 128 + m * 16) * 1024 + col0;
#pragma unroll
                for (int bj = 0; bj < 2; ++bj) { const f32x4 v0 = acc[ai][bj][m][0], v1 = acc[ai][bj][m][1];
                    u32x4 w; w.x = cvtpk(v0[0], v0[1]); w.y = cvtpk(v0[2], v0[3]); w.z = cvtpk(v1[0], v1[1]); w.w = cvtpk(v1[2], v1[3]);
                    *(u32x4*)(rowp + bj * 128) = w; } }
    }
};
template <bool KV> struct EpiUp {
    static constexpr bool PERM = true, AFTER_DRAIN = false;
    unsigned char* ws;
    __device__ __forceinline__ void operator()(const f32x4 (&acc)[2][2][4][2], const pg8::Unit& u, int wr, int wc, int fr_, int fq_) const {
        int fr = fr_, fq = fq_; asm volatile("" : "+v"(fr), "+v"(fq));
        const int row0 = u.pm * 256 + wr * 64 + fr, pn = u.pn;
        bf16_t* Q = (bf16_t*)(ws + WS_Q); bf16_t* K = (bf16_t*)(ws + WS_K); bf16_t* V = (bf16_t*)(ws + WS_V);
        const float* RS = (const float*)(ws + WS_RS); const f32x2* ROPE = (const f32x2*)(ws + WS_ROPE);
#pragma unroll
        for (int ai = 0; ai < 2; ++ai)
#pragma unroll
            for (int m = 0; m < 4; ++m) { const int row = row0 + ai * 128 + m * 16, b = row >> 12, s = row & 4095;
                const f32x2 rs = *(const f32x2*)(RS + 2 * (size_t)row);
#pragma unroll
                for (int bj = 0; bj < 2; ++bj) { f32x4 v0 = acc[ai][bj][m][0], v1 = acc[ai][bj][m][1];
                    if (!KV) {
                        v0 = v0 * rs.x; v1 = v1 * rs.x;
                        const int n = 256 * pn + 128 * bj + 32 * wc + 8 * fq, hh = n / 192, j = n - hh * 192;
                        bf16_t* qrow = Q + ((size_t)(b * 4 + hh) * 4096 + s) * 192;
                        if (j < 128) { u32x4 w; w.x = cvtpk(v0[0], v0[1]); w.y = cvtpk(v0[2], v0[3]); w.z = cvtpk(v1[0], v1[1]); w.w = cvtpk(v1[2], v1[3]);
                            *(u32x4*)(qrow + j) = w; }
                        else { const int i0 = (j - 128) >> 1;
                            const f32x4 c01 = *(const f32x4*)(ROPE + (size_t)row * 32 + i0), c23 = *(const f32x4*)(ROPE + (size_t)row * 32 + i0 + 2);
                            const float cs[4] = {c01[0], c01[2], c23[0], c23[2]}, sn[4] = {c01[1], c01[3], c23[1], c23[3]};
                            float o1[4], o2[4];
#pragma unroll
                            for (int q = 0; q < 4; ++q) { o1[q] = v0[q] * cs[q] - v1[q] * sn[q]; o2[q] = v1[q] * cs[q] + v0[q] * sn[q]; }
                            u32x2 w1, w2; w1.x = cvtpk(o1[0], o1[1]); w1.y = cvtpk(o1[2], o1[3]); w2.x = cvtpk(o2[0], o2[1]); w2.y = cvtpk(o2[2], o2[3]);
                            *(u32x2*)(qrow + 128 + i0) = w1; *(u32x2*)(qrow + 160 + i0) = w2; }
                    } else {
                        v0 = v0 * rs.y; v1 = v1 * rs.y; const int hh = pn, jj = 32 * wc + 8 * fq;
                        u32x4 w; w.x = cvtpk(v0[0], v0[1]); w.y = cvtpk(v0[2], v0[3]); w.z = cvtpk(v1[0], v1[1]); w.w = cvtpk(v1[2], v1[3]);
                        if (bj == 0) *(u32x4*)(K + ((size_t)(b * 4 + hh) * 4096 + s) * 192 + jj) = w;
                        else         *(u32x4*)(V + ((size_t)(b * 4 + hh) * 4096 + s) * 128 + jj) = w;
                    } }
                asm volatile("" ::: "memory"); }
    }
};
struct EpiOddIn {
    static constexpr bool PERM = true, AFTER_DRAIN = false;
    unsigned char* ws;
    __device__ __forceinline__ void operator()(const f32x4 (&acc)[2][2][4][2], const pg8::Unit& u, int wr, int wc, int fr_, int fq_) const {
        int fr = fr_, fq = fq_; asm volatile("" : "+v"(fr), "+v"(fq));
        const int row0 = u.pm * 256 + wr * 64 + fr, pn = u.pn, cu = 32 * wc + 8 * fq;
        typedef float f2 __attribute__((ext_vector_type(2)));
        if (pn < 16) {
            bf16_t* UZ = (bf16_t*)(ws + WS_UZ);
#pragma unroll
            for (int ai = 0; ai < 2; ++ai)
#pragma unroll
                for (int m = 0; m < 4; ++m) { const size_t row = (size_t)(row0 + ai * 128 + m * 16); float o[8];
#pragma unroll
                    for (int n = 0; n < 2; ++n) { const f32x4 uu = acc[ai][0][m][n], zz = acc[ai][1][m][n];
                        const f2 ga = pg8::gelu_pk((f2){uu[0], uu[1]}), gb = pg8::gelu_pk((f2){uu[2], uu[3]});
                        o[4 * n + 0] = ga.x * silu_f(zz[0]); o[4 * n + 1] = ga.y * silu_f(zz[1]); o[4 * n + 2] = gb.x * silu_f(zz[2]); o[4 * n + 3] = gb.y * silu_f(zz[3]); }
                    *(u32x4*)(UZ + row * 2048 + 128 * pn + cu) = pack8(o); }
        } else {
            bf16_t* V2 = (bf16_t*)(ws + WS_V2); f32x2* PART = (f32x2*)(ws + WS_PART);
#pragma unroll
            for (int ai = 0; ai < 2; ++ai)
#pragma unroll
                for (int m = 0; m < 4; ++m) { const size_t row = (size_t)(row0 + ai * 128 + m * 16); float s = 0.f, ss = 0.f;
#pragma unroll
                    for (int bj = 0; bj < 2; ++bj) { float o[8];
#pragma unroll
                        for (int n = 0; n < 2; ++n) { const f32x4 vv = acc[ai][bj][m][n];
                            const f2 ga = pg8::gelu_pk((f2){vv[0], vv[1]}), gb = pg8::gelu_pk((f2){vv[2], vv[3]});
                            o[4 * n + 0] = ga.x; o[4 * n + 1] = ga.y; o[4 * n + 2] = gb.x; o[4 * n + 3] = gb.y; }
#pragma unroll
                        for (int q = 0; q < 8; ++q) { s += o[q]; ss += o[q] * o[q]; }
                        *(u32x4*)(V2 + row * 2048 + 256 * (pn - 16) + 128 * bj + cu) = pack8(o); }
                    s += __shfl_xor(s, 16); ss += __shfl_xor(ss, 16); s += __shfl_xor(s, 32); ss += __shfl_xor(ss, 32);
                    if (fq == 0) PART[row * 32 + (pn - 16) * 4 + wc] = (f32x2){s, ss}; }
        }
    }
};

__device__ __forceinline__ void rs_rope_phase(const Params& p) {
    const int tid = tid_fresh(), lane = tid & 63, wave = tid >> 6, sub = lane & 7, rg = lane >> 3;
    unsigned char* ws = p.ws;
    const bf16_t* CQ = (const bf16_t*)(ws + WS_CQ); const bf16_t* CKV = (const bf16_t*)(ws + WS_CKV); const bf16_t* KR = (const bf16_t*)(ws + WS_KR);
    float* RS = (float*)(ws + WS_RS); const f32x2* ROPE = (const f32x2*)(ws + WS_ROPE); bf16_t* K = (bf16_t*)(ws + WS_K);
    for (int row0 = (blockIdx.x * 8 + wave) * 8; row0 < T_; row0 += gridDim.x * 64) {
        const int row = row0 + rg, b = row >> 12, s = row & 4095;
        float sq = 0.f, sk = 0.f;
#pragma unroll
        for (int q = 0; q < 4; ++q) { const u32x4 a = *(const u32x4*)(CQ + (size_t)row * 256 + sub * 32 + 8 * q); float f[8]; unpack8(a, f);
#pragma unroll
            for (int j = 0; j < 8; ++j) sq += f[j] * f[j]; }
#pragma unroll
        for (int q = 0; q < 2; ++q) { const u32x4 a = *(const u32x4*)(CKV + (size_t)row * 128 + sub * 16 + 8 * q); float f[8]; unpack8(a, f);
#pragma unroll
            for (int j = 0; j < 8; ++j) sk += f[j] * f[j]; }
        sq += __shfl_xor(sq, 1); sk += __shfl_xor(sk, 1); sq += __shfl_xor(sq, 2); sk += __shfl_xor(sk, 2); sq += __shfl_xor(sq, 4); sk += __shfl_xor(sk, 4);
        if (sub == 0) { f32x2 o; o.x = rsqrtf(sq * (1.0f / 256.0f) + EPS); o.y = rsqrtf(sk * (1.0f / 128.0f) + EPS); *(f32x2*)(RS + 2 * (size_t)row) = o; }
        const int i0 = 4 * sub;
        const u32x2 x1w = *(const u32x2*)(KR + (size_t)row * 64 + i0), x2w = *(const u32x2*)(KR + (size_t)row * 64 + 32 + i0);
        const f32x4 c01 = *(const f32x4*)(ROPE + (size_t)row * 32 + i0), c23 = *(const f32x4*)(ROPE + (size_t)row * 32 + i0 + 2);
        const float x1[4] = {bflo(x1w.x), bfhi(x1w.x), bflo(x1w.y), bfhi(x1w.y)}, x2[4] = {bflo(x2w.x), bfhi(x2w.x), bflo(x2w.y), bfhi(x2w.y)};
        const float cs[4] = {c01[0], c01[2], c23[0], c23[2]}, sn[4] = {c01[1], c01[3], c23[1], c23[3]};
        float o1[4], o2[4];
#pragma unroll
        for (int j = 0; j < 4; ++j) { o1[j] = x1[j] * cs[j] - x2[j] * sn[j]; o2[j] = x2[j] * cs[j] + x1[j] * sn[j]; }
        u32x2 w1, w2; w1.x = cvtpk(o1[0], o1[1]); w1.y = cvtpk(o1[2], o1[3]); w2.x = cvtpk(o2[0], o2[1]); w2.y = cvtpk(o2[2], o2[3]);
#pragma unroll
        for (int h = 0; h < 4; ++h) { bf16_t* kp = K + ((size_t)(b * 4 + h) * 4096 + s) * 192 + 128; *(u32x2*)(kp + i0) = w1; *(u32x2*)(kp + 32 + i0) = w2; }
    }
}

constexpr int GL_QF = 0, GL_KF = 9216, GL_QB = 18432, GL_KB = 27648, GL_VT = 36864, GL_ATT = 55296, GL_GRP = 64512, GL_W2 = 129024, GL_B2 = 137216, GL_ROW = 144;
static_assert(GL_B2 + 512 <= LDS_BYTES, "gla lds");

__device__ __forceinline__ void gla_stage_w2(const Params& p, int e, int h, LAS unsigned char* lds) {
    LAS float* W2L = (LAS float*)(lds + GL_W2); LAS float* B2L = (LAS float*)(lds + GL_B2);
    const int tid = tid_fresh();
    for (int idx = tid; idx < 2048; idx += 512) { const int dir = idx >> 10, d = (idx >> 4) & 63, r = idx & 15;
        W2L[idx] = p.in[dir ? I_W2B : I_W2F][((size_t)e * 16 + r) * 256 + h * 64 + d]; }
    if (tid < 128) { const int dir = tid >> 6, d = tid & 63; B2L[tid] = p.in[dir ? I_B2B : I_B2F][e * 256 + h * 64 + d]; }
}
__device__ __forceinline__ void gla_stage_vt(const Params& p, int b, int h, int chunk, LAS unsigned char* G, int gt) {
    const bf16_t* GV = (const bf16_t*)(p.ws + WS_GV);
    const int wv = gt >> 6, ln = gt & 63, c0 = 8 * ((ln >> 4) + 4 * wv);
#pragma unroll
    for (int i = 0; i < 2; ++i) { const int tp = (ln & 15) + 16 * i; const size_t tokA = (size_t)b * 4096 + chunk * 64 + 2 * tp;
        const u32x4 ra = *(const u32x4*)(GV + tokA * 512 + h * 128 + c0), rb = *(const u32x4*)(GV + (tokA + 1) * 512 + h * 128 + c0);
        const unsigned wa[4] = {ra.x, ra.y, ra.z, ra.w}, wb[4] = {rb.x, rb.y, rb.z, rb.w};
#pragma unroll
        for (int q = 0; q < 4; ++q) { const unsigned lo = (wa[q] & 0xffffu) | (wb[q] << 16), hi = (wa[q] >> 16) | (wb[q] & 0xffff0000u);
            *(LAS unsigned*)(G + GL_VT + (c0 + 2 * q) * GL_ROW + 4 * tp) = lo; *(LAS unsigned*)(G + GL_VT + (c0 + 2 * q + 1) * GL_ROW + 4 * tp) = hi; } }
}
__device__ __forceinline__ void gla_stage_ga(const Params& p, int b, int chunk, LAS unsigned char* G, int gt) {
    const float* ga = (const float*)(p.ws + WS_GA) + ((size_t)b * 4096 + chunk * 64) * 32;
#pragma unroll
    for (int i = 0; i < 2; ++i) { const int pc = gt + 256 * i; *(LAS f32x4*)(G + GL_ATT + (pc >> 3) * GL_ROW + (pc & 7) * 16) = *(const f32x4*)(ga + pc * 4); }
}
template <int CTRL, int ROWMASK> __device__ __forceinline__ float dpp_f(float src) {
    return __int_as_float(__builtin_amdgcn_update_dpp(0, __float_as_int(src), CTRL, ROWMASK, 0xf, false)); }
__device__ __forceinline__ float wave_incl_scan(float v) {
    v += dpp_f<0x111, 0xf>(v); v += dpp_f<0x112, 0xf>(v); v += dpp_f<0x114, 0xf>(v); v += dpp_f<0x118, 0xf>(v);
    v += dpp_f<0x142, 0xa>(v);
    v += dpp_f<0x143, 0xc>(v);
    return v; }
template <bool FOR_A>
__device__ __forceinline__ void gla_prep(const Params& p, int e, int b, int h, int chunk, LAS unsigned char* lds, LAS unsigned char* G, int wv, int lane) {
    const LAS float* W2L = (const LAS float*)(lds + GL_W2); const LAS float* B2L = (const LAS float*)(lds + GL_B2);
    const size_t tok = (size_t)b * 4096 + chunk * 64 + lane;
    float af[16], ab[16];
#pragma unroll
    for (int q = 0; q < 4; ++q) { const f32x4 x = *(const LAS f32x4*)(G + GL_ATT + lane * GL_ROW + 16 * q), y = *(const LAS f32x4*)(G + GL_ATT + lane * GL_ROW + 64 + 16 * q);
        af[4 * q] = x[0]; af[4 * q + 1] = x[1]; af[4 * q + 2] = x[2]; af[4 * q + 3] = x[3]; ab[4 * q] = y[0]; ab[4 * q + 1] = y[1]; ab[4 * q + 2] = y[2]; ab[4 * q + 3] = y[3]; }
    float pf[16], pb[16], gbv[16];
#pragma unroll
    for (int dd = 0; dd < 16; ++dd) { const int d = 16 * wv + dd; float xf = B2L[d], xb = B2L[64 + d];
#pragma unroll
        for (int q = 0; q < 4; ++q) { const f32x4 wf = *(const LAS f32x4*)(W2L + d * 16 + 4 * q), wb = *(const LAS f32x4*)(W2L + 1024 + d * 16 + 4 * q);
            xf += af[4 * q] * wf[0] + af[4 * q + 1] * wf[1] + af[4 * q + 2] * wf[2] + af[4 * q + 3] * wf[3];
            xb += ab[4 * q] * wb[0] + ab[4 * q + 1] * wb[1] + ab[4 * q + 2] * wb[2] + ab[4 * q + 3] * wb[3]; }
        pf[dd] = logsig_f(xf) * 0.0625f; gbv[dd] = logsig_f(xb) * 0.0625f; pb[dd] = gbv[dd]; }
#pragma unroll
    for (int dd = 0; dd < 16; ++dd) { pf[dd] = wave_incl_scan(pf[dd]); pb[dd] = wave_incl_scan(pb[dd]); }
#pragma unroll
    for (int dd = 0; dd < 16; ++dd) { const float tot = __int_as_float(__builtin_amdgcn_readlane(__float_as_int(pb[dd]), 63)); pb[dd] = tot - pb[dd] + gbv[dd]; }
    if (FOR_A) {
        float* EV = (float*)(p.ws + WS_EV);
#pragma unroll
        for (int dd = 0; dd < 16; ++dd) { const float tf = __int_as_float(__builtin_amdgcn_readlane(__float_as_int(pf[dd]), 63)), tb = __int_as_float(__builtin_amdgcn_readlane(__float_as_int(pb[dd]), 0));
            if (lane == 0) { EV[((size_t)((b * 4 + h) * 2 + 0) * 64 + chunk) * 64 + 16 * wv + dd] = __expf(tf); EV[((size_t)((b * 4 + h) * 2 + 1) * 64 + chunk) * 64 + 16 * wv + dd] = __expf(tb); } }
    }
#ifdef DBG_MAXP
    if (FOR_A) { float mx = 0.f;
        for (int dd = 0; dd < 16; ++dd) { mx = fmaxf(mx, DBG_MAXP); }
        atomicMax((int*)(p.ws + WS_PART) + 41, __float_as_int(mx)); }
#endif
    float kv[16], qv[16];
    { const bf16_t* kp = (const bf16_t*)(p.ws + WS_GK) + tok * 256 + h * 64 + 16 * wv; const u32x4 k0 = *(const u32x4*)kp, k1 = *(const u32x4*)(kp + 8);
      float t0[8], t1[8]; unpack8(k0, t0); unpack8(k1, t1);
#pragma unroll
      for (int q = 0; q < 8; ++q) { kv[q] = t0[q]; kv[8 + q] = t1[q]; } }
    if (!FOR_A) { const bf16_t* qp = (const bf16_t*)(p.ws + WS_GQ) + tok * 256 + h * 64 + 16 * wv; const u32x4 q0 = *(const u32x4*)qp, q1 = *(const u32x4*)(qp + 8);
      float t0[8], t1[8]; unpack8(q0, t0); unpack8(q1, t1);
#pragma unroll
      for (int q = 0; q < 8; ++q) { qv[q] = t0[q] * 0.125f; qv[8 + q] = t1[q] * 0.125f; } }
    if (FOR_A) {
#pragma unroll
        for (int dd = 0; dd < 16; ++dd) { const int d = 16 * wv + dd;
#ifdef DBG_NOEXP
            const float kf = kv[dd], kb = kv[dd];
#else
            const float kf = kv[dd] * __expf(-pf[dd]), kb = kv[dd] * __expf(-pb[dd]);
#endif
#ifdef DBG_KEXPR
            { const float vv = DBG_KEXPR; const float mv = (vv != vv) ? 7.7e7f : fabsf(vv); atomicMax((int*)(p.ws + WS_PART) + 41, __float_as_int(mv)); }
#endif

            *(LAS bf16_t*)(G + GL_QF + d * GL_ROW + 2 * lane) = (bf16_t)(cvtpk(kf, kf) & 0xffff);
            *(LAS bf16_t*)(G + GL_KF + d * GL_ROW + 2 * lane) = (bf16_t)(cvtpk(kb, kb) & 0xffff); }
    } else {
        float o[8];
#define GLA_PUT(OFF, EXPR0) do { _Pragma("unroll") for (int hf = 0; hf < 2; ++hf) { _Pragma("unroll") for (int q = 0; q < 8; ++q) { const int dd = 8 * hf + q; o[q] = (EXPR0); } \
            *(LAS u32x4*)(G + (OFF) + lane * GL_ROW + (16 * wv + 8 * hf) * 2) = pack8(o); } } while (0)
        GLA_PUT(GL_QF, qv[dd] * __expf(pf[dd]));
        GLA_PUT(GL_KF, kv[dd] * __expf(-pf[dd]));
        GLA_PUT(GL_QB, qv[dd] * __expf(pb[dd]));
        GLA_PUT(GL_KB, kv[dd] * __expf(-pb[dd]));
#undef GLA_PUT
    }
}

__device__ __forceinline__ void gla_a_phase(const Params& p, int e, LAS unsigned char* lds) {
    const int tid = tid_fresh(), grp = __builtin_amdgcn_readfirstlane(tid >> 8), wv = __builtin_amdgcn_readfirstlane((tid & 255) >> 6);
    LAS unsigned char* G = lds + grp * GL_GRP;
    bf16_t* ST = (bf16_t*)(p.ws + WS_ST);
    int h_staged = -1;
    for (int it = blockIdx.x; it < 1024; it += gridDim.x) {
        int lane = tid & 63; asm volatile("" : "+v"(lane));
        const int gt = 64 * wv + lane, tq = lane & 15, quad = lane >> 4;
        const int b = it >> 7, h = (it >> 5) & 3, chunk = 2 * (it & 31) + grp;
        __syncthreads();
        if (h != h_staged) { gla_stage_w2(p, e, h, lds); h_staged = h; }
        gla_stage_ga(p, b, chunk, G, gt);
        __syncthreads();
        gla_prep<true>(p, e, b, h, chunk, lds, G, wv, lane);
        gla_stage_vt(p, b, h, chunk, G, gt);
        __syncthreads();
        const int dir = wv >> 1, ch = wv & 1;
        LAS unsigned char* KT = G + (dir ? GL_KF : GL_QF);
        f32x4 acc[4][4];
#pragma unroll
        for (int mb = 0; mb < 4; ++mb)
#pragma unroll
            for (int nb = 0; nb < 4; ++nb) acc[mb][nb] = (f32x4){0.f, 0.f, 0.f, 0.f};
#pragma unroll
        for (int ks = 0; ks < 2; ++ks) { bf16x8 a[4], bb[4];
#pragma unroll
            for (int mb = 0; mb < 4; ++mb) a[mb] = *(const LAS bf16x8*)(KT + (16 * mb + tq) * GL_ROW + (32 * ks + 8 * quad) * 2);
#pragma unroll
            for (int nb = 0; nb < 4; ++nb) bb[nb] = *(const LAS bf16x8*)(G + GL_VT + (64 * ch + 16 * nb + tq) * GL_ROW + (32 * ks + 8 * quad) * 2);
#pragma unroll
            for (int mb = 0; mb < 4; ++mb)
#pragma unroll
                for (int nb = 0; nb < 4; ++nb) acc[mb][nb] = MFMA16(a[mb], bb[nb], acc[mb][nb]); }
        bf16_t* slot = ST + ((size_t)((b * 4 + h) * 2 + dir) * 64 + chunk) * 8192;
#pragma unroll
        for (int mb = 0; mb < 4; ++mb)
#pragma unroll
            for (int nb = 0; nb < 4; ++nb) { const int c = 64 * ch + 16 * nb + tq, d = 16 * mb + 4 * quad; const f32x4 v = acc[mb][nb];
                u32x2 w; w.x = cvtpk(v[0], v[1]); w.y = cvtpk(v[2], v[3]); *(u32x2*)(slot + c * 64 + d) = w; }
    }
}
__device__ __forceinline__ void gla_b_phase(const Params& p, bool dry = false) {
    bf16_t* ST = (bf16_t*)(p.ws + WS_ST); const float* EV = (const float*)(p.ws + WS_EV);
    const int tid = tid_fresh();
    for (int e = blockIdx.x * 512 + tid; e < 131072; e += gridDim.x * 512) {
        const int seq = e >> 11, within = e & 2047, dq = within & 15, dir = seq & 1;
        bf16_t* sp = ST + (size_t)seq * 64 * 8192 + within * 4; const float* ep = EV + (size_t)seq * 64 * 64 + dq * 4;
        float S0 = 0.f, S1 = 0.f, S2 = 0.f, S3 = 0.f;
        for (int k0 = 0; k0 < 64; k0 += 8) { u32x2 uu[8]; f32x4 ee[8];
#pragma unroll
            for (int q = 0; q < 8; ++q) { const int ck = dir ? 63 - (k0 + q) : (k0 + q); uu[q] = *(const u32x2*)(sp + (size_t)ck * 8192); ee[q] = *(const f32x4*)(ep + ck * 64); }
#pragma unroll
            for (int q = 0; q < 8; ++q) { const int ck = dir ? 63 - (k0 + q) : (k0 + q);
                u32x2 w; w.x = cvtpk(S0, S1); w.y = cvtpk(S2, S3); if (!dry || S0 == 1.2345e33f) *(u32x2*)(sp + (size_t)ck * 8192) = w;
                S0 = ee[q][0] * (S0 + bflo(uu[q].x)); S1 = ee[q][1] * (S1 + bfhi(uu[q].x)); S2 = ee[q][2] * (S2 + bflo(uu[q].y)); S3 = ee[q][3] * (S3 + bfhi(uu[q].y)); } }
    }
}
__device__ __forceinline__ void gla_c_phase(const Params& p, int e, LAS unsigned char* lds) {
    const int tid = tid_fresh(), grp = __builtin_amdgcn_readfirstlane(tid >> 8), wv = __builtin_amdgcn_readfirstlane((tid & 255) >> 6);
    LAS unsigned char* G = lds + grp * GL_GRP;
    const bf16_t* ST = (const bf16_t*)(p.ws + WS_ST); const bf16_t* GZ = (const bf16_t*)(p.ws + WS_GZ); bf16_t* O = (bf16_t*)(p.ws + WS_H);
    int h_staged = -1;
    for (int it = blockIdx.x; it < 1024; it += gridDim.x) {
        int lane = tid & 63; asm volatile("" : "+v"(lane));
        const int gt = 64 * wv + lane, tq = lane & 15, quad = lane >> 4;
        const int b = it >> 7, h = (it >> 5) & 3, chunk = 2 * (it & 31) + grp;
        __syncthreads();
        if (h != h_staged) { gla_stage_w2(p, e, h, lds); h_staged = h; }
        gla_stage_ga(p, b, chunk, G, gt);
        __syncthreads();
        gla_prep<false>(p, e, b, h, chunk, lds, G, wv, lane);
        gla_stage_vt(p, b, h, chunk, G, gt);
        __syncthreads();
        const int t = 16 * wv + tq;
        u32x4 stf[4], stb[4];
        { const bf16_t* slf = ST + ((size_t)((b * 4 + h) * 2 + 0) * 64 + chunk) * 8192; const bf16_t* slb = ST + ((size_t)((b * 4 + h) * 2 + 1) * 64 + chunk) * 8192;
#pragma unroll
          for (int i = 0; i < 4; ++i) { const int pc = gt + 256 * i; stf[i] = *(const u32x4*)(slf + pc * 8); stb[i] = *(const u32x4*)(slb + pc * 8); } }
        bf16x8 bqf[2], bqb[2];
        {
            f32x4 sf[4], sb[4];
#pragma unroll
            for (int mb = 0; mb < 4; ++mb) { sf[mb] = (f32x4){0.f, 0.f, 0.f, 0.f}; sb[mb] = (f32x4){0.f, 0.f, 0.f, 0.f}; }
#pragma unroll
            for (int ks = 0; ks < 2; ++ks) { const int ko = (32 * ks + 8 * quad) * 2;
                bqf[ks] = *(const LAS bf16x8*)(G + GL_QF + t * GL_ROW + ko); bqb[ks] = *(const LAS bf16x8*)(G + GL_QB + t * GL_ROW + ko);
#pragma unroll
                for (int mb = 0; mb < 4; ++mb) { const bf16x8 akf = *(const LAS bf16x8*)(G + GL_KF + (16 * mb + tq) * GL_ROW + ko), akb = *(const LAS bf16x8*)(G + GL_KB + (16 * mb + tq) * GL_ROW + ko);
                    sf[mb] = MFMA16(akf, bqf[ks], sf[mb]); sb[mb] = MFMA16(akb, bqb[ks], sb[mb]); } }
#pragma unroll
            for (int mb = 0; mb < 4; ++mb) { const int s0 = 16 * mb + 4 * quad; float v[4];
#pragma unroll
                for (int j = 0; j < 4; ++j) v[j] = (s0 + j <= t) ? sf[mb][j] : sb[mb][j];
                u32x2 w; w.x = cvtpk(v[0], v[1]); w.y = cvtpk(v[2], v[3]); *(LAS u32x2*)(G + GL_ATT + t * GL_ROW + s0 * 2) = w; }
        }
        __syncthreads();
#pragma unroll
        for (int i = 0; i < 4; ++i) { const int pc = gt + 256 * i, c = pc >> 3, c8 = pc & 7;
            *(LAS u32x4*)(G + c * GL_ROW + c8 * 16) = stf[i]; *(LAS u32x4*)(G + 18432 + c * GL_ROW + c8 * 16) = stb[i]; }
        f32x4 o[8];
#pragma unroll
        for (int mb = 0; mb < 8; ++mb) o[mb] = (f32x4){0.f, 0.f, 0.f, 0.f};
        const int crow0 = 8 * (tq >> 2) + (tq & 3);
#pragma unroll
        for (int ks = 0; ks < 2; ++ks) { const int ko = (32 * ks + 8 * quad) * 2; const bf16x8 batt = *(const LAS bf16x8*)(G + GL_ATT + t * GL_ROW + ko);
#pragma unroll
            for (int mb = 0; mb < 8; ++mb) { const int c = 32 * (mb >> 1) + crow0 + 4 * (mb & 1);
                const bf16x8 av = *(const LAS bf16x8*)(G + GL_VT + c * GL_ROW + ko); o[mb] = MFMA16(av, batt, o[mb]); } }
        __syncthreads();
#pragma unroll
        for (int dir = 0; dir < 2; ++dir) {
#pragma unroll
            for (int ks = 0; ks < 2; ++ks) { const int ko = (32 * ks + 8 * quad) * 2; const bf16x8 bq = dir ? bqb[ks] : bqf[ks];
#pragma unroll
                for (int mb = 0; mb < 8; ++mb) { const int c = 32 * (mb >> 1) + crow0 + 4 * (mb & 1);
                    const bf16x8 as = *(const LAS bf16x8*)(G + dir * 18432 + c * GL_ROW + ko); o[mb] = MFMA16(as, bq, o[mb]); } } }
        float ss = 0.f;
#pragma unroll
        for (int mb = 0; mb < 8; ++mb) ss += o[mb][0] * o[mb][0] + o[mb][1] * o[mb][1] + o[mb][2] * o[mb][2] + o[mb][3] * o[mb][3];
        ss += __shfl_xor(ss, 16); ss += __shfl_xor(ss, 32);
        const float rs = rsqrtf(ss * (1.0f / 128.0f) + EPS);
        const size_t tok = (size_t)b * 4096 + chunk * 64 + t;
#pragma unroll
        for (int pp = 0; pp < 4; ++pp) { const int c0 = 32 * pp + 8 * quad;
            const u32x4 gzw = *(const u32x4*)(GZ + tok * 512 + h * 128 + c0); float z[8]; unpack8(gzw, z);
            const f32x4 g0 = *(const f32x4*)(p.in[I_GNORM] + e * 128 + c0), g1 = *(const f32x4*)(p.in[I_GNORM] + e * 128 + c0 + 4);
            float r[8];
#pragma unroll
            for (int j = 0; j < 4; ++j) { r[j] = o[2 * pp][j] * rs * g0[j] * silu_f(z[j]); r[4 + j] = o[2 * pp + 1][j] * rs * g1[j] * silu_f(z[4 + j]); }
            *(u32x4*)(O + tok * 1024 + h * 128 + c0) = pack8(r); }
    }
}

#ifndef ATT_EARLY
#define ATT_EARLY 1
#endif
namespace att {
constexpr int DQK = 192, DV = 128, NW = 8, QBLK = 32, KVBLK = 64;
constexpr float SCALE = 0.07216878364870323f;
constexpr float THR = 8.f;
constexpr int SDEPTH = ATT_SDEPTH;
constexpr int SHM_V = KVBLK * DV * 2, SHM_K = KVBLK * DQK * 2;
constexpr int SHM_QR = 2 * SHM_V + 2 * SHM_K + NW * 64 * 4;
constexpr int NQR = ATT_NQR;
constexpr int SHM_ATTN = SHM_QR + NW * (12 - NQR) * 1024;
#define KSWZ(row, colB) ((row) * 384 + ((colB) ^ (((row) & 7) << 4)))
#define SBAR() __builtin_amdgcn_sched_barrier(0)
__device__ __forceinline__ int crow(int r, int hi) { return (r & 3) + 8 * (r >> 2) + 4 * hi; }
__device__ __forceinline__ unsigned cvtpkv(float lo, float hi) { unsigned r; asm volatile("v_cvt_pk_bf16_f32 %0, %1, %2" : "=v"(r) : "v"(lo), "v"(hi)); return r; }

__device__ __forceinline__ void partialSM(f32x16& p0, f32x16& p1, float& m_reg, float& mn, float& alpha) {
  constexpr float C = SCALE * 1.4426950408889634f;
  float pmax = p0[0];
#pragma unroll
  for (int r = 1; r < 16; ++r) pmax = fmaxf(pmax, p0[r]);
#pragma unroll
  for (int r = 0; r < 16; ++r) pmax = fmaxf(pmax, p1[r]);
  { auto rr = __builtin_amdgcn_permlane32_swap(__float_as_uint(pmax), __float_as_uint(pmax), false, false);
    pmax = fmaxf(__uint_as_float(rr[0]), __uint_as_float(rr[1])); }
  if (__builtin_expect(__all(pmax - m_reg <= THR / SCALE), 1)) { mn = m_reg; alpha = 1.f; }
  else { mn = fmaxf(m_reg, pmax); alpha = __builtin_amdgcn_exp2f((m_reg - mn) * C); m_reg = mn; }
  float mnC = -mn * C;
#pragma unroll
  for (int r = 0; r < 16; ++r) p0[r] = fmaf(p0[r], C, mnC);
#pragma unroll
  for (int r = 0; r < 16; ++r) p1[r] = fmaf(p1[r], C, mnC);
#pragma unroll
  for (int r = 0; r < 16; ++r) p0[r] = __builtin_amdgcn_exp2f(p0[r]);
}
__device__ __forceinline__ void finishSM(f32x16& p0, f32x16& p1, float alpha, float& l_reg, bf16x8& pa0, bf16x8& pa1, bf16x8& pa2, bf16x8& pa3) {
#pragma unroll
  for (int r = 0; r < 16; ++r) p1[r] = __builtin_amdgcn_exp2f(p1[r]);
  float ps = 0;
#pragma unroll
  for (int r = 0; r < 16; ++r) ps += p0[r];
#pragma unroll
  for (int r = 0; r < 16; ++r) ps += p1[r];
  { auto rr = __builtin_amdgcn_permlane32_swap(__float_as_uint(ps), __float_as_uint(ps), false, false);
    ps = __uint_as_float(rr[0]) + __uint_as_float(rr[1]); }
  l_reg = l_reg * alpha + ps;
#define PK4(P, BASE, OUT) do { unsigned a0 = cvtpkv(P[BASE + 0], P[BASE + 1]), a1 = cvtpkv(P[BASE + 2], P[BASE + 3]);   \
    unsigned b0 = cvtpkv(P[BASE + 4], P[BASE + 5]), b1 = cvtpkv(P[BASE + 6], P[BASE + 7]);                              \
    auto r0 = __builtin_amdgcn_permlane32_swap(a0, b0, false, false); auto r1 = __builtin_amdgcn_permlane32_swap(a1, b1, false, false); \
    u32x4 w = {r0[0], r1[0], r0[1], r1[1]}; OUT = *reinterpret_cast<bf16x8*>(&w); } while (0)
  PK4(p0, 0, pa0); PK4(p0, 8, pa1); PK4(p1, 0, pa2); PK4(p1, 8, pa3);
#undef PK4
}
__device__ __forceinline__ void qkt(f32x16& p0, f32x16& p1, const char* Ks, const bf16x8* qr, const char* qrl, int r32, int hi) {
  p0 = f32x16{}; p1 = f32x16{};
#pragma unroll
  for (int d0 = 0; d0 < 12; ++d0) { int cb = (d0 * 16 + hi * 8) * 2;
    bf16x8 b0 = *reinterpret_cast<const bf16x8*>(Ks + KSWZ(r32, cb));
    bf16x8 b1 = *reinterpret_cast<const bf16x8*>(Ks + KSWZ(32 + r32, cb));
    const bf16x8 q = d0 < NQR ? qr[d0 < NQR ? d0 : 0] : *reinterpret_cast<const bf16x8*>(qrl + (d0 - NQR) * 1024);
    p0 = __builtin_amdgcn_mfma_f32_32x32x16_bf16(b0, q, p0, 0, 0, 0);
    p1 = __builtin_amdgcn_mfma_f32_32x32x16_bf16(b1, q, p1, 0, 0, 0); }
}
__device__ __forceinline__ int v_st(int k, int c) { const int kk = (k & ~0xC) | ((k & 4) << 1) | ((k & 8) >> 1); return ((kk >> 3) * 4 + (c >> 5)) * 512 + ((kk & 7) * 32 + (c & 31)) * 2; }
__device__ __forceinline__ int v_rd_base(int lane) { return ((lane & 3) << 3) | (((lane >> 2) & 3) << 6) | (((lane >> 4) & 1) << 5) | (((lane >> 5) & 1) << 8); }
constexpr int v_rd_off(int d0, int ks, int half) { return d0 * 512 + ks * 4096 + half * 2048; }
template <int OFF> __device__ __forceinline__ s16x4 tr_read(int vb) {
  s16x4 r; asm volatile("ds_read_b64_tr_b16 %0, %1 offset:%2" : "=&v"(r) : "v"(vb), "i"(OFF) : "memory"); return r;
}
template <int D0> __device__ __forceinline__ void pv_one(f32x16& od, int vb, bf16x8 pa0, bf16x8 pa1, bf16x8 pa2, bf16x8 pa3) {
  const s16x4 l0 = tr_read<v_rd_off(D0, 0, 0)>(vb), h0 = tr_read<v_rd_off(D0, 0, 1)>(vb), l1 = tr_read<v_rd_off(D0, 1, 0)>(vb), h1 = tr_read<v_rd_off(D0, 1, 1)>(vb);
  const s16x4 l2 = tr_read<v_rd_off(D0, 2, 0)>(vb), h2 = tr_read<v_rd_off(D0, 2, 1)>(vb), l3 = tr_read<v_rd_off(D0, 3, 0)>(vb), h3 = tr_read<v_rd_off(D0, 3, 1)>(vb);
  asm volatile("s_waitcnt lgkmcnt(0)" ::: "memory"); SBAR();
#define PK(L, H) (bf16x8){L[0], L[1], L[2], L[3], H[0], H[1], H[2], H[3]}
  od = __builtin_amdgcn_mfma_f32_32x32x16_bf16(pa0, PK(l0, h0), od, 0, 0, 0);
  od = __builtin_amdgcn_mfma_f32_32x32x16_bf16(pa1, PK(l1, h1), od, 0, 0, 0);
  od = __builtin_amdgcn_mfma_f32_32x32x16_bf16(pa2, PK(l2, h2), od, 0, 0, 0);
  od = __builtin_amdgcn_mfma_f32_32x32x16_bf16(pa3, PK(l3, h3), od, 0, 0, 0);
#undef PK
}
__device__ __forceinline__ void pv_d0(f32x16* o, int vb, bf16x8 pa0, bf16x8 pa1, bf16x8 pa2, bf16x8 pa3) {
  pv_one<0>(o[0], vb, pa0, pa1, pa2, pa3); pv_one<1>(o[1], vb, pa0, pa1, pa2, pa3); pv_one<2>(o[2], vb, pa0, pa1, pa2, pa3); pv_one<3>(o[3], vb, pa0, pa1, pa2, pa3);
}

template <int OFF> __device__ __forceinline__ bf16x8 lds_rd128(int a) { bf16x8 r; asm volatile("ds_read_b128 %0, %1 offset:%2" : "=&v"(r) : "v"(a), "i"(OFF) : "memory"); return r; }
template <int N> __device__ __forceinline__ void lgkm_wait2(bf16x8& a, bf16x8& b) { asm volatile("s_waitcnt lgkmcnt(%2)" : "+v"(a), "+v"(b) : "n"(N) : "memory"); }
template <int N> __device__ __forceinline__ void lgkm_wait3(bf16x8& a, bf16x8& b, bf16x8& c) { asm volatile("s_waitcnt lgkmcnt(%3)" : "+v"(a), "+v"(b), "+v"(c) : "n"(N) : "memory"); }
template <int N> __device__ __forceinline__ void lgkm_wait2s(s16x4& a, s16x4& b) { asm volatile("s_waitcnt lgkmcnt(%2)" : "+v"(a), "+v"(b) : "n"(N) : "memory"); }
constexpr int k_off(int buf, int d0, int half) { return buf * SHM_K + (d0 >> 2) * 128 + half * 12288; }
constexpr int q_off(int d0) { return (d0 >= NQR ? d0 - NQR : 0) * 1024; }
template <int BUF, int D0> __device__ __forceinline__ void k_fetch(bf16x8& b0, bf16x8& b1, bf16x8& qx, const int (&ka)[4], int qa) {
  b0 = lds_rd128<k_off(BUF, D0, 0)>(ka[D0 & 3]); b1 = lds_rd128<k_off(BUF, D0, 1)>(ka[D0 & 3]);
  if constexpr (D0 >= NQR) qx = lds_rd128<q_off(D0)>(qa);
}
template <int BUF, int D0> __device__ __forceinline__ void qk_step(f32x16& p0, f32x16& p1, bf16x8 (&b0)[2], bf16x8 (&b1)[2], bf16x8 (&qx)[2], const bf16x8* qr, const int (&ka)[4], int qa) {
  if constexpr (D0 < 11) k_fetch<BUF, D0 + 1>(b0[(D0 + 1) & 1], b1[(D0 + 1) & 1], qx[(D0 + 1) & 1], ka, qa);
  constexpr int PEND = D0 < 11 ? (2 + ((D0 + 1) >= NQR ? 1 : 0)) : 0;
  if constexpr (D0 >= NQR) lgkm_wait3<PEND>(b0[D0 & 1], b1[D0 & 1], qx[D0 & 1]); else lgkm_wait2<PEND>(b0[D0 & 1], b1[D0 & 1]);
  const bf16x8 q = D0 < NQR ? qr[D0 < NQR ? D0 : 0] : qx[D0 & 1];
  __builtin_amdgcn_s_setprio(1);
  p0 = __builtin_amdgcn_mfma_f32_32x32x16_bf16(b0[D0 & 1], q, p0, 0, 0, 0);
  p1 = __builtin_amdgcn_mfma_f32_32x32x16_bf16(b1[D0 & 1], q, p1, 0, 0, 0);
  __builtin_amdgcn_s_setprio(0);
}
template <int BUF> __device__ __forceinline__ void qkt2(f32x16& p0, f32x16& p1, const bf16x8* qr, const int (&ka)[4], int qa) {
  p0 = f32x16{}; p1 = f32x16{};
  bf16x8 b0[2], b1[2], qx[2];
  k_fetch<BUF, 0>(b0[0], b1[0], qx[0], ka, qa);
  qk_step<BUF, 0>(p0, p1, b0, b1, qx, qr, ka, qa); qk_step<BUF, 1>(p0, p1, b0, b1, qx, qr, ka, qa); qk_step<BUF, 2>(p0, p1, b0, b1, qx, qr, ka, qa); qk_step<BUF, 3>(p0, p1, b0, b1, qx, qr, ka, qa);
  qk_step<BUF, 4>(p0, p1, b0, b1, qx, qr, ka, qa); qk_step<BUF, 5>(p0, p1, b0, b1, qx, qr, ka, qa); qk_step<BUF, 6>(p0, p1, b0, b1, qx, qr, ka, qa); qk_step<BUF, 7>(p0, p1, b0, b1, qx, qr, ka, qa);
  qk_step<BUF, 8>(p0, p1, b0, b1, qx, qr, ka, qa); qk_step<BUF, 9>(p0, p1, b0, b1, qx, qr, ka, qa); qk_step<BUF, 10>(p0, p1, b0, b1, qx, qr, ka, qa); qk_step<BUF, 11>(p0, p1, b0, b1, qx, qr, ka, qa);
}
template <int BUF, int S> __device__ __forceinline__ void v_fetch(s16x4& l, s16x4& h, int vb) {
  l = tr_read<BUF * SHM_V + v_rd_off(S & 3, S >> 2, 0)>(vb); h = tr_read<BUF * SHM_V + v_rd_off(S & 3, S >> 2, 1)>(vb);
}
template <int BUF, int S> __device__ __forceinline__ void pv_step(f32x16* o, s16x4 (&l)[3], s16x4 (&h)[3], int vb, const bf16x8 (&pa)[4]) {
  if constexpr (S + 2 < 16) v_fetch<BUF, S + 2>(l[(S + 2) % 3], h[(S + 2) % 3], vb);
  constexpr int PEND = S + 2 < 16 ? 4 : (S + 1 < 16 ? 2 : 0);
  lgkm_wait2s<PEND>(l[S % 3], h[S % 3]);
  const s16x4 L = l[S % 3], H = h[S % 3];
  __builtin_amdgcn_s_setprio(1);
  o[S & 3] = __builtin_amdgcn_mfma_f32_32x32x16_bf16(pa[S >> 2], (bf16x8){L[0], L[1], L[2], L[3], H[0], H[1], H[2], H[3]}, o[S & 3], 0, 0, 0);
  __builtin_amdgcn_s_setprio(0);
}
template <int BUF> __device__ __forceinline__ void pv2(f32x16* o, int vb, bf16x8 pa0, bf16x8 pa1, bf16x8 pa2, bf16x8 pa3) {
  s16x4 l[3], h[3]; const bf16x8 pa[4] = {pa0, pa1, pa2, pa3};
  v_fetch<BUF, 0>(l[0], h[0], vb); v_fetch<BUF, 1>(l[1], h[1], vb);
  pv_step<BUF, 0>(o, l, h, vb, pa); pv_step<BUF, 1>(o, l, h, vb, pa); pv_step<BUF, 2>(o, l, h, vb, pa); pv_step<BUF, 3>(o, l, h, vb, pa);
  pv_step<BUF, 4>(o, l, h, vb, pa); pv_step<BUF, 5>(o, l, h, vb, pa); pv_step<BUF, 6>(o, l, h, vb, pa); pv_step<BUF, 7>(o, l, h, vb, pa);
  pv_step<BUF, 8>(o, l, h, vb, pa); pv_step<BUF, 9>(o, l, h, vb, pa); pv_step<BUF, 10>(o, l, h, vb, pa); pv_step<BUF, 11>(o, l, h, vb, pa);
  pv_step<BUF, 12>(o, l, h, vb, pa); pv_step<BUF, 13>(o, l, h, vb, pa); pv_step<BUF, 14>(o, l, h, vb, pa); pv_step<BUF, 15>(o, l, h, vb, pa);
}

__device__ __forceinline__ void attn_body(const bf16_t* __restrict__ Qb, const bf16_t* __restrict__ Kh, const bf16_t* __restrict__ Vh,
                                          const bf16_t* __restrict__ MZb, bf16_t* __restrict__ Ob, int seq, char* lds) {
  const int tid = tid_fresh(), wid = __builtin_amdgcn_readfirstlane(tid >> 6), lane = tid & 63, r32 = lane & 31, hi = lane >> 5;
  char* V_lds = lds; char* K_lds = lds + 2 * SHM_V;
  float* wsl = (float*)(lds + 2 * SHM_V + 2 * SHM_K) + wid * 64; float* li_l = wsl; float* al_l = wsl + 32;
  float m_reg = -1e30f, l_reg = 0; f32x16 o[4] = {}; bf16x8 qr[NQR];
  char* qrl = lds + SHM_QR + wid * ((12 - NQR) * 1024) + lane * 16;
  const bf16_t* Qw = Qb + (long)(wid * QBLK + r32) * DQK + hi * 8;
#pragma unroll
  for (int d0 = 0; d0 < NQR; ++d0) qr[d0] = *reinterpret_cast<const bf16x8*>(Qw + d0 * 16);
#pragma unroll
  for (int d0 = NQR; d0 < 12; ++d0) *reinterpret_cast<bf16x8*>(qrl + (d0 - NQR) * 1024) = *reinterpret_cast<const bf16x8*>(Qw + d0 * 16);
  const int sr = tid >> 4, sc = (tid & 15) * 8, vst0 = v_st(sr, sc);
  const int sr2 = tid >> 3, sl2 = 16 + (tid & 7);
  const unsigned kg0 = sr * DQK + sc, kg2 = sr2 * DQK + sl2 * 8, voff0 = sr * DV + sc;
  const int kl0 = KSWZ(sr, sc * 2), kl2 = KSWZ(sr2, sl2 * 16);
  const int vb0 = (int)(uintptr_t)(LAS char*)V_lds + v_rd_base(lane);
  int ka[4]; { const int kbase = (int)(uintptr_t)(LAS char*)K_lds + r32 * 384;
#pragma unroll
    for (int j = 0; j < 4; ++j) ka[j] = kbase + ((j * 32 + hi * 16) ^ ((r32 & 7) << 4)); }
  const int qa = (int)(uintptr_t)(LAS char*)qrl;
  struct { bf16x8 vs0, vs1, ks0, ks1, ks2; } sr_[SDEPTH];
#define SLOAD(i, k0) do { const bf16_t* Kt = Kh + (size_t)(k0) * DQK; const bf16_t* Vt = Vh + (size_t)(k0) * DV; \
    sr_[i].vs0 = *(const bf16x8*)(Vt + voff0); sr_[i].vs1 = *(const bf16x8*)(Vt + voff0 + 32 * DV); \
    sr_[i].ks0 = *(const bf16x8*)(Kt + kg0); sr_[i].ks1 = *(const bf16x8*)(Kt + kg0 + 32 * DQK); sr_[i].ks2 = *(const bf16x8*)(Kt + kg2); } while (0)
#define SWRITE(b, i) do { *(bf16x8*)(V_lds + (b) * SHM_V + vst0) = sr_[i].vs0; *(bf16x8*)(V_lds + (b) * SHM_V + vst0 + 8192) = sr_[i].vs1; \
    *(bf16x8*)(K_lds + (b) * SHM_K + kl0) = sr_[i].ks0; *(bf16x8*)(K_lds + (b) * SHM_K + kl0 + 32 * 384) = sr_[i].ks1; *(bf16x8*)(K_lds + (b) * SHM_K + kl2) = sr_[i].ks2; } while (0)
#define SWAIT() do { if constexpr (SDEPTH == 2) asm volatile("s_waitcnt vmcnt(5)" ::: "memory"); else asm volatile("s_waitcnt vmcnt(0)" ::: "memory"); } while (0)
#define RESC(a) do { if (__any((a) < 1.f)) { if (hi == 0) al_l[r32] = (a); asm volatile("s_waitcnt lgkmcnt(0)" ::: "memory"); \
    _Pragma("unroll") for (int d = 0; d < 4; ++d) _Pragma("unroll") for (int r = 0; r < 16; ++r) o[d][r] *= al_l[crow(r, hi)]; } } while (0)
  f32x16 pA0, pA1, pB0, pB1; float mnA, mnB, alA, alB; bf16x8 pa0, pa1, pa2, pa3; const int NT = seq / KVBLK;
  constexpr int SE = 0, SO = SDEPTH - 1;
  SLOAD(SE, 0); asm volatile("s_waitcnt vmcnt(0)" ::: "memory"); SWRITE(0, SE); __syncthreads();
  qkt2<0>(pA0, pA1, qr, ka, qa); partialSM(pA0, pA1, m_reg, mnA, alA);
  SLOAD(SO, KVBLK); if constexpr (SDEPTH == 2) { if (2 < NT) SLOAD(SE, 2 * KVBLK); }
  SWAIT(); SWRITE(1, SO); __syncthreads();
  for (int j = 1; j + 1 < NT; j += 2) {
#if ATT_EARLY
    SBAR(); SLOAD(SO, (j + SDEPTH) * KVBLK); SBAR();
#endif
    SBAR(); qkt2<1>(pB0, pB1, qr, ka, qa);
    finishSM(pA0, pA1, alA, l_reg, pa0, pa1, pa2, pa3); SBAR();
#if !ATT_EARLY
    SLOAD(SO, (j + SDEPTH) * KVBLK); SBAR();
#endif
    pv2<0>(o, vb0, pa0, pa1, pa2, pa3); partialSM(pB0, pB1, m_reg, mnB, alB);
    __syncthreads(); SWAIT(); SWRITE(0, SE);
    RESC(alB); __syncthreads();
#if ATT_EARLY
    SBAR(); if (SDEPTH == 1 || j + 3 < NT) SLOAD(SE, (j + 1 + SDEPTH) * KVBLK); SBAR();
#endif
    SBAR(); qkt2<0>(pA0, pA1, qr, ka, qa);
    finishSM(pB0, pB1, alB, l_reg, pa0, pa1, pa2, pa3); SBAR();
#if !ATT_EARLY
    if (SDEPTH == 1 || j + 3 < NT) SLOAD(SE, (j + 1 + SDEPTH) * KVBLK); SBAR();
#endif
    pv2<1>(o, vb0, pa0, pa1, pa2, pa3); partialSM(pA0, pA1, m_reg, mnA, alA);
    __syncthreads(); SWAIT(); SWRITE(1, SO);
    RESC(alA); __syncthreads();
  }
  SBAR(); qkt2<1>(pB0, pB1, qr, ka, qa);
  finishSM(pA0, pA1, alA, l_reg, pa0, pa1, pa2, pa3); SBAR();
  pv2<0>(o, vb0, pa0, pa1, pa2, pa3); partialSM(pB0, pB1, m_reg, mnB, alB);
  __syncthreads(); RESC(alB);
  finishSM(pB0, pB1, alB, l_reg, pa0, pa1, pa2, pa3); SBAR();
  pv2<1>(o, vb0, pa0, pa1, pa2, pa3);
  if (hi == 0) li_l[r32] = l_reg; asm volatile("s_waitcnt lgkmcnt(0)" ::: "memory");
  float rli[16];
#pragma unroll
  for (int r = 0; r < 16; ++r) rli[r] = __builtin_amdgcn_rcpf(li_l[crow(r, hi)]);
  __syncthreads();
  int ln = lane; asm volatile("" : "+v"(ln));
  char* Tw = lds + wid * 8192; const int r32l = ln & 31, hil = ln >> 5;
#pragma unroll
  for (int r = 0; r < 16; ++r) { const int ro = (r & 3) + 8 * (r >> 2);
#pragma unroll
    for (int d0 = 0; d0 < 4; ++d0) { const float v = o[d0][r] * rli[r];
      *(bf16_t*)(Tw + (ro + 4 * hil) * 256 + (32 * d0 + r32l) * 2) = (bf16_t)(cvtpk(v, v) & 0xffff); } }
  asm volatile("" ::: "memory");
  bf16_t* Ow = Ob + (size_t)(wid * QBLK) * 1024; const bf16_t* Zw = MZb + (size_t)(wid * QBLK) * 512;
#pragma unroll
  for (int i = 0; i < 8; ++i) { const int pc = ln + 64 * i, row = pc >> 4, c8 = pc & 15;
    const u32x4 ov = *(const u32x4*)(Tw + row * 256 + c8 * 16), zv = *(const u32x4*)(Zw + (unsigned)(row * 512 + c8 * 8));
    float fo[8], fz[8]; unpack8(ov, fo); unpack8(zv, fz);
#pragma unroll
    for (int j = 0; j < 8; ++j) fo[j] *= silu_f(fz[j]);
    *(u32x4*)(Ow + (unsigned)(row * 1024 + c8 * 8)) = pack8(fo); }
#undef SLOAD
#undef SWRITE
#undef SWAIT
#undef RESC
}
}

__device__ __forceinline__ void attn_phase(const Params& p, unsigned char* lds_generic) {
    const bf16_t* Q = (const bf16_t*)(p.ws + WS_Q); const bf16_t* K = (const bf16_t*)(p.ws + WS_K); const bf16_t* V = (const bf16_t*)(p.ws + WS_V);
    const bf16_t* MZ = (const bf16_t*)(p.ws + WS_MZ); bf16_t* O = (bf16_t*)(p.ws + WS_H);
    for (int it = blockIdx.x; it < 512; it += gridDim.x) {
        const int xcd = it & 7, r = it >> 3, bh = xcd * 4 + (r >> 4), qb = r & 15, b = bh >> 2, h = bh & 3;
        __syncthreads();
        const size_t tok0 = (size_t)b * 4096 + qb * 256;
        att::attn_body(Q + ((size_t)bh * 4096 + qb * 256) * 192, K + (size_t)bh * 4096 * 192, V + (size_t)bh * 4096 * 128,
                       MZ + tok0 * 512 + h * 128, O + tok0 * 1024 + 512 + h * 128, 4096, (char*)lds_generic);
    }
    __syncthreads();
}

constexpr int MX_WL = 0, MX_VT = 34816, MX_ST = 104448, MX_ROW = 272;
__device__ __forceinline__ void mix_phase(const Params& p, int oi, LAS unsigned char* lds, bool dry = false) {
    const int tid = tid_fresh(), w = __builtin_amdgcn_readfirstlane(tid >> 6), lane = tid & 63, tq = lane & 15, quad = lane >> 4;
    const bf16_t* Wsb = (const bf16_t*)(p.ws + WS_WS); const bf16_t* V2 = (const bf16_t*)(p.ws + WS_V2); bf16_t* UZ = (bf16_t*)(p.ws + WS_UZ);
    const f32x2* PART = (const f32x2*)(p.ws + WS_PART);
    LAS f32x2* STAT = (LAS f32x2*)(lds + MX_ST);
    const int per = 2048 / gridDim.x; int last_g = -1;
    for (int i = 0; i < per; ++i) {
        const int it = blockIdx.x * per + i, g = it >> 8, bn = it & 255, b = bn >> 5, n = bn & 31; const size_t tok0 = (size_t)b * 4096 + n * 128;
        __syncthreads();
        if (g != last_g) { last_g = g;
#pragma unroll
            for (int q = 0; q < 4; ++q) { const int pc = tid + 512 * q, row = pc >> 4, cgp = pc & 15;
                *(LAS u32x4*)(lds + MX_WL + row * MX_ROW + cgp * 16) = *(const u32x4*)(Wsb + ((size_t)(oi * 8 + g) * 128 + row) * 128 + cgp * 8); } }
        {
            const int tl = tid >> 2, part = tid & 3; const f32x4* pp = (const f32x4*)(PART + (tok0 + tl) * 32 + part * 8);
            const f32x4 p0 = pp[0], p1 = pp[1], p2 = pp[2], p3 = pp[3];
            float s = (p0[0] + p0[2]) + (p1[0] + p1[2]) + (p2[0] + p2[2]) + (p3[0] + p3[2]), ss = (p0[1] + p0[3]) + (p1[1] + p1[3]) + (p2[1] + p2[3]) + (p3[1] + p3[3]);
            s += __shfl_xor(s, 1); ss += __shfl_xor(ss, 1); s += __shfl_xor(s, 2); ss += __shfl_xor(ss, 2);
            const float mu = s * (1.0f / 2048.0f), var = ss * (1.0f / 2048.0f) - mu * mu; if (part == 0) STAT[tl] = (f32x2){mu, rsqrtf(var + EPS)}; }
        u32x4 uzw[8];
#pragma unroll
        for (int nb = 0; nb < 8; ++nb) uzw[nb] = *(const u32x4*)(UZ + (tok0 + 16 * nb + tq) * 2048 + g * 256 + 32 * w + 8 * quad);
        __syncthreads();
        {
            const int c0 = 8 * ((lane >> 4) + 4 * w);
            const f32x4 gl0 = *(const f32x4*)(p.in[I_SGG] + oi * 2048 + g * 256 + c0), gl1 = *(const f32x4*)(p.in[I_SGG] + oi * 2048 + g * 256 + c0 + 4);
            const f32x4 bl0 = *(const f32x4*)(p.in[I_SGB] + oi * 2048 + g * 256 + c0), bl1 = *(const f32x4*)(p.in[I_SGB] + oi * 2048 + g * 256 + c0 + 4);
#pragma unroll
            for (int q = 0; q < 4; ++q) { const int rp = (lane & 15) + 16 * q; const size_t tokA = tok0 + 2 * rp; const f32x2 sa = STAT[2 * rp], sb = STAT[2 * rp + 1];
                const u32x4 ra = *(const u32x4*)(V2 + tokA * 2048 + g * 256 + c0), rb = *(const u32x4*)(V2 + (tokA + 1) * 2048 + g * 256 + c0);
                float fa[8], fb[8]; unpack8(ra, fa); unpack8(rb, fb);
#pragma unroll
                for (int e = 0; e < 8; ++e) { const float gg = e < 4 ? gl0[e & 3] : gl1[e & 3], bb = e < 4 ? bl0[e & 3] : bl1[e & 3];
                    const float va = (fa[e] - sa.x) * sa.y * gg + bb, vb = (fb[e] - sb.x) * sb.y * gg + bb;
                    *(LAS unsigned*)(lds + MX_VT + (c0 + e) * MX_ROW + 4 * rp) = cvtpk(va, vb); } }
        }
        __syncthreads();
        bf16x8 A[2][4];
#pragma unroll
        for (int mb = 0; mb < 2; ++mb)
#pragma unroll
            for (int ks = 0; ks < 4; ++ks) { const int c = 32 * w + 8 * (tq >> 2) + 4 * mb + (tq & 3);
                A[mb][ks] = *(const LAS bf16x8*)(lds + MX_VT + c * MX_ROW + (32 * ks + 8 * quad) * 2); }
#pragma unroll
        for (int nb = 0; nb < 8; ++nb) {
            f32x4 a0 = (f32x4){0.f, 0.f, 0.f, 0.f}, a1 = (f32x4){0.f, 0.f, 0.f, 0.f};
#pragma unroll
            for (int ks = 0; ks < 4; ++ks) { const bf16x8 bw = *(const LAS bf16x8*)(lds + MX_WL + (16 * nb + tq) * MX_ROW + (32 * ks + 8 * quad) * 2);
                a0 = MFMA16(A[0][ks], bw, a0); a1 = MFMA16(A[1][ks], bw, a1); }
            const int ti = 16 * nb + tq; const size_t tok = tok0 + ti; const float bias = p.in[I_SGBS][(oi * 8 + g) * 128 + ti];
            bf16_t* up = UZ + tok * 2048 + g * 256 + 32 * w + 8 * quad;
            float f[8]; unpack8(uzw[nb], f);
#pragma unroll
            for (int j = 0; j < 4; ++j) { f[j] *= (a0[j] + bias); f[4 + j] *= (a1[j] + bias); }
            if (!dry || f[0] == 1.2345e33f) *(u32x4*)up = pack8(f);
        }
    }
    __syncthreads();
}

constexpr size_t WS_BAR = (WS_TOTAL + 255) / 256 * 256;
constexpr size_t WS_NEED = WS_BAR + (size_t)XCD_BAR_WORDS * 4;
__device__ __forceinline__ int opq(int x) { asm volatile("" : "+s"(x)); return x; }
__global__ void __launch_bounds__(512, 2) mega(Params p) {
    extern __shared__ __attribute__((aligned(16))) unsigned char lds_[];
    LAS unsigned char* lds = (LAS unsigned char*)lds_;
    cg::grid_group grid = cg::this_grid();
    const int lo = p.ph_lo, hi = p.ph_hi;
    unsigned char* ws = p.ws;
#ifdef ONLY_PH
#define IN(k) ((((k) - 2) % 10 + 2 == ONLY_PH || (k) == ONLY_PH) && lo <= (k) && (k) < hi)
#else
#define IN(k) (lo <= (k) && (k) < hi)
#endif
    volatile LAS unsigned* xb_st = (volatile LAS unsigned*)(lds + LDS_BYTES - 16);
    if (threadIdx.x < 4) xb_st[threadIdx.x] = 0u;
    __syncthreads();
    XcdBarrier xbar = xcd_barrier_post((unsigned*)(ws + WS_BAR), xb_st);
    if (p.ph_lo < 0) grid.sync();
#ifdef DBL_BAR
#define SEAM(k) do { if (IN(k) && IN((k) + 1)) { xcd_barrier(xbar); xcd_barrier(xbar); } } while (0)
#else
#define SEAM(k) do { if (IN(k) && IN((k) + 1)) xcd_barrier(xbar); } while (0)
#endif
#if defined(DBG_MAXP) || defined(DBG_KEXPR)
    if (blockIdx.x == 0 && threadIdx.x == 0) ((int*)(ws + WS_PART))[41] = 0;
#endif
#ifndef REP
#define REP 0
#endif
#define REPN(bit) (((REP) >> (bit)) & 1 ? 2 : 1)
    if (IN(0)) for (int rep = 0; rep < REPN(8); ++rep) p0_phase(p, lds);
    SEAM(0);
    if (IN(1)) for (int rep = 0; rep < (((REP) >> 10) & 1 ? 5 : 1); ++rep) norm_phase(p, -1, 0, nullptr, p.in[I_X]);
    SEAM(1);
    if (((REP) >> 11) & 1) for (int rep = 0; rep < 20; ++rep) grid.sync();
    for (int lp = 0; lp < 2; ++lp) {
        const int base = 2 + 10 * lp, le = 2 * lp, lod = 2 * lp + 1;
        if (IN(base + 0)) for (int rep = 0; rep < REPN(0); ++rep) {
            pg8::Gemm g{(const bf16_t*)(ws + WS_H), (const bf16_t*)(ws + WS_WINE) + (size_t)lp * 2560 * 1024, T_, opq(2560), opq(1024)};
            pg8::StaticOrder S; S.init(T_, 2560, (int)gridDim.x, (int)blockIdx.x); EpiEvenIn E{ws};
            pg8::gemm_phase<EpiEvenIn, pg8::StaticOrder, false>(lds, g, S, E, nullptr);
        }
        SEAM(base + 0);
        if (IN(base + 1)) { for (int rep = 0; rep < REPN(9); ++rep) rs_rope_phase(p); for (int rep = 0; rep < REPN(1); ++rep) gla_a_phase(p, lp, lds); }
        SEAM(base + 1);
        if (IN(base + 2)) {
          for (int rep = 0; rep < REPN(2); ++rep) {
            { pg8::Gemm g{(const bf16_t*)(ws + WS_CQ), (const bf16_t*)(ws + WS_WUP) + (size_t)lp * WUP_E, T_, opq(768), opq(256)};
              pg8::StaticOrder S; S.init(T_, 768, (int)gridDim.x, (int)blockIdx.x); EpiUp<false> E{ws};
              pg8::gemm_phase<EpiUp<false>, pg8::StaticOrder, false>(lds, g, S, E, nullptr); }
            { pg8::Gemm g{(const bf16_t*)(ws + WS_CKV), (const bf16_t*)(ws + WS_WUP) + (size_t)lp * WUP_E + WUP_KV, T_, opq(1024), opq(128)};
              pg8::StaticOrder S; S.init(T_, 1024, (int)gridDim.x, (int)blockIdx.x); EpiUp<true> E{ws};
              pg8::gemm_phase<EpiUp<true>, pg8::StaticOrder, false>(lds, g, S, E, nullptr); } }
            if (((REP) >> 12) & 1) gla_b_phase(p, true);
            gla_b_phase(p);
        }
        SEAM(base + 2);
        if (IN(base + 3)) {
#ifdef ATT_VAR
            attn_phase<ATT_VAR>(p, lds_);
#endif
            for (int rep = 0; rep < REPN(3); ++rep) attn_phase(p, lds_); for (int rep = 0; rep < REPN(4); ++rep) gla_c_phase(p, lp, lds); }
        SEAM(base + 3);
        if (IN(base + 4)) for (int rep = 0; rep < REPN(5); ++rep) {
            pg8::Gemm g{(const bf16_t*)(ws + WS_H), (const bf16_t*)(ws + WS_WOUTE) + (size_t)lp * 1024 * 1024, T_, opq(1024), opq(1024)};
            pg8::StaticOrder S; S.init(T_, 1024, (int)gridDim.x, (int)blockIdx.x); EpiY E{(bf16_t*)(ws + WS_YE)};
            pg8::gemm_phase<EpiY, pg8::StaticOrder, false>(lds, g, S, E, nullptr);
        }
        SEAM(base + 4);
        if (IN(base + 5)) norm_phase(p, le, le + 1, (const bf16_t*)(ws + WS_YE), le == 0 ? p.in[I_X] : p.out);
        SEAM(base + 5);
        if (IN(base + 6)) for (int rep = 0; rep < REPN(6); ++rep) {
            pg8::Gemm g{(const bf16_t*)(ws + WS_H), (const bf16_t*)(ws + WS_WINO) + (size_t)lp * 6144 * 1024, T_, opq(6144), opq(1024)};
            pg8::StaticOrder S; S.init(T_, 6144, (int)gridDim.x, (int)blockIdx.x); EpiOddIn E{ws};
            pg8::gemm_phase<EpiOddIn, pg8::StaticOrder, false>(lds, g, S, E, nullptr);
        }
        SEAM(base + 6);
        if (IN(base + 7)) { if (((REP) >> 13) & 1) mix_phase(p, lp, lds, true); mix_phase(p, lp, lds); }
        SEAM(base + 7);
        if (IN(base + 8)) for (int rep = 0; rep < REPN(7); ++rep) {
            pg8::Gemm g{(const bf16_t*)(ws + WS_UZ), (const bf16_t*)(ws + WS_WOUTO) + (size_t)lp * 1024 * 2048, T_, opq(1024), opq(2048)};
            pg8::StaticOrder S; S.init(T_, 1024, (int)gridDim.x, (int)blockIdx.x); EpiY E{(bf16_t*)(ws + WS_YO)};
            pg8::gemm_phase<EpiY, pg8::StaticOrder, false>(lds, g, S, E, nullptr);
        }
        SEAM(base + 8);
        if (IN(base + 9)) norm_phase(p, lod, lod < 3 ? lod + 1 : -1, (const bf16_t*)(ws + WS_YO), p.out);
        SEAM(base + 9);
    }
#ifdef DEBUG_HI
    {
        int* DIAG = (int*)(ws + WS_PART);
        const int tid = tid_fresh(); const size_t gtid = (size_t)blockIdx.x * 512 + tid, gsz = (size_t)gridDim.x * 512;
        grid.sync();
        if (blockIdx.x == 0 && tid < 64 && tid != 41) DIAG[tid] = 0;
        for (size_t i = gtid; i < (size_t)T_ * 1024; i += gsz) p.out[i] = DBG_KEEP_OUT ? p.out[i] : 0.f;
        grid.sync();
#define DBG_CHECK(bi, off_, n_, isf32) { int bad = 0; \
            if (isf32) { const float* q = (const float*)(ws + (off_)); for (size_t i = gtid; i < (size_t)(n_); i += gsz) { const float v = q[i]; if (!(fabsf(v) < DBG_LIM)) bad = 1; } } \
            else { const bf16_t* q = (const bf16_t*)(ws + (off_)); for (size_t i = gtid; i < (size_t)(n_); i += gsz) { const float v = bf2f(q[i]); if (!(fabsf(v) < DBG_LIM)) bad = 1; } } \
            if (bad) atomicAdd(&DIAG[bi], 1); }
        DEBUG_BUFS
#ifdef DBG_FRAC
        { int cnt = 0; const bf16_t* q = (const bf16_t*)(ws + DBG_FRAC_OFF); for (size_t i = gtid; i < (size_t)(DBG_FRAC_N); i += gsz) { const float v = bf2f(q[i]); if (!(fabsf(v) < DBG_LIM)) ++cnt; } if (cnt) atomicAdd(&DIAG[40], cnt); }
#endif
        const int nb = DBG_NB;
        grid.sync();
        if (blockIdx.x == 0 && tid == 0) { int first = -1; for (int bi = 0; bi < nb; ++bi) if (first < 0 && __hip_atomic_load(&DIAG[bi], __ATOMIC_RELAXED, __HIP_MEMORY_SCOPE_AGENT) != 0) first = bi; p.out[0] = 1000.f * (float)(first + 1);
#if defined(DBG_MAXP) || defined(DBG_KEXPR)
            p.out[0] = 100.f * __int_as_float(__hip_atomic_load(&DIAG[41], __ATOMIC_RELAXED, __HIP_MEMORY_SCOPE_AGENT));
#endif
#ifdef DBG_FRAC
            p.out[0] = 100.f * (float)__hip_atomic_load(&DIAG[40], __ATOMIC_RELAXED, __HIP_MEMORY_SCOPE_AGENT);
#endif
        }
    }
#endif
}

extern "C" void kernel_launch(void* const* d_in, const int* in_sizes, int n_in, void* d_out, int out_size, void* d_ws, size_t ws_size, hipStream_t stream) {
    static int grid_blocks = 0;
    if (!grid_blocks) {
        if (n_in != 24 || out_size != T_ * 1024 || ws_size < WS_NEED) { fprintf(stderr, "kernel_launch: unexpected shapes (n_in %d out %d ws %zu need %zu)\n", n_in, out_size, ws_size, (size_t)WS_NEED); return; }
        if (hipFuncSetAttribute((const void*)mega, hipFuncAttributeMaxDynamicSharedMemorySize, (int)LDS_BYTES) != hipSuccess) { fprintf(stderr, "hipFuncSetAttribute failed\n"); return; }
        int dev = 0, cus = 0, per_cu = 0;
        (void)hipGetDevice(&dev);
        (void)hipDeviceGetAttribute(&cus, hipDeviceAttributeMultiprocessorCount, dev);
        (void)hipOccupancyMaxActiveBlocksPerMultiprocessor(&per_cu, mega, 512, LDS_BYTES);
        if (per_cu < 1 || cus != 256) { fprintf(stderr, "kernel_launch: occupancy %d cus %d\n", per_cu, cus); }
        grid_blocks = 256;
    }
    Params p{};
    for (int i = 0; i < 24; ++i) p.in[i] = (const float*)d_in[i];
    p.out = (float*)d_out; p.ws = (unsigned char*)d_ws;
#if N_LAUNCH_MODE == 0
    (void)hipMemsetAsync((unsigned char*)d_ws + WS_BAR, 0, (size_t)XCD_BAR_WORDS * 4, stream);
#ifdef DEBUG_HI
    p.ph_lo = 0; p.ph_hi = DEBUG_HI;
#else
    p.ph_lo = 0; p.ph_hi = NPHASE;
#endif
    void* args[] = {&p};
    hipError_t e = hipLaunchCooperativeKernel((void*)mega, dim3(grid_blocks), dim3(512), args, LDS_BYTES, stream);
    if (e != hipSuccess) fprintf(stderr, "cooperative launch failed: %s (grid %d)\n", hipGetErrorString(e), grid_blocks);
#else
    for (int k = 0; k < NPHASE; ++k) { p.ph_lo = k; p.ph_hi = k + 1; hipLaunchKernelGGL(mega, dim3(grid_blocks), dim3(512), LDS_BYTES, stream, p); }
#endif
}
```
